# Optimizing an MI355X kernel written in HIP

```python
import numpy as np
import jax
import jax.numpy as jnp
from jax import lax

D_MODEL = 1024
BATCH = 16
SEQ = 2048
DEPTH = 2

Q_BLOCK = 128
NEG_INF = -1e30
MLA_HEADS = 8
MLA_Q_LORA = 256
MLA_KV_LORA = 128
MLA_NOPE_DIM = 64
MLA_ROPE_DIM = 32
MLA_V_DIM = 64
MLA_QK_DIM = MLA_NOPE_DIM + MLA_ROPE_DIM
ROPE_THETA = 10000.0
CONV_CHANNELS = 512
CONV_WIDTH = 31
MIX0_IN = MLA_Q_LORA + MLA_KV_LORA + MLA_ROPE_DIM + 2 * CONV_CHANNELS
MIX0_OUT = MLA_HEADS * MLA_V_DIM + CONV_CHANNELS
NSA_HEADS = 16
NSA_KV_GROUPS = 2
NSA_HEADS_PER_GROUP = NSA_HEADS // NSA_KV_GROUPS
NSA_HEAD_DIM = 64
NSA_KV_WIDTH = NSA_KV_GROUPS * NSA_HEAD_DIM
NSA_IN = NSA_HEADS * NSA_HEAD_DIM + 6 * NSA_KV_WIDTH + 3 * NSA_HEADS
CMP_BLOCK = 32
CMP_STRIDE = 16
CMP_HIDDEN = 128
SLC_BLOCK = 64
SLC_TOP_N = 8
WINDOW = 256
FORCE_SCORE = 1e4
MOE_GROUPS = 4
MOE_EXPERTS_PER_GROUP = 8
MOE_EXPERTS = MOE_GROUPS * MOE_EXPERTS_PER_GROUP
MOE_TOP_K = 2
MOE_HIDDEN = 256
MOE_ROW_BLOCK = 128

kernel_name = "hybrid_mla_conformer_nsa_hmoe"


def rms_norm(x, g, eps=1e-6):
    xf = x.astype(jnp.float32)
    y = xf * lax.rsqrt(jnp.mean(xf * xf, axis=-1, keepdims=True) + eps)
    return (y * g.astype(jnp.float32)).astype(x.dtype)


def layer_norm(x, g, b, eps=1e-5):
    xf = x.astype(jnp.float32)
    mu = jnp.mean(xf, axis=-1, keepdims=True)
    xc = xf - mu
    var = jnp.mean(xc * xc, axis=-1, keepdims=True)
    y = xc * lax.rsqrt(var + eps) * g.astype(jnp.float32) + b.astype(jnp.float32)
    return y.astype(x.dtype)


def alibi_slopes(n_heads):
    return jnp.asarray(2.0 ** (-8.0 * np.arange(1, n_heads + 1) / n_heads), jnp.float32)


def apply_rope(x, pos):
    half = x.shape[-1] // 2
    inv_freq = ROPE_THETA ** (-jnp.arange(half, dtype=jnp.float32) / half)
    ang = pos.astype(jnp.float32)[:, :, None, None] * inv_freq
    cos = jnp.cos(ang).astype(x.dtype)
    sin = jnp.sin(ang).astype(x.dtype)
    x1, x2 = x[..., :half], x[..., half:]
    return jnp.concatenate([x1 * cos - x2 * sin, x1 * sin + x2 * cos], axis=-1)


def causal_block_attention(q, k, v, scale):
    S = q.shape[2]
    outs = []
    for i in range(S // Q_BLOCK):
        end = (i + 1) * Q_BLOCK
        s = jnp.einsum('bhqd,bhkd->bhqk', q[:, :, i * Q_BLOCK:end], k[:, :, :end]).astype(jnp.float32) * scale
        mask = (i * Q_BLOCK + jnp.arange(Q_BLOCK))[:, None] >= jnp.arange(end)[None, :]
        p = jax.nn.softmax(jnp.where(mask, s, NEG_INF), axis=-1).astype(v.dtype)
        outs.append(jnp.einsum('bhqk,bhkd->bhqd', p, v[:, :, :end]))
    return jnp.concatenate(outs, axis=2)


def causal_depthwise_conv(u, w, b):
    C = u.shape[-1]
    y = lax.conv_general_dilated(u, w[:, None, :].astype(u.dtype), window_strides=(1,),
                                 padding=((CONV_WIDTH - 1, 0),),
                                 dimension_numbers=('NWC', 'WIO', 'NWC'), feature_group_count=C)
    return y + b


def mla_conv_mixer(h, pos, w_in, q_a_norm, w_uq, kv_a_norm, w_ukv, q_norm, k_norm,
                   dw_w, dw_b, ln_g, ln_b, w_out):
    B, S, _ = h.shape
    proj = h @ w_in
    c_q, c_kv, k_rope, conv_in = jnp.split(
        proj, [MLA_Q_LORA, MLA_Q_LORA + MLA_KV_LORA, MLA_Q_LORA + MLA_KV_LORA + MLA_ROPE_DIM], axis=-1)
    q = (rms_norm(c_q, q_a_norm) @ w_uq).reshape(B, S, MLA_HEADS, MLA_QK_DIM)
    kv = (rms_norm(c_kv, kv_a_norm) @ w_ukv).reshape(B, S, MLA_HEADS, MLA_NOPE_DIM + MLA_V_DIM)
    k_nope, v = kv[..., :MLA_NOPE_DIM], kv[..., MLA_NOPE_DIM:]
    k = jnp.concatenate(
        [k_nope, jnp.broadcast_to(k_rope[:, :, None, :], (B, S, MLA_HEADS, MLA_ROPE_DIM))], axis=-1)
    q = rms_norm(q, q_norm)
    k = rms_norm(k, k_norm)
    q = jnp.concatenate([q[..., :MLA_NOPE_DIM], apply_rope(q[..., MLA_NOPE_DIM:], pos)], axis=-1)
    k = jnp.concatenate([k[..., :MLA_NOPE_DIM], apply_rope(k[..., MLA_NOPE_DIM:], pos)], axis=-1)
    o_mla = causal_block_attention(q.transpose(0, 2, 1, 3), k.transpose(0, 2, 1, 3),
                                   v.transpose(0, 2, 1, 3), MLA_QK_DIM ** -0.5)
    o_mla = o_mla.transpose(0, 2, 1, 3).reshape(B, S, MLA_HEADS * MLA_V_DIM)
    a, g = jnp.split(conv_in, 2, axis=-1)
    u = causal_depthwise_conv(a * jax.nn.sigmoid(g), dw_w, dw_b)
    u = jax.nn.silu(layer_norm(u, ln_g, ln_b))
    return jnp.concatenate([o_mla, u], axis=-1) @ w_out


def compress_blocks(kv, pe, w1, w2):
    B, G, S, DK = kv.shape
    n_cmp = (S - CMP_BLOCK) // CMP_STRIDE + 1
    idx = CMP_STRIDE * np.arange(n_cmp)[:, None] + np.arange(CMP_BLOCK)[None, :]
    blocks = (kv[:, :, idx] + pe).reshape(B, G, n_cmp, CMP_BLOCK * DK)
    return jax.nn.gelu(blocks @ w1) @ w2


def compressed_attention(q, k_cmp, v_cmp, pos, slopes):
    S = q.shape[3]
    n_cmp = k_cmp.shape[2]
    end_idx = np.arange(n_cmp) * CMP_STRIDE + CMP_BLOCK - 1
    s = jnp.einsum('bghtd,bgcd->bghtc', q, k_cmp).astype(jnp.float32) * NSA_HEAD_DIM ** -0.5
    dist = (pos[:, :, None] - pos[:, end_idx][:, None, :]).astype(jnp.float32)
    valid = np.arange(S)[:, None] >= end_idx[None, :]
    s = s - slopes[None, :, :, None, None] * dist[:, None, None]
    s = jnp.where(valid, s, NEG_INF)
    m = jnp.max(s, axis=-1, keepdims=True)
    p = jnp.where(valid, jnp.exp(s - m), 0.0)
    p = p / jnp.maximum(jnp.sum(p, axis=-1, keepdims=True), 1e-20)
    o = jnp.einsum('bghtc,bgcd->bghtd', p.astype(v_cmp.dtype), v_cmp)
    return o, p


def select_blocks(p_cmp, S):
    n_cmp = p_cmp.shape[-1]
    n_sel = S // SLC_BLOCK
    cmp_start = np.arange(n_cmp) * CMP_STRIDE
    slc_start = np.arange(n_sel) * SLC_BLOCK
    overlap = (cmp_start[:, None] < slc_start[None, :] + SLC_BLOCK) & (cmp_start[:, None] + CMP_BLOCK > slc_start[None, :])
    imp = jnp.einsum('bghtc,cj->bgtj', p_cmp, jnp.asarray(overlap, jnp.float32))
    cur = np.arange(S)[:, None] // SLC_BLOCK
    j = np.arange(n_sel)[None, :]
    forced = (j == 0) | (j == cur) | (j == cur - 1)
    imp = jnp.where(forced, FORCE_SCORE, jnp.where(j <= cur, imp, -1.0))
    _, sel = lax.top_k(imp, min(SLC_TOP_N, n_sel))
    return sel


def selected_attention(q, k, v, pos, sel, slopes):
    B, G, HPG, S, DK = q.shape
    n_sel = S // SLC_BLOCK
    nq = S // Q_BLOCK
    n_top = sel.shape[-1]
    kb = k.reshape(B, G, n_sel, SLC_BLOCK, DK)
    vb = v.reshape(B, G, n_sel, SLC_BLOCK, DK)
    pos_blocks = pos.reshape(B, n_sel, SLC_BLOCK)
    q_c = q.reshape(B, G, HPG, nq, Q_BLOCK, DK).transpose(3, 0, 1, 2, 4, 5)
    sel_c = sel.reshape(B, G, nq, Q_BLOCK, n_top).transpose(2, 0, 1, 3, 4)
    pos_c = pos.reshape(B, nq, Q_BLOCK).transpose(1, 0, 2)
    starts = jnp.arange(nq, dtype=jnp.int32) * Q_BLOCK
    gather_kv = jax.vmap(jax.vmap(lambda blk, idx: blk[idx]))
    gather_pos = jax.vmap(lambda pb, idx: pb[idx])

    def one_block(args):
        qc, sc, pq, t0 = args
        kg = gather_kv(kb, sc)
        vg = gather_kv(vb, sc)
        pk = gather_pos(pos_blocks, sc)
        s = jnp.einsum('bghqd,bgqnld->bghqnl', qc, kg).astype(jnp.float32) * DK ** -0.5
        t_idx = t0 + jnp.arange(Q_BLOCK)
        k_idx = sc[..., None] * SLC_BLOCK + jnp.arange(SLC_BLOCK)
        valid = k_idx <= t_idx[None, None, :, None, None]
        dist = (pq[:, None, :, None, None] - pk).astype(jnp.float32)
        s = s - slopes[None, :, :, None, None, None] * dist[:, :, None]
        s = jnp.where(valid[:, :, None], s, NEG_INF).reshape(B, G, HPG, Q_BLOCK, n_top * SLC_BLOCK)
        p = jax.nn.softmax(s, axis=-1).reshape(B, G, HPG, Q_BLOCK, n_top, SLC_BLOCK).astype(v.dtype)
        return jnp.einsum('bghqnl,bgqnld->bghqd', p, vg)

    o = lax.map(one_block, (q_c, sel_c, pos_c, starts))
    return o.transpose(1, 2, 3, 0, 4, 5).reshape(B, G, HPG, S, DK)


def window_attention(q, k, v, pos, slopes):
    B, G, HPG, S, DK = q.shape
    nq = S // Q_BLOCK
    span = WINDOW + Q_BLOCK
    k_pad = jnp.pad(k, ((0, 0), (0, 0), (WINDOW, 0), (0, 0)))
    v_pad = jnp.pad(v, ((0, 0), (0, 0), (WINDOW, 0), (0, 0)))
    pos_pad = jnp.pad(pos, ((0, 0), (WINDOW, 0)))
    q_c = q.reshape(B, G, HPG, nq, Q_BLOCK, DK).transpose(3, 0, 1, 2, 4, 5)
    pos_c = pos.reshape(B, nq, Q_BLOCK).transpose(1, 0, 2)
    starts = jnp.arange(nq, dtype=jnp.int32) * Q_BLOCK

    def one_block(args):
        qc, pq, t0 = args
        kb = lax.dynamic_slice_in_dim(k_pad, t0, span, axis=2)
        vb = lax.dynamic_slice_in_dim(v_pad, t0, span, axis=2)
        pk = lax.dynamic_slice_in_dim(pos_pad, t0, span, axis=1)
        s = jnp.einsum('bghqd,bgkd->bghqk', qc, kb).astype(jnp.float32) * DK ** -0.5
        t_idx = t0 + jnp.arange(Q_BLOCK)
        k_idx = t0 - WINDOW + jnp.arange(span)
        rel = t_idx[:, None] - k_idx[None, :]
        valid = (k_idx[None, :] >= 0) & (rel >= 0) & (rel < WINDOW)
        dist = (pq[:, :, None] - pk[:, None, :]).astype(jnp.float32)
        s = s - slopes[None, :, :, None, None] * dist[:, None, None]
        p = jax.nn.softmax(jnp.where(valid, s, NEG_INF), axis=-1).astype(v.dtype)
        return jnp.einsum('bghqk,bgkd->bghqd', p, vb)

    o = lax.map(one_block, (q_c, pos_c, starts))
    return o.transpose(1, 2, 3, 0, 4, 5).reshape(B, G, HPG, S, DK)


def nsa_mixer(h, pos, slopes, w_in, q_norm, k_norm_cmp, k_norm_slc, k_norm_win,
              cmp_pe_k, cmp_w1_k, cmp_w2_k, cmp_pe_v, cmp_w1_v, cmp_w2_v, w_out):
    B, S, _ = h.shape
    G, HPG, DK = NSA_KV_GROUPS, NSA_HEADS_PER_GROUP, NSA_HEAD_DIM
    proj = h @ w_in
    split_pts = np.cumsum([NSA_HEADS * DK] + [NSA_KV_WIDTH] * 6).tolist()
    q, kc, vc, ks, vs, kw, vw, gates = jnp.split(proj, split_pts, axis=-1)
    q = rms_norm(q.reshape(B, S, G, HPG, DK), q_norm).transpose(0, 2, 3, 1, 4)
    to_kv = lambda t: t.reshape(B, S, G, DK).transpose(0, 2, 1, 3)
    k_cmp = rms_norm(compress_blocks(to_kv(kc), cmp_pe_k, cmp_w1_k, cmp_w2_k), k_norm_cmp)
    v_cmp = compress_blocks(to_kv(vc), cmp_pe_v, cmp_w1_v, cmp_w2_v)
    o_cmp, p_cmp = compressed_attention(q, k_cmp, v_cmp, pos, slopes)
    sel = select_blocks(p_cmp, S)
    o_slc = selected_attention(q, rms_norm(to_kv(ks), k_norm_slc), to_kv(vs), pos, sel, slopes)
    o_win = window_attention(q, rms_norm(to_kv(kw), k_norm_win), to_kv(vw), pos, slopes)
    g = jax.nn.sigmoid(gates).reshape(B, S, 3, G, HPG).transpose(2, 0, 3, 4, 1)[..., None]
    o = g[0] * o_cmp + g[1] * o_slc + g[2] * o_win
    return o.transpose(0, 3, 1, 2, 4).reshape(B, S, NSA_HEADS * DK) @ w_out


def hierarchical_moe(h, router_group, router_group_b, router_expert, router_expert_b, w_gate, w_up, w_down):
    B, S, D = h.shape
    T = B * S
    xt = h.reshape(T, D)
    g_logits = (xt @ router_group).astype(jnp.float32) + router_group_b.astype(jnp.float32)
    _, grp = lax.top_k(g_logits, 1)
    g_w = jnp.take_along_axis(jax.nn.softmax(g_logits, axis=-1), grp, axis=-1)
    e_logits = ((xt @ router_expert).astype(jnp.float32) + router_expert_b.astype(jnp.float32)
                ).reshape(T, MOE_GROUPS, MOE_EXPERTS_PER_GROUP)
    e_in = jnp.take_along_axis(e_logits, grp[:, :, None], axis=1)[:, 0]
    top_val, top_idx = lax.top_k(e_in, MOE_TOP_K)
    gates = jax.nn.softmax(top_val, axis=-1) * g_w
    expert = grp * MOE_EXPERTS_PER_GROUP + top_idx
    A = T * MOE_TOP_K
    e_flat = expert.reshape(A)
    tok_flat = jnp.repeat(jnp.arange(T, dtype=jnp.int32), MOE_TOP_K)
    w_flat = gates.reshape(A).astype(h.dtype)
    order = jnp.argsort(e_flat)
    e_sorted = e_flat[order]
    counts = jnp.bincount(e_flat, length=MOE_EXPERTS)
    starts = jnp.cumsum(counts) - counts
    padded = (counts + MOE_ROW_BLOCK - 1) // MOE_ROW_BLOCK * MOE_ROW_BLOCK
    padded_end = jnp.cumsum(padded)
    dest = (padded_end - padded)[e_sorted] + (jnp.arange(A) - starts[e_sorted])
    R = A + MOE_EXPERTS * MOE_ROW_BLOCK
    n_blk = R // MOE_ROW_BLOCK
    row_tok = jnp.full((R,), T, jnp.int32).at[dest].set(tok_flat[order])
    row_w = jnp.zeros((R,), h.dtype).at[dest].set(w_flat[order])
    blk_expert = jnp.clip(jnp.searchsorted(padded_end, jnp.arange(n_blk) * MOE_ROW_BLOCK, side='right'),
                          0, MOE_EXPERTS - 1)
    x_pad = jnp.concatenate([xt, jnp.zeros((1, D), xt.dtype)], axis=0)

    def expert_block(args):
        toks, wts, e = args
        rows = x_pad[toks]
        y = (jax.nn.silu(rows @ w_gate[e]) * (rows @ w_up[e])) @ w_down[e]
        return y * wts[:, None]

    ys = lax.map(expert_block, (row_tok.reshape(n_blk, MOE_ROW_BLOCK), row_w.reshape(n_blk, MOE_ROW_BLOCK), blk_expert))
    out = jax.ops.segment_sum(ys.reshape(R, D), row_tok, num_segments=T + 1)[:T]
    return out.reshape(B, S, D).astype(h.dtype)


def setup_inputs(seed: int = 0) -> dict:
    key = jax.random.key(seed)
    keys = iter(jax.random.split(key, 64))
    n_even = (DEPTH + 1) // 2
    n_odd = DEPTH // 2
    D = D_MODEL

    def dense(shape, fan_in):
        return jax.random.normal(next(keys), shape, jnp.float32) * fan_in ** -0.5

    def gain(shape):
        return 1.0 + 0.05 * jax.random.normal(next(keys), shape, jnp.float32)

    def small(shape, scale=0.02):
        return scale * jax.random.normal(next(keys), shape, jnp.float32)

    x = jax.random.normal(next(keys), (BATCH, SEQ, D), jnp.float32)
    positions = (jnp.cumsum(jax.random.randint(next(keys), (BATCH, SEQ), 1, 3), axis=1) - 1).astype(jnp.int32)
    L, DK = CMP_BLOCK, NSA_HEAD_DIM
    return {
        "x": x,
        "positions": positions,
        "norm_mix": gain((DEPTH, D)),
        "norm_ffn": gain((DEPTH, D)),
        "mix0_w_in": dense((n_even, D, MIX0_IN), D),
        "mla_q_a_norm": gain((n_even, MLA_Q_LORA)),
        "mla_w_uq": dense((n_even, MLA_Q_LORA, MLA_HEADS * MLA_QK_DIM), MLA_Q_LORA),
        "mla_kv_a_norm": gain((n_even, MLA_KV_LORA)),
        "mla_w_ukv": dense((n_even, MLA_KV_LORA, MLA_HEADS * (MLA_NOPE_DIM + MLA_V_DIM)), MLA_KV_LORA),
        "mla_q_norm": gain((n_even, MLA_QK_DIM)),
        "mla_k_norm": gain((n_even, MLA_QK_DIM)),
        "conv_dw_w": dense((n_even, CONV_WIDTH, CONV_CHANNELS), CONV_WIDTH),
        "conv_dw_b": small((n_even, CONV_CHANNELS)),
        "conv_ln_g": gain((n_even, CONV_CHANNELS)),
        "conv_ln_b": small((n_even, CONV_CHANNELS)),
        "mix0_w_out": dense((n_even, MIX0_OUT, D), MIX0_OUT),
        "nsa_w_in": dense((n_odd, D, NSA_IN), D),
        "nsa_q_norm": gain((n_odd, DK)),
        "nsa_k_norm_cmp": gain((n_odd, DK)),
        "nsa_k_norm_slc": gain((n_odd, DK)),
        "nsa_k_norm_win": gain((n_odd, DK)),
        "nsa_cmp_pe_k": small((n_odd, L, DK), 0.1),
        "nsa_cmp_w1_k": dense((n_odd, L * DK, CMP_HIDDEN), L * DK),
        "nsa_cmp_w2_k": dense((n_odd, CMP_HIDDEN, DK), CMP_HIDDEN),
        "nsa_cmp_pe_v": small((n_odd, L, DK), 0.1),
        "nsa_cmp_w1_v": dense((n_odd, L * DK, CMP_HIDDEN), L * DK),
        "nsa_cmp_w2_v": dense((n_odd, CMP_HIDDEN, DK), CMP_HIDDEN),
        "nsa_w_out": dense((n_odd, NSA_HEADS * DK, D), NSA_HEADS * DK),
        "moe_router_group": dense((DEPTH, D, MOE_GROUPS), D),
        "moe_router_group_b": small((DEPTH, MOE_GROUPS), 0.01),
        "moe_router_expert": dense((DEPTH, D, MOE_EXPERTS), D),
        "moe_router_expert_b": small((DEPTH, MOE_EXPERTS), 0.01),
        "moe_w_gate": dense((DEPTH, MOE_EXPERTS, D, MOE_HIDDEN), D),
        "moe_w_up": dense((DEPTH, MOE_EXPERTS, D, MOE_HIDDEN), D),
        "moe_w_down": dense((DEPTH, MOE_EXPERTS, MOE_HIDDEN, D), MOE_HIDDEN),
    }


def reference(x, positions, norm_mix, norm_ffn, mix0_w_in, mla_q_a_norm, mla_w_uq, mla_kv_a_norm,
              mla_w_ukv, mla_q_norm, mla_k_norm, conv_dw_w, conv_dw_b, conv_ln_g, conv_ln_b, mix0_w_out,
              nsa_w_in, nsa_q_norm, nsa_k_norm_cmp, nsa_k_norm_slc, nsa_k_norm_win,
              nsa_cmp_pe_k, nsa_cmp_w1_k, nsa_cmp_w2_k, nsa_cmp_pe_v, nsa_cmp_w1_v, nsa_cmp_w2_v, nsa_w_out,
              moe_router_group, moe_router_group_b, moe_router_expert, moe_router_expert_b,
              moe_w_gate, moe_w_up, moe_w_down):
    slopes = alibi_slopes(NSA_HEADS).reshape(NSA_KV_GROUPS, NSA_HEADS_PER_GROUP)
    for layer in range(DEPTH):
        i = layer // 2
        h = rms_norm(x, norm_mix[layer])
        if layer % 2 == 0:
            mix = mla_conv_mixer(h, positions, mix0_w_in[i], mla_q_a_norm[i], mla_w_uq[i], mla_kv_a_norm[i],
                                 mla_w_ukv[i], mla_q_norm[i], mla_k_norm[i], conv_dw_w[i], conv_dw_b[i],
                                 conv_ln_g[i], conv_ln_b[i], mix0_w_out[i])
        else:
            mix = nsa_mixer(h, positions, slopes, nsa_w_in[i], nsa_q_norm[i], nsa_k_norm_cmp[i],
                            nsa_k_norm_slc[i], nsa_k_norm_win[i], nsa_cmp_pe_k[i], nsa_cmp_w1_k[i],
                            nsa_cmp_w2_k[i], nsa_cmp_pe_v[i], nsa_cmp_w1_v[i], nsa_cmp_w2_v[i], nsa_w_out[i])
        x = x + mix
        x = x + hierarchical_moe(rms_norm(x, norm_ffn[layer]), moe_router_group[layer], moe_router_group_b[layer],
                                 moe_router_expert[layer], moe_router_expert_b[layer],
                                 moe_w_gate[layer], moe_w_up[layer], moe_w_down[layer])
    return x
```

```cpp
#include <hip/hip_runtime.h>
#include <hip/hip_cooperative_groups.h>
#include <stdint.h>
#include <math.h>
#include <stdio.h>
#include <string.h>
namespace cg = cooperative_groups;

typedef unsigned short bf16_t;
typedef short bf16x8 __attribute__((ext_vector_type(8)));
typedef float f32x4 __attribute__((ext_vector_type(4)));
typedef unsigned u32x4 __attribute__((ext_vector_type(4)));
typedef unsigned u32x2 __attribute__((ext_vector_type(2)));

#define DEVI __device__ __forceinline__
#define AS4 __attribute__((address_space(4)))

constexpr int T_ = 32768;
constexpr int S_ = 2048;
constexpr int LDS_BYTES = 155648;
constexpr int LDS_MISC = 147456;
constexpr float LOG2E = 1.4426950408889634f;
constexpr float NEGBIG = -1e30f;

struct ConvJob {
  const float* src; bf16_t* dst; const float* gain;
  int K, N, Npad, mode, batch, tile_start, pad0;
  long long sstride, dstride;
};
constexpr int MAXJOBS = 16;

struct Params {
  const float* x; const int* pos; const float* norm_mix; const float* norm_ffn;
  const float* mla_q_norm; const float* mla_k_norm;
  const float* conv_dw_w; const float* conv_dw_b; const float* conv_ln_g; const float* conv_ln_b;
  const float* nsa_q_norm; const float* nsa_k_norm_cmp; const float* nsa_k_norm_slc; const float* nsa_k_norm_win;
  const float* cmp_pe_k; const float* cmp_w1_k; const float* cmp_pe_v; const float* cmp_w1_v;
  const float* r_group; const float* r_group_b; const float* r_expert; const float* r_expert_b;
  float* out;
  bf16_t* W1t; bf16_t* Wuqt; bf16_t* Wukvt; bf16_t* Wo0t; bf16_t* W5t;
  bf16_t* Wc1kt; bf16_t* Wc1vt; bf16_t* Wc2kt; bf16_t* Wc2vt; bf16_t* Wo1t;
  bf16_t* Wgut; bf16_t* Wdt;
  float* xr;
  bf16_t* hn;
  bf16_t* proj0; bf16_t* Q0; bf16_t* K0; bf16_t* V0t;
  bf16_t* ybuf; bf16_t* hbuf;
  bf16_t* Q1; bf16_t* KC; bf16_t* VC; bf16_t* KS; bf16_t* VSt; bf16_t* KW; bf16_t* VWt; float* GATES;
  bf16_t* KCMP; bf16_t* VCMPt;
  bf16_t* RWh; bf16_t* RWl; float* rs; float2* row_aux; int* row_tok; int* gcnt; float* bias1; unsigned* bar;
  float inv_freq[16];
  ConvJob jobs[MAXJOBS];
  int njobs0, ntiles0, njobs1_begin, ntiles1, use_cg, njobsA, ntilesA, pad3;
};

typedef const AS4 Params& PR;
DEVI const AS4 Params* get_params() {
  const AS4 Params* kp = (const AS4 Params*)__builtin_amdgcn_kernarg_segment_ptr();
  asm volatile("" : "+s"(kp));
  return kp;
}

DEVI int get_tid() { int t = threadIdx.x; asm volatile("" : "+v"(t)); return t; }

typedef float f32x2_ __attribute__((ext_vector_type(2)));
typedef __bf16 bf16x2_ __attribute__((ext_vector_type(2)));
DEVI unsigned pack2(float lo, float hi) { const f32x2_ v = {lo, hi}; return __builtin_bit_cast(unsigned, __builtin_convertvector(v, bf16x2_)); }
DEVI float bflo(unsigned w) { return __uint_as_float(w << 16); }
DEVI float bfhi(unsigned w) { return __uint_as_float(w & 0xffff0000u); }
DEVI float bf2f(bf16_t h) { return __uint_as_float(((unsigned)h) << 16); }
DEVI bf16_t f2bf(float f) { return (bf16_t)(pack2(f, 0.f) & 0xffffu); }
DEVI float fast_exp2(float x) { return __builtin_amdgcn_exp2f(x); }
DEVI float fast_rcp(float x) { return __builtin_amdgcn_rcpf(x); }
DEVI float sigmoidf_(float x) { return fast_rcp(1.0f + fast_exp2(-x * LOG2E)); }
DEVI float wave_sum(float v) {
  v += __shfl_xor(v, 32); v += __shfl_xor(v, 16); v += __shfl_xor(v, 8);
  v += __shfl_xor(v, 4); v += __shfl_xor(v, 2); v += __shfl_xor(v, 1); return v;
}
DEVI void sincos_rev(float ang, float& s, float& c) {
  float rev = ang * 0.15915494309189535f;
  rev = rev - floorf(rev);
  s = __builtin_amdgcn_sinf(rev); c = __builtin_amdgcn_cosf(rev);
}

struct XcdIter {
  int xcd, lb, nlb;
  DEVI void init() { xcd = blockIdx.x & 7; lb = blockIdx.x >> 3; nlb = gridDim.x >> 3; }
};

DEVI int swz(int r, int c16) { return r * 128 + ((c16 ^ ((r >> 1) & 7)) << 4); }

template <int NT>
DEVI void mma_stage(const char* As, const char* Bs, f32x4 (&acc)[4][NT], int wr, int wc, int fr, int fq) {
  bf16x8 a[2][4], b[2][NT];
#pragma unroll
  for (int ks = 0; ks < 2; ++ks) {
#pragma unroll
    for (int m = 0; m < 4; ++m) a[ks][m] = *(const bf16x8*)(As + swz(wr * 64 + m * 16 + fr, ks * 4 + fq));
#pragma unroll
    for (int n = 0; n < NT; ++n) b[ks][n] = *(const bf16x8*)(Bs + swz(wc * (NT * 16) + n * 16 + fr, ks * 4 + fq));
  }
  __builtin_amdgcn_sched_barrier(0);
#pragma unroll
  for (int ks = 0; ks < 2; ++ks) {
#pragma unroll
    for (int m = 0; m < 4; ++m)
#pragma unroll
      for (int n = 0; n < NT; ++n) acc[m][n] = __builtin_amdgcn_mfma_f32_16x16x32_bf16(a[ks][m], b[ks][n], acc[m][n], 0, 0, 0);
    __builtin_amdgcn_sched_barrier(0);
  }
}

template <int NT>
DEVI void load_frags(const char* As, const char* Bs, bf16x8 (&a)[2][4], bf16x8 (&b)[2][NT], int wr, int wc, int fr, int fq) {
#pragma unroll
  for (int ks = 0; ks < 2; ++ks) {
#pragma unroll
    for (int m = 0; m < 4; ++m) a[ks][m] = *(const bf16x8*)(As + swz(wr * 64 + m * 16 + fr, ks * 4 + fq));
#pragma unroll
    for (int n = 0; n < NT; ++n) b[ks][n] = *(const bf16x8*)(Bs + swz(wc * (NT * 16) + n * 16 + fr, ks * 4 + fq));
  }
}
template <int NT>
DEVI void mfma_frags(const bf16x8 (&a)[2][4], const bf16x8 (&b)[2][NT], f32x4 (&acc)[4][NT]) {
#pragma unroll
  for (int ks = 0; ks < 2; ++ks)
#pragma unroll
    for (int m = 0; m < 4; ++m)
#pragma unroll
      for (int n = 0; n < NT; ++n) acc[m][n] = __builtin_amdgcn_mfma_f32_16x16x32_bf16(a[ks][m], b[ks][n], acc[m][n], 0, 0, 0);
}

template <int NT, class ARow, class BRow>
DEVI void gemm_mainloop2(f32x4 (&acc)[4][NT], ARow arow, BRow brow, int K, char* lds);

template <int NT, class ARow>
DEVI void gemm_mainloop(f32x4 (&acc)[4][NT], ARow arow, const bf16_t* __restrict__ Bt, int ldb, int K, char* lds) {
  gemm_mainloop2<NT>(acc, arow, [&](int r) { return Bt + (size_t)r * ldb; }, K, lds);
}

template <int NT, class ARow, class BRow>
DEVI void gemm_mainloop2(f32x4 (&acc)[4][NT], ARow arow, BRow brow, int K, char* lds) {
  constexpr int BN = NT * 32;
  constexpr int NBD = (BN * 8 + 511) / 512;
  constexpr int NDMA = 4 + NBD;
  constexpr int STAGE = 32768 + BN * 128;
  const int tid = get_tid(), lane = tid & 63, wid = tid >> 6, wr = wid >> 1, wc = wid & 1, fr = lane & 15, fq = lane >> 4;
  const int lr = tid >> 3, pc = tid & 7, lc = pc ^ ((lr >> 1) & 7);
  const bf16_t* ap[4]; const bf16_t* bp[NBD]; int boff[NBD];
#pragma unroll
  for (int i = 0; i < 4; ++i) ap[i] = arow(lr + 64 * i) + lc * 8;
#pragma unroll
  for (int i = 0; i < NBD; ++i) {
    int r = lr + 64 * i; if (r >= BN) r -= BN;
    bp[i] = brow(r) + lc * 8; boff[i] = r * 128 + pc * 16;
  }
#pragma unroll
  for (int m = 0; m < 4; ++m)
#pragma unroll
    for (int n = 0; n < NT; ++n) acc[m][n] = (f32x4){0.f, 0.f, 0.f, 0.f};
  const int nk = K >> 6;
  auto issue = [&](int kt, int st) {
    char* As = lds + st * STAGE; char* Bs = As + 32768;
#pragma unroll
    for (int i = 0; i < 4; ++i) __builtin_amdgcn_global_load_lds((const unsigned*)(ap[i] + kt * 64), (unsigned*)(As + (tid + 512 * i) * 16), 16, 0, 0);
#pragma unroll
    for (int i = 0; i < NBD; ++i) __builtin_amdgcn_global_load_lds((const unsigned*)(bp[i] + kt * 64), (unsigned*)(Bs + boff[i]), 16, 0, 0);
  };
  issue(0, 0);
  issue(1, 1);
  int st = 0;
  for (int kt = 0; kt < nk; ++kt) {
    if (kt + 1 < nk) asm volatile("s_waitcnt vmcnt(%0)" :: "n"(NDMA) : "memory");
    else asm volatile("s_waitcnt vmcnt(0)" ::: "memory");
    __builtin_amdgcn_s_barrier();
    asm volatile("" ::: "memory");
    const char* As = lds + st * STAGE; const char* Bs = As + 32768;
    bf16x8 fa[2][4], fb[2][NT];
    load_frags<NT>(As, Bs, fa, fb, wr, wc, fr, fq);
    __builtin_amdgcn_sched_barrier(0);
    if (kt + 2 < nk) { int s2 = st + 2; if (s2 >= 3) s2 -= 3; issue(kt + 2, s2); }
    mfma_frags<NT>(fa, fb, acc);
    st = (st == 2) ? 0 : st + 1;
  }
  __syncthreads();
}

template <int NT>
DEVI void acc_to_lds(const f32x4 (&acc)[4][NT], float* Cs) {
  constexpr int LDC = NT * 32 + 4;
  const int lane = get_tid() & 63, wid = get_tid() >> 6, wr = wid >> 1, wc = wid & 1, fr = lane & 15, fq = lane >> 4;
#pragma unroll
  for (int m = 0; m < 4; ++m)
#pragma unroll
    for (int n = 0; n < NT; ++n)
#pragma unroll
      for (int j = 0; j < 4; ++j) Cs[(wr * 64 + m * 16 + fq * 4 + j) * LDC + wc * (NT * 16) + n * 16 + fr] = acc[m][n][j];
  __syncthreads();
}

DEVI void conv_weight_tile(const AS4 ConvJob& jb, int local, char* lds, int tid) {
  float* tile = (float*)lds;
  const int nkt = jb.K >> 6, nnt = jb.Npad >> 6;
  const int per = nkt * nnt;
  const int bi = local / per; const int rem = local - bi * per;
  const int ktile = rem / nnt, ntile = rem - ktile * nnt;
  const int k0 = ktile * 64, n0 = ntile * 64;
  const float* src = jb.src + (size_t)bi * jb.sstride;
  bf16_t* dst = jb.dst + (size_t)bi * jb.dstride;
  {
    const int c4 = (tid & 15) * 4; const int r0 = tid >> 4;
#pragma unroll
    for (int i = 0; i < 4; ++i) {
      const int k = r0 + 16 * i; const int n = n0 + c4;
      float4 v = make_float4(0.f, 0.f, 0.f, 0.f);
      if (n < jb.N) v = *(const float4*)(src + (size_t)(k0 + k) * jb.N + n);
      if (jb.gain) { const float g = jb.gain[k0 + k]; v.x *= g; v.y *= g; v.z *= g; v.w *= g; }
      tile[k * 65 + c4 + 0] = v.x; tile[k * 65 + c4 + 1] = v.y; tile[k * 65 + c4 + 2] = v.z; tile[k * 65 + c4 + 3] = v.w;
    }
  }
  __syncthreads();
  {
    const int n = tid >> 2, kseg = (tid & 3) * 16;
    unsigned w[8];
#pragma unroll
    for (int i = 0; i < 8; ++i) w[i] = pack2(tile[(kseg + 2 * i) * 65 + n], tile[(kseg + 2 * i + 1) * 65 + n]);
    const int ng = n0 + n;
    int row = ng;
    if (jb.mode == 1) row = (ng >> 6) * 128 + (ng & 63);
    else if (jb.mode == 2) row = (ng >> 6) * 128 + 64 + (ng & 63);
    bf16_t* d = dst + (size_t)row * jb.K + k0 + kseg;
    *(u32x4*)(d) = (u32x4){w[0], w[1], w[2], w[3]};
    *(u32x4*)(d + 8) = (u32x4){w[4], w[5], w[6], w[7]};
  }
  __syncthreads();
}

DEVI void conv_weights_phase(PR p, int jbegin, int jend, int ntiles, char* lds) {
  const int vb = blockIdx.x * 2 + (get_tid() >> 8), nvb = gridDim.x * 2, vtid = get_tid() & 255;
  char* ldsv = lds + (get_tid() >> 8) * 32768;
  const int niter = (ntiles + nvb - 1) / nvb;
  for (int it = 0; it < niter; ++it) {
    const int t = vb + it * nvb;
    if (t < ntiles) {
      int j = jbegin;
      while (j + 1 < jend && p.jobs[j + 1].tile_start <= t) ++j;
      conv_weight_tile(p.jobs[j], t - p.jobs[j].tile_start, ldsv, vtid);
    } else { __syncthreads(); __syncthreads(); }
  }
}

DEVI void rownorm_phase(const float* __restrict__ src, const bf16_t* __restrict__ y, const float* __restrict__ gain,
                        float* dstx, bf16_t* dsth) {
  const int lane = get_tid() & 63;
  const int wave = blockIdx.x * 8 + (get_tid() >> 6), nw = gridDim.x * 8;
  for (int row = wave; row < T_; row += nw) {
    float4 v[4];
#pragma unroll
    for (int i = 0; i < 4; ++i) v[i] = *(const float4*)(src + (size_t)row * 1024 + i * 256 + lane * 4);
    if (y) {
#pragma unroll
      for (int s = 0; s < 2; ++s)
#pragma unroll
        for (int i = 0; i < 4; ++i) {
          u32x2 w = *(const u32x2*)(y + (size_t)(row * 2 + s) * 1024 + i * 256 + lane * 4);
          v[i].x += bflo(w.x); v[i].y += bfhi(w.x); v[i].z += bflo(w.y); v[i].w += bfhi(w.y);
        }
    }
    if (dstx) {
#pragma unroll
      for (int i = 0; i < 4; ++i) *(float4*)(dstx + (size_t)row * 1024 + i * 256 + lane * 4) = v[i];
    }
    if (dsth) {
      float ss = 0.f;
#pragma unroll
      for (int i = 0; i < 4; ++i) ss += v[i].x * v[i].x + v[i].y * v[i].y + v[i].z * v[i].z + v[i].w * v[i].w;
      ss = wave_sum(ss);
      const float r = 1.0f / sqrtf(ss * (1.0f / 1024.0f) + 1e-6f);
#pragma unroll
      for (int i = 0; i < 4; ++i) {
        const float4 g = *(const float4*)(gain + i * 256 + lane * 4);
        u32x2 w; w.x = pack2(v[i].x * r * g.x, v[i].y * r * g.y); w.y = pack2(v[i].z * r * g.z, v[i].w * r * g.w);
        *(u32x2*)(dsth + (size_t)row * 1024 + i * 256 + lane * 4) = w;
      }
    }
  }
}

DEVI void gemm_bf16out_phase(const bf16_t* A, int lda, const bf16_t* Bt, int K, int ncolt, bf16_t* out, int ldo, int nvalid, char* lds) {
  float* Cs = (float*)lds;
  XcdIter xi; xi.init();
  const int gsz = (ncolt > 8) ? 6 : ncolt;
  for (int n = xi.lb; n < 16 * ncolt; n += xi.nlb) {
    const int grp = n / (16 * gsz), rem = n - grp * (16 * gsz);
    const int rl = rem / gsz, jn = grp * gsz + (rem - rl * gsz);
    const int rt = xi.xcd * 16 + rl;
    f32x4 acc[4][4];
    const bf16_t* Ab = A + (size_t)rt * 256 * lda;
    gemm_mainloop<4>(acc, [&](int r) { return Ab + (size_t)r * lda; }, Bt + (size_t)jn * 128 * K, K, K, lds);
    acc_to_lds<4>(acc, Cs);
    const int c4 = get_tid() & 31, r0 = get_tid() >> 5;
    const int col = jn * 128 + c4 * 4;
    if (col < nvalid) {
#pragma unroll
      for (int i = 0; i < 16; ++i) {
        const int row = r0 + 16 * i;
        const f32x4 v = *(const f32x4*)(Cs + row * 132 + c4 * 4);
        u32x2 w; w.x = pack2(v[0], v[1]); w.y = pack2(v[2], v[3]);
        *(u32x2*)(out + (size_t)(rt * 256 + row) * ldo + col) = w;
      }
    }
    __syncthreads();
  }
}

DEVI void gemm_resid_phase(const bf16_t* A, const bf16_t* Bt, const float* base, float* xr, char* lds) {
  float* Cs = (float*)lds;
  XcdIter xi; xi.init();
  for (int n = xi.lb; n < 16 * 8; n += xi.nlb) {
    const int rt = xi.xcd * 16 + (n >> 3), jn = n & 7;
    f32x4 acc[4][4];
    const bf16_t* Ab = A + (size_t)rt * 256 * 1024;
    gemm_mainloop<4>(acc, [&](int r) { return Ab + (size_t)r * 1024; }, Bt + (size_t)jn * 128 * 1024, 1024, 1024, lds);
    const int c4 = get_tid() & 31, r0 = get_tid() >> 5;
    const int col = jn * 128 + c4 * 4;
    float4 bres[16];
#pragma unroll
    for (int i = 0; i < 16; ++i) bres[i] = *(const float4*)(base + (size_t)(rt * 256 + r0 + 16 * i) * 1024 + col);
    acc_to_lds<4>(acc, Cs);
#pragma unroll
    for (int i = 0; i < 16; ++i) {
      const int row = r0 + 16 * i;
      const f32x4 v = *(const f32x4*)(Cs + row * 132 + c4 * 4);
      const size_t o = (size_t)(rt * 256 + row) * 1024 + col;
      const float4 b = bres[i];
      *(float4*)(xr + o) = make_float4(b.x + v[0], b.y + v[1], b.z + v[2], b.w + v[3]);
    }
    __syncthreads();
  }
}

template <int KW>
DEVI void row_rms_scale(const bf16_t* Ab, int lda, float* rsA) {
  const int row = get_tid() >> 1, half = get_tid() & 1;
  const bf16_t* q = Ab + (size_t)row * lda + half * (KW / 2);
  float ss = 0.f;
#pragma unroll
  for (int i = 0; i < KW / 16; ++i) {
    const u32x4 w = *(const u32x4*)(q + i * 8);
#pragma unroll
    for (int e = 0; e < 4; ++e) { const float a = bflo(w[e]), b = bfhi(w[e]); ss += a * a + b * b; }
  }
  ss += __shfl_xor(ss, 1);
  if (half == 0) rsA[row] = 1.0f / sqrtf(ss * (1.0f / KW) + 1e-6f);
}

DEVI void qup_tile(PR p, int rt, int h, char* lds) {
  float* Cs = (float*)lds;
  float* rsA = (float*)(lds + LDS_MISC);
  const bf16_t* Ab = p.proj0 + (size_t)rt * 256 * 1440;
  row_rms_scale<256>(Ab, 1440, rsA);
  f32x4 acc[4][3];
  gemm_mainloop<3>(acc, [&](int r) { return Ab + (size_t)r * 1440; }, p.Wuqt + (size_t)h * 96 * 256, 256, 256, lds);
  acc_to_lds<3>(acc, Cs);
  const int row = get_tid() >> 1, half = get_tid() & 1;
  const int t = rt * 256 + row, b = t >> 11, s = t & 2047;
  const float rq = rsA[row];
  float v[48];
#pragma unroll
  for (int i = 0; i < 12; ++i) {
    const f32x4 c = *(const f32x4*)(Cs + row * 100 + half * 48 + i * 4);
    v[4 * i] = c[0] * rq; v[4 * i + 1] = c[1] * rq; v[4 * i + 2] = c[2] * rq; v[4 * i + 3] = c[3] * rq;
  }
  float ss = 0.f;
#pragma unroll
  for (int i = 0; i < 48; ++i) ss += v[i] * v[i];
  ss += __shfl_xor(ss, 1);
  const float rn = 1.0f / sqrtf(ss * (1.0f / 96.0f) + 1e-6f);
  const float osc = 0.10206207261596575f * LOG2E;
#pragma unroll
  for (int i = 0; i < 48; ++i) v[i] = v[i] * rn * p.mla_q_norm[half * 48 + i];
  if (half == 1) {
    const float fpos = (float)p.pos[t];
#pragma unroll
    for (int i = 0; i < 16; ++i) {
      float sn, cs; sincos_rev(fpos * p.inv_freq[i], sn, cs);
      const float x1 = v[16 + i], x2 = v[32 + i];
      v[16 + i] = x1 * cs - x2 * sn; v[32 + i] = x1 * sn + x2 * cs;
    }
  }
  bf16_t* dst = p.Q0 + ((size_t)(b * 8 + h) * 2048 + s) * 96 + half * 48;
#pragma unroll
  for (int i = 0; i < 6; ++i) {
    u32x4 w;
    w[0] = pack2(v[8 * i] * osc, v[8 * i + 1] * osc); w[1] = pack2(v[8 * i + 2] * osc, v[8 * i + 3] * osc);
    w[2] = pack2(v[8 * i + 4] * osc, v[8 * i + 5] * osc); w[3] = pack2(v[8 * i + 6] * osc, v[8 * i + 7] * osc);
    *(u32x4*)(dst + i * 8) = w;
  }
  __syncthreads();
}

DEVI void kvup_tile(PR p, int rt, int h, char* lds) {
  float* Cs = (float*)lds;
  float* rsA = (float*)(lds + LDS_MISC);
  const bf16_t* Ab = p.proj0 + (size_t)rt * 256 * 1440 + 256;
  row_rms_scale<128>(Ab, 1440, rsA);
  f32x4 acc[4][4];
  gemm_mainloop<4>(acc, [&](int r) { return Ab + (size_t)r * 1440; }, p.Wukvt + (size_t)h * 128 * 128, 128, 128, lds);
  acc_to_lds<4>(acc, Cs);
  const int row = get_tid() >> 1, half = get_tid() & 1;
  const int t = rt * 256 + row, b = t >> 11, s = t & 2047;
  const float rkv = rsA[row];
  if (half == 0) {
    float kr[32];
    const bf16_t* rp = p.proj0 + (size_t)t * 1440 + 384;
#pragma unroll
    for (int i = 0; i < 4; ++i) {
      const u32x4 w = *(const u32x4*)(rp + i * 8);
#pragma unroll
      for (int e = 0; e < 4; ++e) { kr[8 * i + 2 * e] = bflo(w[e]); kr[8 * i + 2 * e + 1] = bfhi(w[e]); }
    }
    float ss = 0.f;
#pragma unroll
    for (int i = 0; i < 32; ++i) ss += kr[i] * kr[i];
#pragma unroll
    for (int i = 0; i < 16; ++i) {
      const f32x4 c = *(const f32x4*)(Cs + row * 132 + i * 4);
#pragma unroll
      for (int e = 0; e < 4; ++e) { const float a = c[e] * rkv; ss += a * a; }
    }
    const float rn = 1.0f / sqrtf(ss * (1.0f / 96.0f) + 1e-6f);
    bf16_t* dst = p.K0 + ((size_t)(b * 8 + h) * 2048 + s) * 96;
#pragma unroll
    for (int i = 0; i < 8; ++i) {
      const f32x4 c0 = *(const f32x4*)(Cs + row * 132 + i * 8);
      const f32x4 c1 = *(const f32x4*)(Cs + row * 132 + i * 8 + 4);
      const float4 g0 = *(const float4*)(p.mla_k_norm + i * 8);
      const float4 g1 = *(const float4*)(p.mla_k_norm + i * 8 + 4);
      const float f = rkv * rn;
      u32x4 w;
      w[0] = pack2(c0[0] * f * g0.x, c0[1] * f * g0.y); w[1] = pack2(c0[2] * f * g0.z, c0[3] * f * g0.w);
      w[2] = pack2(c1[0] * f * g1.x, c1[1] * f * g1.y); w[3] = pack2(c1[2] * f * g1.z, c1[3] * f * g1.w);
      *(u32x4*)(dst + i * 8) = w;
    }
#pragma unroll
    for (int i = 0; i < 32; ++i) kr[i] = kr[i] * rn * p.mla_k_norm[64 + i];
    const float fpos = (float)p.pos[t];
#pragma unroll
    for (int i = 0; i < 16; ++i) {
      float sn, cs; sincos_rev(fpos * p.inv_freq[i], sn, cs);
      const float x1 = kr[i], x2 = kr[16 + i];
      kr[i] = x1 * cs - x2 * sn; kr[16 + i] = x1 * sn + x2 * cs;
    }
#pragma unroll
    for (int i = 0; i < 4; ++i) {
      u32x4 w;
      w[0] = pack2(kr[8 * i], kr[8 * i + 1]); w[1] = pack2(kr[8 * i + 2], kr[8 * i + 3]);
      w[2] = pack2(kr[8 * i + 4], kr[8 * i + 5]); w[3] = pack2(kr[8 * i + 6], kr[8 * i + 7]);
      *(u32x4*)(dst + 64 + i * 8) = w;
    }
  } else {
    bf16_t* dst = p.V0t + ((size_t)(b * 8 + h) * 64) * 2048 + s;
#pragma unroll
    for (int i = 0; i < 16; ++i) {
      const f32x4 c = *(const f32x4*)(Cs + row * 132 + 64 + i * 4);
#pragma unroll
      for (int e = 0; e < 4; ++e) dst[(size_t)(i * 4 + e) * 2048] = f2bf(c[e] * rkv);
    }
  }
  __syncthreads();
}

DEVI void conv_tile(PR p, int tile, char* lds, int tid) {
  const int lane = tid & 63, wid = tid >> 6;
  const int b = tile >> 6, t0 = (tile & 63) * 32;
  unsigned* glu = (unsigned*)lds;
#pragma unroll 1
  for (int i0 = 0; i0 < 62; i0 += 16) {
    unsigned av[16], gv[16];
#pragma unroll
    for (int k = 0; k < 16; ++k) {
      const int i = i0 + k; const int tt = max(t0 - 30 + i, 0);
      const bf16_t* rp = p.proj0 + (size_t)(b * 2048 + tt) * 1440;
      av[k] = (i < 62) ? *(const unsigned*)(rp + 416 + 2 * tid) : 0u;
      gv[k] = (i < 62) ? *(const unsigned*)(rp + 928 + 2 * tid) : 0u;
    }
#pragma unroll
    for (int k = 0; k < 16; ++k) {
      const int i = i0 + k;
      const unsigned a = av[k], g = gv[k];
      const unsigned w = (t0 - 30 + i >= 0) ? pack2(bflo(a) * sigmoidf_(bflo(g)), bfhi(a) * sigmoidf_(bfhi(g))) : 0u;
      if (i < 62) glu[i * 256 + tid] = w;
    }
  }
  __syncthreads();
  float y0[32], y1[32];
  {
    const float2 bb = *(const float2*)(p.conv_dw_b + 2 * tid);
#pragma unroll
    for (int t = 0; t < 32; ++t) { y0[t] = bb.x; y1[t] = bb.y; }
  }
  {
    float2 w[31];
#pragma unroll
    for (int j = 0; j < 31; ++j) w[j] = *(const float2*)(p.conv_dw_w + j * 512 + 2 * tid);
#pragma unroll
    for (int i = 0; i < 62; ++i) {
      const unsigned g2 = glu[i * 256 + tid];
      const float lo = bflo(g2), hi = bfhi(g2);
#pragma unroll
      for (int t = (i > 30 ? i - 30 : 0); t <= (i < 31 ? i : 31); ++t) { y0[t] += w[i - t].x * lo; y1[t] += w[i - t].y * hi; }
    }
  }
  __syncthreads();
  float* ys = (float*)lds;
#pragma unroll
  for (int t = 0; t < 32; ++t) *(float2*)(ys + t * 516 + 2 * tid) = make_float2(y0[t], y1[t]);
  __syncthreads();
  for (int k = 0; k < 8; ++k) {
    const int tl = wid * 8 + k;
    const f32x4 a0 = *(const f32x4*)(ys + tl * 516 + lane * 8);
    const f32x4 a1 = *(const f32x4*)(ys + tl * 516 + lane * 8 + 4);
    float v[8] = {a0[0], a0[1], a0[2], a0[3], a1[0], a1[1], a1[2], a1[3]};
    float sm = 0.f;
#pragma unroll
    for (int e = 0; e < 8; ++e) sm += v[e];
    const float mu = wave_sum(sm) * (1.0f / 512.0f);
    float sq = 0.f;
#pragma unroll
    for (int e = 0; e < 8; ++e) { v[e] -= mu; sq += v[e] * v[e]; }
    const float rstd = 1.0f / sqrtf(wave_sum(sq) * (1.0f / 512.0f) + 1e-5f);
    const float4 g0 = *(const float4*)(p.conv_ln_g + lane * 8), g1 = *(const float4*)(p.conv_ln_g + lane * 8 + 4);
    const float4 b0 = *(const float4*)(p.conv_ln_b + lane * 8), b1 = *(const float4*)(p.conv_ln_b + lane * 8 + 4);
    const float gg[8] = {g0.x, g0.y, g0.z, g0.w, g1.x, g1.y, g1.z, g1.w};
    const float bb[8] = {b0.x, b0.y, b0.z, b0.w, b1.x, b1.y, b1.z, b1.w};
    float o[8];
#pragma unroll
    for (int e = 0; e < 8; ++e) { const float z = v[e] * rstd * gg[e] + bb[e]; o[e] = z * sigmoidf_(z); }
    u32x4 w; w[0] = pack2(o[0], o[1]); w[1] = pack2(o[2], o[3]); w[2] = pack2(o[4], o[5]); w[3] = pack2(o[6], o[7]);
    *(u32x4*)(p.hn + (size_t)(b * 2048 + t0 + tl) * 1024 + 512 + lane * 8) = w;
  }
  __syncthreads();
}

DEVI void l0_phase2(PR p, char* lds) {
  XcdIter xi; xi.init();
  for (int n = xi.lb; n < 320; n += xi.nlb) {
    if (n < 128) qup_tile(p, xi.xcd * 16 + (n >> 3), n & 7, lds);
    else if (n < 256) kvup_tile(p, xi.xcd * 16 + ((n - 128) >> 3), (n - 128) & 7, lds);
    else conv_tile(p, xi.xcd * 128 + (n - 256) * 2 + (get_tid() >> 8), lds + (get_tid() >> 8) * 73728, get_tid() & 255);
  }
}

template <int NKS, int KSTR>
DEVI void qk_tile(const char* Ks, const bf16x8 (&qf)[2][NKS], f32x4 (&s)[4][2], int fr, int fq) {
#pragma unroll
  for (int kt = 0; kt < 4; ++kt) {
    s[kt][0] = (f32x4){0.f, 0.f, 0.f, 0.f}; s[kt][1] = (f32x4){0.f, 0.f, 0.f, 0.f};
#pragma unroll
    for (int ks = 0; ks < NKS; ++ks) {
      const bf16x8 a = *(const bf16x8*)(Ks + (kt * 16 + fr) * KSTR + ks * 64 + fq * 16);
      s[kt][0] = __builtin_amdgcn_mfma_f32_16x16x32_bf16(a, qf[0][ks], s[kt][0], 0, 0, 0);
      s[kt][1] = __builtin_amdgcn_mfma_f32_16x16x32_bf16(a, qf[1][ks], s[kt][1], 0, 0, 0);
    }
  }
}
template <int VSTR>
DEVI void pv_tile(const char* Vs, const f32x4 (&pr)[4][2], f32x4 (&o)[4][2], int fr, int fq) {
#pragma unroll
  for (int u = 0; u < 2; ++u) {
    bf16x8 bfr[2];
#pragma unroll
    for (int qt = 0; qt < 2; ++qt) {
      u32x4 w;
      w[0] = pack2(pr[2 * u][qt][0], pr[2 * u][qt][1]); w[1] = pack2(pr[2 * u][qt][2], pr[2 * u][qt][3]);
      w[2] = pack2(pr[2 * u + 1][qt][0], pr[2 * u + 1][qt][1]); w[3] = pack2(pr[2 * u + 1][qt][2], pr[2 * u + 1][qt][3]);
      bfr[qt] = __builtin_bit_cast(bf16x8, w);
    }
#pragma unroll
    for (int dt = 0; dt < 4; ++dt) {
      const char* vp = Vs + (dt * 16 + fr) * VSTR + (32 * u + 4 * fq) * 2;
      const u32x2 lo = *(const u32x2*)(vp);
      const u32x2 hi = *(const u32x2*)(vp + 32);
      const u32x4 aw = (u32x4){lo[0], lo[1], hi[0], hi[1]};
      const bf16x8 a = __builtin_bit_cast(bf16x8, aw);
      o[dt][0] = __builtin_amdgcn_mfma_f32_16x16x32_bf16(a, bfr[0], o[dt][0], 0, 0, 0);
      o[dt][1] = __builtin_amdgcn_mfma_f32_16x16x32_bf16(a, bfr[1], o[dt][1], 0, 0, 0);
    }
  }
}
DEVI void softmax_update(f32x4 (&s)[4][2], float (&m)[2], float (&l)[2], f32x4 (&o)[4][2]) {
#pragma unroll
  for (int qt = 0; qt < 2; ++qt) {
    float mx = NEGBIG;
#pragma unroll
    for (int kt = 0; kt < 4; ++kt)
#pragma unroll
      for (int j = 0; j < 4; ++j) mx = fmaxf(mx, s[kt][qt][j]);
    mx = fmaxf(mx, __shfl_xor(mx, 16)); mx = fmaxf(mx, __shfl_xor(mx, 32));
    const float mn = fmaxf(m[qt], mx);
    const float alpha = fast_exp2(m[qt] - mn);
    m[qt] = mn;
    const float mnc = fmaxf(mn, -1e29f);
    float rsum = 0.f;
#pragma unroll
    for (int kt = 0; kt < 4; ++kt)
#pragma unroll
      for (int j = 0; j < 4; ++j) {
        const float pv = fast_exp2(s[kt][qt][j] - mnc);
        s[kt][qt][j] = pv; rsum += pv;
      }
    l[qt] = l[qt] * alpha + rsum;
#pragma unroll
    for (int dt = 0; dt < 4; ++dt) { o[dt][qt][0] *= alpha; o[dt][qt][1] *= alpha; o[dt][qt][2] *= alpha; o[dt][qt][3] *= alpha; }
  }
}

DEVI void exp_accum(f32x4 (&s)[4][2], float (&l)[2]) {
#pragma unroll
  for (int qt = 0; qt < 2; ++qt) {
    float rsum = 0.f;
#pragma unroll
    for (int kt = 0; kt < 4; ++kt)
#pragma unroll
      for (int j = 0; j < 4; ++j) { const float pv = fast_exp2(s[kt][qt][j]); s[kt][qt][j] = pv; rsum += pv; }
    l[qt] += rsum;
  }
}

DEVI unsigned bf_hi_bits(float v) { return pack2(v, 0.f) & 0xffffu; }
DEVI float bf_round(float v) { return __uint_as_float(bf_hi_bits(v) << 16); }
template <int NKS, int KSTR>
DEVI void qk_tile_aug(const char* Ks, const char* Kaug, const bf16x8 (&qf)[2][NKS], const bf16x8 (&qa)[2], f32x4 (&s)[4][2], int fr, int fq) {
#pragma unroll
  for (int kt = 0; kt < 4; ++kt) {
    s[kt][0] = (f32x4){0.f, 0.f, 0.f, 0.f}; s[kt][1] = (f32x4){0.f, 0.f, 0.f, 0.f};
#pragma unroll
    for (int ks = 0; ks < NKS; ++ks) {
      const bf16x8 a = *(const bf16x8*)(Ks + (kt * 16 + fr) * KSTR + ks * 64 + fq * 16);
      s[kt][0] = __builtin_amdgcn_mfma_f32_16x16x32_bf16(a, qf[0][ks], s[kt][0], 0, 0, 0);
      s[kt][1] = __builtin_amdgcn_mfma_f32_16x16x32_bf16(a, qf[1][ks], s[kt][1], 0, 0, 0);
    }
    u32x4 aw = *(const u32x4*)(Kaug + (kt * 16 + fr) * 16);
    if (fq != 0) aw = (u32x4){0u, 0u, 0u, 0u};
    const bf16x8 a = __builtin_bit_cast(bf16x8, aw);
    s[kt][0] = __builtin_amdgcn_mfma_f32_16x16x32_bf16(a, qa[0], s[kt][0], 0, 0, 0);
    s[kt][1] = __builtin_amdgcn_mfma_f32_16x16x32_bf16(a, qa[1], s[kt][1], 0, 0, 0);
  }
}
DEVI bf16x8 make_qaug(float slope2, float colc, int fq) {
  const float sh = bf_round(slope2), sl = slope2 - sh;
  const float c1 = bf_round(colc), r1 = colc - c1, c2 = bf_round(r1), c3 = r1 - c2;
  u32x4 w;
  w[0] = pack2(sh, sh); w[1] = pack2(sl, sl); w[2] = pack2(c1, c2); w[3] = pack2(c3, 0.f);
  if (fq != 0) w = (u32x4){0u, 0u, 0u, 0u};
  return __builtin_bit_cast(bf16x8, w);
}
DEVI u32x4 make_kaug(float v) {
  const float ph = bf_round(v), pl = v - ph;
  u32x4 w; w[0] = pack2(ph, pl); w[1] = pack2(ph, pl); w[2] = 0x3f803f80u; w[3] = 0x00003f80u;
  return w;
}
DEVI void exp_tile(f32x4 (&s)[4][2]) {
#pragma unroll
  for (int kt = 0; kt < 4; ++kt)
#pragma unroll
    for (int qt = 0; qt < 2; ++qt)
#pragma unroll
      for (int j = 0; j < 4; ++j) s[kt][qt][j] = fast_exp2(s[kt][qt][j]);
}
template <int VSTR>
DEVI void pv_tile_l(const char* Vs, const f32x4 (&pr)[4][2], f32x4 (&o)[4][2], f32x4 (&ol)[2], int fr, int fq) {
  const u32x4 onesw = (u32x4){0x3f803f80u, 0x3f803f80u, 0x3f803f80u, 0x3f803f80u};
  const bf16x8 ones = __builtin_bit_cast(bf16x8, onesw);
#pragma unroll
  for (int u = 0; u < 2; ++u) {
    bf16x8 bfr[2];
#pragma unroll
    for (int qt = 0; qt < 2; ++qt) {
      u32x4 w;
      w[0] = pack2(pr[2 * u][qt][0], pr[2 * u][qt][1]); w[1] = pack2(pr[2 * u][qt][2], pr[2 * u][qt][3]);
      w[2] = pack2(pr[2 * u + 1][qt][0], pr[2 * u + 1][qt][1]); w[3] = pack2(pr[2 * u + 1][qt][2], pr[2 * u + 1][qt][3]);
      bfr[qt] = __builtin_bit_cast(bf16x8, w);
    }
#pragma unroll
    for (int dt = 0; dt < 4; ++dt) {
      const char* vp = Vs + (dt * 16 + fr) * VSTR + (32 * u + 4 * fq) * 2;
      const u32x2 lo = *(const u32x2*)(vp);
      const u32x2 hi = *(const u32x2*)(vp + 32);
      const u32x4 aw = (u32x4){lo[0], lo[1], hi[0], hi[1]};
      const bf16x8 a = __builtin_bit_cast(bf16x8, aw);
      o[dt][0] = __builtin_amdgcn_mfma_f32_16x16x32_bf16(a, bfr[0], o[dt][0], 0, 0, 0);
      o[dt][1] = __builtin_amdgcn_mfma_f32_16x16x32_bf16(a, bfr[1], o[dt][1], 0, 0, 0);
    }
    ol[0] = __builtin_amdgcn_mfma_f32_16x16x32_bf16(ones, bfr[0], ol[0], 0, 0, 0);
    ol[1] = __builtin_amdgcn_mfma_f32_16x16x32_bf16(ones, bfr[1], ol[1], 0, 0, 0);
  }
}

DEVI float head8_sum(float v) {
  v += __builtin_bit_cast(float, __builtin_amdgcn_update_dpp(0, __builtin_bit_cast(int, v), 0xB1, 0xF, 0xF, true));
  v += __builtin_bit_cast(float, __builtin_amdgcn_update_dpp(0, __builtin_bit_cast(int, v), 0x4E, 0xF, 0xF, true));
  v += __builtin_bit_cast(float, __builtin_amdgcn_update_dpp(0, __builtin_bit_cast(int, v), 0x141, 0xF, 0xF, true));
  return v;
}

DEVI void rowsum_tile(const f32x4 (&pr)[4][2], f32x4 (&ol)[2]) {
  const u32x4 onesw = (u32x4){0x3f803f80u, 0x3f803f80u, 0x3f803f80u, 0x3f803f80u};
  const bf16x8 ones = __builtin_bit_cast(bf16x8, onesw);
#pragma unroll
  for (int u = 0; u < 2; ++u)
#pragma unroll
    for (int qt = 0; qt < 2; ++qt) {
      u32x4 w;
      w[0] = pack2(pr[2 * u][qt][0], pr[2 * u][qt][1]); w[1] = pack2(pr[2 * u][qt][2], pr[2 * u][qt][3]);
      w[2] = pack2(pr[2 * u + 1][qt][0], pr[2 * u + 1][qt][1]); w[3] = pack2(pr[2 * u + 1][qt][2], pr[2 * u + 1][qt][3]);
      ol[qt] = __builtin_amdgcn_mfma_f32_16x16x32_bf16(ones, __builtin_bit_cast(bf16x8, w), ol[qt], 0, 0, 0);
    }
}

DEVI void mla_attn_phase(PR p, char* lds) {
  constexpr int KSTR = 208, VSTR = 144;
  const int tid = get_tid(), lane = tid & 63, wid = tid >> 6, fr = lane & 15, fq = lane >> 4;
  XcdIter xi; xi.init();
  for (int n = xi.lb; n < 128; n += xi.nlb) {
    __syncthreads();
    const int r = n >> 5, li = n & 31, jq = li & 7;
    const int bh = xi.xcd * 16 + r * 4 + (li >> 3);
    const int j4 = (jq + 4) & 7;
    const int qt256 = (r == 0) ? jq : (r == 1) ? 7 - jq : (r == 2) ? j4 : 7 - j4;
    const int q0 = qt256 * 256 + wid * 32;
    const bf16_t* Qb = p.Q0 + (size_t)bh * 2048 * 96;
    const bf16_t* Kb = p.K0 + (size_t)bh * 2048 * 96;
    const bf16_t* Vb = p.V0t + (size_t)bh * 64 * 2048;
    bf16x8 qf[2][3];
#pragma unroll
    for (int qt = 0; qt < 2; ++qt)
#pragma unroll
      for (int ks = 0; ks < 3; ++ks) qf[qt][ks] = *(const bf16x8*)(Qb + (size_t)(q0 + 16 * qt + fr) * 96 + ks * 32 + fq * 8);
    f32x4 o[4][2]; f32x4 ol[2];
    ol[0] = (f32x4){0.f, 0.f, 0.f, 0.f}; ol[1] = (f32x4){0.f, 0.f, 0.f, 0.f};
#pragma unroll
    for (int dt = 0; dt < 4; ++dt) { o[dt][0] = (f32x4){0.f, 0.f, 0.f, 0.f}; o[dt][1] = (f32x4){0.f, 0.f, 0.f, 0.f}; }
    const int nkt = 4 * (qt256 + 1);
    u32x4 rk[2], rv;
    const int kr0 = tid / 12, kc0 = tid - kr0 * 12;
    const int kq1 = (tid < 256) ? tid + 512 : tid;
    const int kr1 = kq1 / 12, kc1 = kq1 - kr1 * 12;
    const int vr0 = tid >> 3, vc0 = tid & 7;
    auto fetch = [&](int key0) {
      rk[0] = *(const u32x4*)(Kb + (size_t)(key0 + kr0) * 96 + kc0 * 8);
      rk[1] = *(const u32x4*)(Kb + (size_t)(key0 + kr1) * 96 + kc1 * 8);
      rv = *(const u32x4*)(Vb + (size_t)vr0 * 2048 + key0 + vc0 * 8);
    };
    fetch(0);
    for (int kt64 = 0; kt64 < nkt; ++kt64) {
      const int key0 = kt64 * 64;
      char* Kc = lds + (kt64 & 1) * 22528; char* Vc = Kc + 64 * KSTR;
      *(u32x4*)(Kc + kr0 * KSTR + kc0 * 16) = rk[0];
      *(u32x4*)(Kc + kr1 * KSTR + kc1 * 16) = rk[1];
      *(u32x4*)(Vc + vr0 * VSTR + vc0 * 16) = rv;
      __syncthreads();
      if (kt64 + 1 < nkt) fetch(key0 + 64);
      if (key0 <= q0 + 31) {
        f32x4 s[4][2];
        qk_tile<3, KSTR>(Kc, qf, s, fr, fq);
        if (key0 + 63 > q0) {
#pragma unroll
          for (int kt = 0; kt < 4; ++kt)
#pragma unroll
            for (int qt = 0; qt < 2; ++qt)
#pragma unroll
              for (int j = 0; j < 4; ++j) {
                const int key = key0 + 16 * kt + 4 * fq + j, qq = q0 + 16 * qt + fr;
                if (key > qq) s[kt][qt][j] = NEGBIG;
              }
        }
        exp_tile(s);
        pv_tile_l<VSTR>(Vc, s, o, ol, fr, fq);
      }
    }
    const int b = bh >> 3, h = bh & 7;
#pragma unroll
    for (int qt = 0; qt < 2; ++qt) {
      const float inv = 1.0f / ol[qt][0];
      bf16_t* dst = p.hn + (size_t)(b * 2048 + q0 + 16 * qt + fr) * 1024 + h * 64 + 4 * fq;
#pragma unroll
      for (int dt = 0; dt < 4; ++dt) {
        u32x2 w; w[0] = pack2(o[dt][qt][0] * inv, o[dt][qt][1] * inv); w[1] = pack2(o[dt][qt][2] * inv, o[dt][qt][3] * inv);
        *(u32x2*)(dst + dt * 16) = w;
      }
    }
  }
  __syncthreads();
}

DEVI void router_phase(PR p, int layer, char* lds) {
  constexpr int WSTR = 528;
  char* Wh = lds;
  char* Wl = lds + 48 * WSTR;
  float* lg = (float*)(lds + 50688);
  float* ssL = (float*)(lds + 50688 + 24576);
  int* cntL = (int*)(lds + 50688 + 24576 + 512);
  int* baseL = cntL + 32;
  const int tid = get_tid(), lane = tid & 63, wid = tid >> 6, fr = lane & 15, fq = lane >> 4;
  const bf16_t* gWh = p.RWh + (size_t)layer * 48 * 1024;
  const bf16_t* gWl = p.RWl + (size_t)layer * 48 * 1024;
  int* gcnt = p.gcnt + layer * 32;
  for (int tile = blockIdx.x; tile < T_ / 128; tile += gridDim.x) {
    const int row = tile * 128 + wid * 16 + fr;
    const float* xrow = p.xr + (size_t)row * 1024;
    bf16_t* hrow = p.hn + (size_t)row * 1024;
    f32x4 acc[3]; acc[0] = acc[1] = acc[2] = (f32x4){0.f, 0.f, 0.f, 0.f};
    float ss = 0.f;
    if (tid < 32) cntL[tid] = 0;
    for (int kc = 0; kc < 4; ++kc) {
      float4 xq[16];
#pragma unroll
      for (int i = 0; i < 16; ++i) xq[i] = *(const float4*)(xrow + kc * 256 + (i >> 2) * 64 + fq * 16 + (i & 3) * 4);
      u32x4 wq[6];
#pragma unroll
      for (int i = 0; i < 3; ++i) {
        const int q = tid + 512 * i; const int n = q >> 5, c = q & 31;
        wq[i] = *(const u32x4*)(gWh + (size_t)n * 1024 + kc * 256 + c * 8);
        wq[3 + i] = *(const u32x4*)(gWl + (size_t)n * 1024 + kc * 256 + c * 8);
      }
      __syncthreads();
#pragma unroll
      for (int i = 0; i < 3; ++i) {
        const int q = tid + 512 * i; const int n = q >> 5, c = q & 31;
        *(u32x4*)(Wh + n * WSTR + c * 16) = wq[i];
        *(u32x4*)(Wl + n * WSTR + c * 16) = wq[3 + i];
      }
      __syncthreads();
#pragma unroll
      for (int s4 = 0; s4 < 4; ++s4) {
        const int kb = kc * 256 + s4 * 64 + fq * 16;
        float xv[16];
#pragma unroll
        for (int i = 0; i < 4; ++i) { const float4 v = xq[s4 * 4 + i]; xv[4 * i] = v.x; xv[4 * i + 1] = v.y; xv[4 * i + 2] = v.z; xv[4 * i + 3] = v.w; }
        unsigned xh[8], xl[8];
#pragma unroll
        for (int i = 0; i < 8; ++i) {
          ss += xv[2 * i] * xv[2 * i] + xv[2 * i + 1] * xv[2 * i + 1];
          xh[i] = pack2(xv[2 * i], xv[2 * i + 1]);
          xl[i] = pack2(xv[2 * i] - bflo(xh[i]), xv[2 * i + 1] - bfhi(xh[i]));
        }
        *(u32x4*)(hrow + kb) = (u32x4){xh[0], xh[1], xh[2], xh[3]};
        *(u32x4*)(hrow + kb + 8) = (u32x4){xh[4], xh[5], xh[6], xh[7]};
#pragma unroll
        for (int m = 0; m < 2; ++m) {
          const bf16x8 ah = __builtin_bit_cast(bf16x8, ((u32x4){xh[4 * m], xh[4 * m + 1], xh[4 * m + 2], xh[4 * m + 3]}));
          const bf16x8 al = __builtin_bit_cast(bf16x8, ((u32x4){xl[4 * m], xl[4 * m + 1], xl[4 * m + 2], xl[4 * m + 3]}));
          const int koff = (s4 * 64 + fq * 16 + 8 * m) * 2;
#pragma unroll
          for (int nt = 0; nt < 3; ++nt) {
            const bf16x8 bh = *(const bf16x8*)(Wh + (nt * 16 + fr) * WSTR + koff);
            const bf16x8 bl = *(const bf16x8*)(Wl + (nt * 16 + fr) * WSTR + koff);
            acc[nt] = __builtin_amdgcn_mfma_f32_16x16x32_bf16(ah, bh, acc[nt], 0, 0, 0);
            acc[nt] = __builtin_amdgcn_mfma_f32_16x16x32_bf16(ah, bl, acc[nt], 0, 0, 0);
            acc[nt] = __builtin_amdgcn_mfma_f32_16x16x32_bf16(al, bh, acc[nt], 0, 0, 0);
          }
        }
      }
    }
    ss += __shfl_xor(ss, 16); ss += __shfl_xor(ss, 32);
    if (fq == 0) ssL[wid * 16 + fr] = ss;
#pragma unroll
    for (int nt = 0; nt < 3; ++nt)
#pragma unroll
      for (int j = 0; j < 4; ++j) lg[(wid * 16 + 4 * fq + j) * 48 + nt * 16 + fr] = acc[nt][j];
    __syncthreads();
    int e0 = 0, e1 = 0, rk0 = 0, rk1 = 0; float w0 = 0.f, w1 = 0.f;
    const int tok = tile * 128 + tid;
    if (tid < 128) {
      const float r = 1.0f / sqrtf(ssL[tid] * (1.0f / 1024.0f) + 1e-6f);
      p.rs[tok] = r;
      const float* L = lg + tid * 48;
      float gl[4];
#pragma unroll
      for (int i = 0; i < 4; ++i) gl[i] = L[i] * r + p.r_group_b[layer * 4 + i];
      int grp = 0; float gm = gl[0];
#pragma unroll
      for (int i = 1; i < 4; ++i) if (gl[i] > gm) { gm = gl[i]; grp = i; }
      float gs = 0.f;
#pragma unroll
      for (int i = 0; i < 4; ++i) gs += expf(gl[i] - gm);
      const float gw = 1.0f / gs;
      float el[8];
#pragma unroll
      for (int i = 0; i < 8; ++i) el[i] = L[4 + grp * 8 + i] * r + p.r_expert_b[layer * 32 + grp * 8 + i];
      int i0 = 0; float v0 = el[0];
#pragma unroll
      for (int i = 1; i < 8; ++i) if (el[i] > v0) { v0 = el[i]; i0 = i; }
      int i1 = (i0 == 0) ? 1 : 0; float v1 = -3e38f;
#pragma unroll
      for (int i = 0; i < 8; ++i) if (i != i0 && el[i] > v1) { v1 = el[i]; i1 = i; }
      const float ex = expf(v1 - v0);
      w0 = gw / (1.0f + ex); w1 = gw * ex / (1.0f + ex);
      e0 = grp * 8 + i0; e1 = grp * 8 + i1;
      rk0 = atomicAdd(&cntL[e0], 1);
      rk1 = atomicAdd(&cntL[e1], 1);
    }
    __syncthreads();
    if (tid < 32) { const int c = cntL[tid]; baseL[tid] = c ? atomicAdd(&gcnt[tid], c) : 0; }
    __syncthreads();
    if (tid < 128) {
      const size_t s0 = (size_t)e0 * T_ + baseL[e0] + rk0, s1 = (size_t)e1 * T_ + baseL[e1] + rk1;
      p.row_tok[s0] = tok * 2;
      p.row_tok[s1] = tok * 2 + 1;
      const float rr = p.rs[tok];
      p.row_aux[s0] = make_float2(w0, rr);
      p.row_aux[s1] = make_float2(w1, rr);
    }
    __syncthreads();
  }
}

DEVI void moe_prefix(const int* gcnt, int* preL) {
  __syncthreads();
  if (get_tid() == 0) {
    int a = 0;
    for (int e = 0; e < 32; ++e) { preL[e] = a; a += (gcnt[e] + 255) >> 8; }
    preL[32] = a;
  }
  __syncthreads();
}
DEVI int find_expert(const int* preL, int rt) {
  int e = 0;
  for (int i = 1; i < 32; ++i) if (preL[i] <= rt) e = i;
  return e;
}

DEVI void moe_gateup_phase(PR p, int layer, char* lds) {
  int* preL = (int*)(lds + LDS_MISC + 1024);
  const int* gcnt = p.gcnt + layer * 32;
  moe_prefix(gcnt, preL);
  const int nrt = preL[32];
  float* Cs = (float*)lds;
  XcdIter xi; xi.init();
  const int rlo = (nrt * xi.xcd) >> 3, rhi = (nrt * (xi.xcd + 1)) >> 3;
  const int total = (rhi - rlo) * 4, G = xi.nlb;
  const int nfull_rounds = total / G, left = total - nfull_rounds * G;
  const bool split = (left > 0) && (2 * left <= G);
  const int nfull = split ? nfull_rounds * G : total;
  const int row = get_tid() >> 1, half = get_tid() & 1;
  for (int it = xi.lb; it < nfull + (split ? 2 * left : 0); it += G) {
    const bool ishalf = it >= nfull;
    const int item = ishalf ? nfull + ((it - nfull) >> 1) : it;
    const int ch = (it - nfull) & 1;
    const int rt = rlo + (item >> 2), j = item & 3;
    const int e = find_expert(preL, rt);
    const int blk = rt - preL[e];
    const int valid = min(256, gcnt[e] - blk * 256);
    const int* rtk = p.row_tok + (size_t)e * T_ + blk * 256;
    const float rsc = (row < valid) ? p.row_aux[(size_t)e * T_ + blk * 256 + row].y : 0.f;
    const bf16_t* Wb = p.Wgut + ((size_t)e * 512 + j * 128) * 1024;
    auto arow = [&](int r) { const int tok = (r < valid) ? (rtk[r] >> 1) : 0; return p.hn + (size_t)tok * 1024; };
    if (!ishalf) {
      f32x4 acc[4][4];
      gemm_mainloop<4>(acc, arow, Wb, 1024, 1024, lds);
      acc_to_lds<4>(acc, Cs);
      if (row < valid) {
        bf16_t* dst = p.hbuf + (size_t)(rt * 256 + row) * 256 + j * 64 + half * 32;
#pragma unroll
        for (int i = 0; i < 4; ++i) {
          float hv[8];
#pragma unroll
          for (int q = 0; q < 2; ++q) {
            const f32x4 g = *(const f32x4*)(Cs + row * 132 + half * 32 + i * 8 + q * 4);
            const f32x4 u = *(const f32x4*)(Cs + row * 132 + 64 + half * 32 + i * 8 + q * 4);
#pragma unroll
            for (int c = 0; c < 4; ++c) { const float gg = g[c] * rsc; hv[q * 4 + c] = gg * sigmoidf_(gg) * (u[c] * rsc); }
          }
          u32x4 w; w[0] = pack2(hv[0], hv[1]); w[1] = pack2(hv[2], hv[3]); w[2] = pack2(hv[4], hv[5]); w[3] = pack2(hv[6], hv[7]);
          *(u32x4*)(dst + i * 8) = w;
        }
      }
    } else {
      f32x4 acc[4][2];
      gemm_mainloop2<2>(acc, arow, [&](int r) { return Wb + (size_t)((r < 32) ? (32 * ch + r) : (64 + 32 * ch + (r - 32))) * 1024; }, 1024, lds);
      acc_to_lds<2>(acc, Cs);
      if (row < valid) {
        bf16_t* dst = p.hbuf + (size_t)(rt * 256 + row) * 256 + j * 64 + ch * 32 + half * 16;
#pragma unroll
        for (int i = 0; i < 2; ++i) {
          float hv[8];
#pragma unroll
          for (int q = 0; q < 2; ++q) {
            const f32x4 g = *(const f32x4*)(Cs + row * 68 + half * 16 + i * 8 + q * 4);
            const f32x4 u = *(const f32x4*)(Cs + row * 68 + 32 + half * 16 + i * 8 + q * 4);
#pragma unroll
            for (int c = 0; c < 4; ++c) { const float gg = g[c] * rsc; hv[q * 4 + c] = gg * sigmoidf_(gg) * (u[c] * rsc); }
          }
          u32x4 w; w[0] = pack2(hv[0], hv[1]); w[1] = pack2(hv[2], hv[3]); w[2] = pack2(hv[4], hv[5]); w[3] = pack2(hv[6], hv[7]);
          *(u32x4*)(dst + i * 8) = w;
        }
      }
    }
    __syncthreads();
  }
}

DEVI void moe_down_phase(PR p, int layer, char* lds) {
  int* preL = (int*)(lds + LDS_MISC + 1024);
  int* tabA = (int*)(lds + LDS_MISC + 2048);
  float* tabW = (float*)(lds + LDS_MISC + 3072);
  const int* gcnt = p.gcnt + layer * 32;
  moe_prefix(gcnt, preL);
  const int nrt = preL[32];
  float* Cs = (float*)lds;
  XcdIter xi; xi.init();
  const int rlo = (nrt * xi.xcd) >> 3, rhi = (nrt * (xi.xcd + 1)) >> 3;
  for (int it = xi.lb; it < (rhi - rlo) * 8; it += xi.nlb) {
    const int rt = rlo + (it >> 3), j = it & 7;
    const int e = find_expert(preL, rt);
    const int blk = rt - preL[e];
    const int valid = min(256, gcnt[e] - blk * 256);
    const int tid = get_tid();
    int a_r = 0; float w_r = 0.f;
    if (tid < valid) { a_r = p.row_tok[(size_t)e * T_ + blk * 256 + tid]; w_r = p.row_aux[(size_t)e * T_ + blk * 256 + tid].x; }
    f32x4 acc[4][4];
    const bf16_t* Ab = p.hbuf + (size_t)rt * 256 * 256;
    gemm_mainloop<4>(acc, [&](int r) { return Ab + (size_t)r * 256; }, p.Wdt + ((size_t)e * 1024 + j * 128) * 256, 256, 256, lds);
    if (tid < 256) { tabA[tid] = a_r; tabW[tid] = w_r; }
    acc_to_lds<4>(acc, Cs);
    const int c4 = tid & 31, r0 = tid >> 5;
#pragma unroll
    for (int i = 0; i < 16; ++i) {
      const int row = r0 + 16 * i;
      if (row < valid) {
        const int a = tabA[row];
        const float w = tabW[row];
        const f32x4 v = *(const f32x4*)(Cs + row * 132 + c4 * 4);
        u32x2 o; o[0] = pack2(v[0] * w, v[1] * w); o[1] = pack2(v[2] * w, v[3] * w);
        *(u32x2*)(p.ybuf + (size_t)a * 1024 + j * 128 + c4 * 4) = o;
      }
    }
    __syncthreads();
  }
}

DEVI void final_phase(PR p) {
  rownorm_phase(p.xr, p.ybuf, nullptr, p.out, nullptr);
}

DEVI void nsa_proj_phase(PR p, char* lds) {
  float* Cs = (float*)lds;
  XcdIter xi; xi.init();
  for (int n = xi.lb; n < 16 * 15; n += xi.nlb) {
    const int grp = n / 80, rem = n - grp * 80;
    const int rl = rem / 5, jn = grp * 5 + (rem - rl * 5);
    const int rt = xi.xcd * 16 + rl;
    f32x4 acc[4][4];
    const bf16_t* Ab = p.hn + (size_t)rt * 256 * 1024;
    gemm_mainloop<4>(acc, [&](int r) { return Ab + (size_t)r * 1024; }, p.W5t + (size_t)jn * 128 * 1024, 1024, 1024, lds);
    acc_to_lds<4>(acc, Cs);
    const int row = get_tid() >> 1, half = get_tid() & 1;
    const int t = rt * 256 + row, b = t >> 11, s = t & 2047;
    const float* cr = Cs + row * 132 + half * 64;
    if (jn == 14) {
      if (half == 0) {
#pragma unroll
        for (int i = 0; i < 12; ++i) {
          const f32x4 c = *(const f32x4*)(cr + i * 4);
          *(float4*)(p.GATES + (size_t)t * 48 + i * 4) = make_float4(sigmoidf_(c[0]), sigmoidf_(c[1]), sigmoidf_(c[2]), sigmoidf_(c[3]));
        }
      }
    } else if (jn == 11 || jn == 13) {
      bf16_t* dst = (jn == 11 ? p.VSt : p.VWt) + ((size_t)(b * 2 + half) * 64) * 2048 + s;
#pragma unroll
      for (int i = 0; i < 16; ++i) {
        const f32x4 c = *(const f32x4*)(cr + i * 4);
#pragma unroll
        for (int e = 0; e < 4; ++e) dst[(size_t)(i * 4 + e) * 2048] = f2bf(c[e]);
      }
    } else {
      const float* gn = nullptr; bf16_t* dst; float osc = 1.0f;
      if (jn < 8) { gn = p.nsa_q_norm; dst = p.Q1 + ((size_t)(b * 16 + jn * 2 + half) * 2048 + s) * 64; osc = 0.125f * LOG2E; }
      else {
        bf16_t* base = (jn == 8) ? p.KC : (jn == 9) ? p.VC : (jn == 10) ? p.KS : p.KW;
        if (jn == 10) gn = p.nsa_k_norm_slc; else if (jn == 12) gn = p.nsa_k_norm_win;
        dst = base + ((size_t)(b * 2 + half) * 2048 + s) * 64;
      }
      float rn = 1.0f;
      if (gn) {
        float ss = 0.f;
#pragma unroll
        for (int i = 0; i < 16; ++i) { const f32x4 c = *(const f32x4*)(cr + i * 4); ss += c[0] * c[0] + c[1] * c[1] + c[2] * c[2] + c[3] * c[3]; }
        rn = osc / sqrtf(ss * (1.0f / 64.0f) + 1e-6f);
      }
#pragma unroll
      for (int i = 0; i < 8; ++i) {
        const f32x4 c0 = *(const f32x4*)(cr + i * 8), c1 = *(const f32x4*)(cr + i * 8 + 4);
        float4 g0 = make_float4(1.f, 1.f, 1.f, 1.f), g1 = g0;
        if (gn) { g0 = *(const float4*)(gn + i * 8); g1 = *(const float4*)(gn + i * 8 + 4); }
        u32x4 w;
        w[0] = pack2(c0[0] * rn * g0.x, c0[1] * rn * g0.y); w[1] = pack2(c0[2] * rn * g0.z, c0[3] * rn * g0.w);
        w[2] = pack2(c1[0] * rn * g1.x, c1[1] * rn * g1.y); w[3] = pack2(c1[2] * rn * g1.z, c1[3] * rn * g1.w);
        *(u32x4*)(dst + i * 8) = w;
      }
    }
    __syncthreads();
  }
}

DEVI void compress_phase(PR p, char* lds) {
  const int tid = get_tid(), lane = tid & 63, wid = tid >> 6, wr = wid >> 1, wc = wid & 1, fr = lane & 15, fq = lane >> 4;
  for (int it = blockIdx.x; it < 32; it += gridDim.x) {
    const int kv = it >> 4, pr = it & 15;
    const bf16_t* base = (kv ? p.VC : p.KC) + (size_t)(2 * pr) * 2048 * 64;
    const bf16_t* W1 = kv ? p.Wc1vt : p.Wc1kt;
    const bf16_t* W2 = kv ? p.Wc2vt : p.Wc2kt;
    const float* bias = p.bias1 + kv * 128;
    f32x4 acc[4][4];
    gemm_mainloop<4>(acc, [&](int r) { return base + (size_t)(r >> 7) * 2048 * 64 + (size_t)min(r & 127, 126) * 1024; }, W1, 2048, 2048, lds);
#pragma unroll
    for (int m = 0; m < 4; ++m)
#pragma unroll
      for (int n = 0; n < 4; ++n)
#pragma unroll
        for (int j = 0; j < 4; ++j) {
          const int row = wr * 64 + m * 16 + fq * 4 + j, col = wc * 64 + n * 16 + fr;
          const float xv = acc[m][n][j] + bias[col];
          const float u2 = 1.5957691216057308f * (xv + 0.044715f * xv * xv * xv);
          const float hv = xv * sigmoidf_(u2);
          const int c = col & 63;
          *(bf16_t*)(lds + (col >> 6) * 32768 + swz(row, c >> 3) + (c & 7) * 2) = f2bf(hv);
        }
#pragma unroll
    for (int i = 0; i < 2; ++i) {
      const int q = tid + 512 * i; const int r = q >> 4, c16 = q & 15;
      *(u32x4*)(lds + 65536 + (c16 >> 3) * 8192 + swz(r, c16 & 7)) = *(const u32x4*)(W2 + (size_t)r * 128 + c16 * 8);
    }
    __syncthreads();
    f32x4 a2[4][2];
#pragma unroll
    for (int m = 0; m < 4; ++m) { a2[m][0] = (f32x4){0.f, 0.f, 0.f, 0.f}; a2[m][1] = (f32x4){0.f, 0.f, 0.f, 0.f}; }
#pragma unroll
    for (int ktile = 0; ktile < 2; ++ktile) mma_stage<2>(lds + ktile * 32768, lds + 65536 + ktile * 8192, a2, wr, wc, fr, fq);
    __syncthreads();
    float* C2 = (float*)lds;
#pragma unroll
    for (int m = 0; m < 4; ++m)
#pragma unroll
      for (int n = 0; n < 2; ++n)
#pragma unroll
        for (int j = 0; j < 4; ++j) C2[(wr * 64 + m * 16 + fq * 4 + j) * 68 + wc * 32 + n * 16 + fr] = a2[m][n][j];
    __syncthreads();
    const int row = tid >> 1, half = tid & 1;
    const int bg = 2 * pr + (row >> 7), rr = row & 127;
    float v[32];
#pragma unroll
    for (int i = 0; i < 8; ++i) { const f32x4 c = *(const f32x4*)(C2 + row * 68 + half * 32 + i * 4); v[4 * i] = c[0]; v[4 * i + 1] = c[1]; v[4 * i + 2] = c[2]; v[4 * i + 3] = c[3]; }
    if (kv == 0) {
      float ss = 0.f;
#pragma unroll
      for (int i = 0; i < 32; ++i) ss += v[i] * v[i];
      ss += __shfl_xor(ss, 1);
      const float rn = (rr < 127) ? 1.0f / sqrtf(ss * (1.0f / 64.0f) + 1e-6f) : 0.f;
      bf16_t* dst = p.KCMP + ((size_t)bg * 128 + rr) * 64 + half * 32;
#pragma unroll
      for (int i = 0; i < 4; ++i) {
        u32x4 w;
#pragma unroll
        for (int e = 0; e < 4; ++e) { const int c = 8 * i + 2 * e; w[e] = pack2(v[c] * rn * p.nsa_k_norm_cmp[half * 32 + c], v[c + 1] * rn * p.nsa_k_norm_cmp[half * 32 + c + 1]); }
        *(u32x4*)(dst + i * 8) = w;
      }
    } else {
      const float z = (rr < 127) ? 1.0f : 0.f;
      bf16_t* dst = p.VCMPt + ((size_t)bg * 64 + half * 32) * 128 + rr;
#pragma unroll
      for (int i = 0; i < 32; ++i) dst[(size_t)i * 128] = f2bf(v[i] * z);
    }
    __syncthreads();
  }
}

DEVI void nsa_attn_phase(PR p, char* lds) {
  constexpr int STR = 144, STG = 19456;
  constexpr int OSTR = 136;
  const int tid = get_tid(), lane = tid & 63, wid = tid >> 6, fr = lane & 15, fq = lane >> 4;
  float* Ptok = (float*)(lds + 2 * STG);
  unsigned* maskL = (unsigned*)(lds + 2 * STG + 16384);
  char* Ot = lds + 2 * STG + 16384 + 128;
  float cbound;
  {
    float gq = fabsf(p.nsa_q_norm[lane]);
    float gk = fmaxf(fabsf(p.nsa_k_norm_cmp[lane]), fmaxf(fabsf(p.nsa_k_norm_slc[lane]), fabsf(p.nsa_k_norm_win[lane])));
#pragma unroll
    for (int m = 32; m >= 1; m >>= 1) { gq = fmaxf(gq, __shfl_xor(gq, m)); gk = fmaxf(gk, __shfl_xor(gk, m)); }
    cbound = 8.0f * LOG2E * gq * gk * 1.01f;
  }
  XcdIter xi; xi.init();
  for (int n = xi.lb; n < 256; n += xi.nlb) {
    const int bg = xi.xcd * 4 + (n >> 6), b = bg >> 1, g = bg & 1;
    const int tl64 = n & 63;
    const int t0 = (((n >> 5) & 1) ? (63 - (tl64 & 31)) : (tl64 & 31)) * 32;
    const int head = fr & 7;
    const int hg = g * 8 + head;
    const int pbase = p.pos[b * 2048 + t0];
    int tq[2]; float colc[2]; bf16x8 qf[2][2]; bf16x8 qa[2]; float gate[3][2];
    const float slope2 = exp2f(-0.5f * (float)(hg + 1)) * LOG2E;
#pragma unroll
    for (int qt = 0; qt < 2; ++qt) {
      tq[qt] = t0 + 4 * wid + 2 * qt + (fr >> 3);
      colc[qt] = -slope2 * (float)(p.pos[b * 2048 + tq[qt]] - pbase) - cbound;
      qa[qt] = make_qaug(slope2, colc[qt], fq);
      const bf16_t* qp = p.Q1 + ((size_t)(b * 16 + hg) * 2048 + tq[qt]) * 64;
      qf[qt][0] = *(const bf16x8*)(qp + fq * 8);
      qf[qt][1] = *(const bf16x8*)(qp + 32 + fq * 8);
      const float* gp = p.GATES + (size_t)(b * 2048 + tq[qt]) * 48 + hg;
      gate[0][qt] = gp[0]; gate[1][qt] = gp[16]; gate[2][qt] = gp[32];
    }
    char* orow[2];
#pragma unroll
    for (int qt = 0; qt < 2; ++qt) orow[qt] = Ot + (32 * wid + 16 * qt + fr) * OSTR + 8 * fq;
    auto out_acc = [&](const f32x4 (&o)[4][2], float f0, float f1, bool first) {
#pragma unroll
      for (int qt = 0; qt < 2; ++qt) {
        const float f = qt ? f1 : f0;
#pragma unroll
        for (int dt = 0; dt < 4; ++dt) {
          float a0 = o[dt][qt][0] * f, a1 = o[dt][qt][1] * f, a2 = o[dt][qt][2] * f, a3 = o[dt][qt][3] * f;
          if (!first) {
            const u32x2 w = *(const u32x2*)(orow[qt] + dt * 32);
            a0 += bflo(w[0]); a1 += bfhi(w[0]); a2 += bflo(w[1]); a3 += bfhi(w[1]);
          }
          u32x2 r; r[0] = pack2(a0, a1); r[1] = pack2(a2, a3);
          *(u32x2*)(orow[qt] + dt * 32) = r;
        }
      }
    };

    u32x4 rk, rv; int rpos = 0;
    const int sr = tid >> 3, sc = tid & 7;
    auto fetch = [&](const bf16_t* Kg, const bf16_t* Vg, int vstride, const int* posg, int pstride, int pmax) {
      rk = *(const u32x4*)(Kg + (size_t)sr * 64 + sc * 8);
      rv = *(const u32x4*)(Vg + (size_t)sr * vstride + sc * 8);
      if (tid < 64) rpos = posg[min(tid * pstride, pmax)];
    };
    auto commit = [&](int st) {
      char* Ks = lds + st * STG; char* Vs = Ks + 9216;
      *(u32x4*)(Ks + sr * 144 + sc * 16) = rk;
      *(u32x4*)(Vs + sr * 144 + sc * 16) = rv;
      if (tid < 64) *(u32x4*)(Ks + 18432 + tid * 16) = make_kaug((float)(rpos - pbase));
    };
    auto fetch_win = [&](int key0) { PR q = *get_params(); fetch(q.KW + ((size_t)bg * 2048 + key0) * 64, q.VWt + (size_t)bg * 64 * 2048 + key0, 2048, q.pos + b * 2048 + key0, 1, 63); };
    auto fetch_slc = [&](int key0) { PR q = *get_params(); fetch(q.KS + ((size_t)bg * 2048 + key0) * 64, q.VSt + (size_t)bg * 64 * 2048 + key0, 2048, q.pos + b * 2048 + key0, 1, 63); };
    auto fetch_cmp = [&](int tile) { PR q = *get_params(); fetch(q.KCMP + ((size_t)bg * 128 + tile * 64) * 64, q.VCMPt + (size_t)bg * 64 * 128 + tile * 64, 128,
                                                                    q.pos + b * 2048 + 1024 * tile + 31, 16, 2047 - 1024 * tile - 31); };

    int stw;
    {
      __syncthreads();
      f32x4 o[4][2], ol[2];
      ol[0] = (f32x4){0.f, 0.f, 0.f, 0.f}; ol[1] = (f32x4){0.f, 0.f, 0.f, 0.f};
#pragma unroll
      for (int dt = 0; dt < 4; ++dt) { o[dt][0] = (f32x4){0.f, 0.f, 0.f, 0.f}; o[dt][1] = (f32x4){0.f, 0.f, 0.f, 0.f}; }
      const int kfirst = max(0, t0 - 255) >> 6, klast = t0 >> 6;
      stw = (klast - kfirst) & 1;
      fetch_win(kfirst * 64);
      for (int k64 = kfirst; k64 <= klast; ++k64) {
        const int key0 = k64 * 64;
        const int st = (k64 - kfirst) & 1;
        commit(st);
        __syncthreads();
        if (k64 < klast) fetch_win(key0 + 64); else fetch_cmp(0);
        const char* Kc = lds + st * STG;
        f32x4 s[4][2];
        qk_tile_aug<2, STR>(Kc, Kc + 18432, qf, qa, s, fr, fq);
        if (key0 < t0 + 31 - 255 || key0 + 63 > t0) {
#pragma unroll
          for (int kt = 0; kt < 4; ++kt)
#pragma unroll
            for (int j = 0; j < 4; ++j) {
              const int key = key0 + 16 * kt + 4 * fq + j;
#pragma unroll
              for (int qt = 0; qt < 2; ++qt) {
                const unsigned rel = (unsigned)(tq[qt] - key);
                s[kt][qt][j] = (rel < 256u) ? s[kt][qt][j] : NEGBIG;
              }
            }
        }
        exp_tile(s);
        pv_tile_l<STR>(Kc + 9216, s, o, ol, fr, fq);
      }
      {
        const float l0 = ol[0][0], l1 = ol[1][0];
        out_acc(o, (l0 > 0.f) ? gate[2][0] / l0 : 0.f, (l1 > 0.f) ? gate[2][1] / l1 : 0.f, true);
      }
    }

    {
      const int clim[2] = {(tq[0] - 31) >> 4, (tq[1] - 31) >> 4};
      const int sA = stw ^ 1, sB = stw;
      f32x4 ol[2];
      ol[0] = (f32x4){0.f, 0.f, 0.f, 0.f}; ol[1] = (f32x4){0.f, 0.f, 0.f, 0.f};
#pragma unroll
      for (int tl2 = 0; tl2 < 2; ++tl2) {
        const int st = tl2 ? sB : sA;
        commit(st);
        __syncthreads();
        if (tl2 == 0) fetch_cmp(1); else fetch_slc(0);
        f32x4 s[4][2];
        qk_tile_aug<2, STR>(lds + st * STG, lds + st * STG + 18432, qf, qa, s, fr, fq);
#pragma unroll
        for (int kt = 0; kt < 4; ++kt)
#pragma unroll
          for (int j = 0; j < 4; ++j) {
            const int c0 = tl2 * 64 + 16 * kt + 4 * fq + j;
#pragma unroll
            for (int qt = 0; qt < 2; ++qt) s[kt][qt][j] = fast_exp2((c0 <= clim[qt]) ? s[kt][qt][j] : NEGBIG);
          }
        rowsum_tile(s, ol);
      }
      float linv[2];
#pragma unroll
      for (int qt = 0; qt < 2; ++qt) { const float r = ol[qt][0]; linv[qt] = (r > 0.f) ? 1.0f / r : 0.f; }
      f32x4 o[4][2];
#pragma unroll
      for (int dt = 0; dt < 4; ++dt) { o[dt][0] = (f32x4){0.f, 0.f, 0.f, 0.f}; o[dt][1] = (f32x4){0.f, 0.f, 0.f, 0.f}; }
#pragma unroll
      for (int tl2 = 0; tl2 < 2; ++tl2) {
        const int st = tl2 ? sB : sA;
        f32x4 s[4][2];
        qk_tile_aug<2, STR>(lds + st * STG, lds + st * STG + 18432, qf, qa, s, fr, fq);
#pragma unroll
        for (int kt = 0; kt < 4; ++kt)
#pragma unroll
          for (int j = 0; j < 4; ++j) {
            const int c0 = tl2 * 64 + 16 * kt + 4 * fq + j;
#pragma unroll
            for (int qt = 0; qt < 2; ++qt) s[kt][qt][j] = fast_exp2((c0 <= clim[qt]) ? s[kt][qt][j] : NEGBIG);
          }
        pv_tile<STR>(lds + st * STG + 9216, s, o, fr, fq);
#pragma unroll
        for (int qt = 0; qt < 2; ++qt) {
          const int tl = 4 * wid + 2 * qt + (fr >> 3);
#pragma unroll
          for (int kt = 0; kt < 4; ++kt) {
            f32x4 hs;
#pragma unroll
            for (int j = 0; j < 4; ++j) hs[j] = head8_sum(s[kt][qt][j] * linv[qt]);
            if (head == 0) *(f32x4*)(Ptok + tl * 128 + tl2 * 64 + 16 * kt + 4 * fq) = hs;
          }
        }
      }
      out_acc(o, gate[0][0] * linv[0], gate[0][1] * linv[1], false);
      __syncthreads();
      const int cur = t0 >> 6;
      const int j = tid & 31;
#pragma unroll
      for (int i = 0; i < 2; ++i) {
        const int tl = (tid >> 5) + 16 * i;
        float im = 0.f;
        for (int c = max(4 * j - 1, 0); c <= 4 * j + 3; ++c) im += Ptok[tl * 128 + c];
        const bool forced = (j == 0) || (j == cur) || (j == cur - 1);
        const float v = forced ? 1e4f : ((j <= cur) ? im : -1.0f);
        unsigned key = ((v < 0.f) ? 0u : (__float_as_uint(v) | 0x80000000u));
        key = (key & ~31u) | (unsigned)(31 - j);
        bool sel = false;
#pragma unroll
        for (int rnd = 0; rnd < 8; ++rnd) {
          unsigned m = key;
          m = max(m, (unsigned)__builtin_amdgcn_update_dpp(0, (int)m, 0xB1, 0xF, 0xF, true));
          m = max(m, (unsigned)__builtin_amdgcn_update_dpp(0, (int)m, 0x4E, 0xF, 0xF, true));
          m = max(m, (unsigned)__builtin_amdgcn_update_dpp(0, (int)m, 0x141, 0xF, 0xF, true));
          m = max(m, (unsigned)__builtin_amdgcn_update_dpp(0, (int)m, 0x140, 0xF, 0xF, true));
          m = max(m, (unsigned)__shfl_xor((int)m, 16));
          const bool win = (key == m);
          sel = sel || win;
          key = win ? 0u : key;
        }
        const unsigned long long bal = __ballot(sel);
        if (j == 0) maskL[tl] = (unsigned)(bal >> (lane & 32));
      }
      __syncthreads();
    }

    {
      const int cur = t0 >> 6;
      const unsigned curmask = (cur >= 31) ? 0xffffffffu : ((2u << cur) - 1u);
      unsigned um = 0u;
#pragma unroll
      for (int i = 0; i < 32; ++i) um |= maskL[i];
      um &= curmask;
      unsigned mq[2];
#pragma unroll
      for (int qt = 0; qt < 2; ++qt) mq[qt] = maskL[4 * wid + 2 * qt + (fr >> 3)];
      const unsigned wm = (maskL[4 * wid] | maskL[4 * wid + 1] | maskL[4 * wid + 2] | maskL[4 * wid + 3]) & curmask;
      f32x4 o[4][2], ol[2];
      ol[0] = (f32x4){0.f, 0.f, 0.f, 0.f}; ol[1] = (f32x4){0.f, 0.f, 0.f, 0.f};
#pragma unroll
      for (int dt = 0; dt < 4; ++dt) { o[dt][0] = (f32x4){0.f, 0.f, 0.f, 0.f}; o[dt][1] = (f32x4){0.f, 0.f, 0.f, 0.f}; }
      unsigned rem = um;
      for (int step = 0; rem != 0u; ++step) {
        const int jb = __builtin_ctz(rem); rem &= rem - 1u;
        const int key0 = jb * 64;
        const int st = step & 1;
        commit(st);
        __syncthreads();
        if (rem != 0u) fetch_slc(__builtin_ctz(rem) * 64);
        if ((wm >> jb) & 1u) {
          const char* Kc = lds + st * STG;
          f32x4 s[4][2];
          bf16x8 qs[2];
          qs[0] = make_qaug(slope2, ((mq[0] >> jb) & 1u) ? colc[0] : NEGBIG, fq);
          qs[1] = make_qaug(slope2, ((mq[1] >> jb) & 1u) ? colc[1] : NEGBIG, fq);
          qk_tile_aug<2, STR>(Kc, Kc + 18432, qf, qs, s, fr, fq);
          {
#pragma unroll
            for (int kt = 0; kt < 4; ++kt)
#pragma unroll
              for (int j = 0; j < 4; ++j) {
                const int key = key0 + 16 * kt + 4 * fq + j;
#pragma unroll
                for (int qt = 0; qt < 2; ++qt) s[kt][qt][j] = (key <= tq[qt]) ? s[kt][qt][j] : NEGBIG;
              }
          }
          exp_tile(s);
          pv_tile_l<STR>(Kc + 9216, s, o, ol, fr, fq);
        }
      }
      {
        const float l0 = ol[0][0], l1 = ol[1][0];
        out_acc(o, (l0 > 0.f) ? gate[1][0] / l0 : 0.f, (l1 > 0.f) ? gate[1][1] / l1 : 0.f, false);
      }
    }
    {
      const int c16 = lane & 7;
#pragma unroll
      for (int i = 0; i < 4; ++i) {
        const int r = (lane >> 3) + 8 * i;
        const int tok = t0 + 4 * wid + 2 * (r >> 4) + ((r & 15) >> 3), hh = g * 8 + (r & 7);
        const char* src = Ot + (32 * wid + r) * OSTR + c16 * 16;
        const u32x2 lo = *(const u32x2*)(src), hi = *(const u32x2*)(src + 8);
        *(u32x4*)(p.hn + (size_t)(b * 2048 + tok) * 1024 + hh * 64 + c16 * 8) = (u32x4){lo[0], lo[1], hi[0], hi[1]};
      }
    }
    __syncthreads();
  }
}

DEVI void misc_init(PR p) {
  if (blockIdx.x >= gridDim.x - 5 && blockIdx.x < gridDim.x - 1) {
    const int part = blockIdx.x - (gridDim.x - 5);
    const int layer = part >> 1, k = (part & 1) * 512 + get_tid();
    const float g = p.norm_ffn[layer * 1024 + k];
    for (int n = 0; n < 48; ++n) {
      float w = 0.f;
      if (n < 4) w = p.r_group[((size_t)layer * 1024 + k) * 4 + n];
      else if (n < 36) w = p.r_expert[((size_t)layer * 1024 + k) * 32 + (n - 4)];
      w *= g;
      const float hi = bf_round(w);
      p.RWh[((size_t)layer * 48 + n) * 1024 + k] = f2bf(hi);
      p.RWl[((size_t)layer * 48 + n) * 1024 + k] = f2bf(w - hi);
    }
  }
  if (blockIdx.x == gridDim.x - 1) {
    const int tid = get_tid();
    if (tid < 64) p.gcnt[tid] = 0;
    if (tid < 256) {
      const int kv = tid >> 7, n = tid & 127;
      const float* pe = kv ? p.cmp_pe_v : p.cmp_pe_k;
      const float* w1 = kv ? p.cmp_w1_v : p.cmp_w1_k;
      float a = 0.f;
      for (int i = 0; i < 2048; ++i) a += pe[i] * w1[(size_t)i * 128 + n];
      p.bias1[tid] = a;
    }
  }
}


#define XB_TMO      128
#define XB_XCNT(j)  (256  + 64 * (j))
#define XB_XSUB(j)  (1280 + 64 * (j))
#define XB_XGEN(j)  (2304 + 64 * (j))
#define XB_TOP      3328
#define XB_TOPGEN   3392
#define XCD_BAR_WORDS 3456
#define XB_SPIN_CAP (1u << 20)
#define LAS __attribute__((address_space(3)))
DEVI unsigned xb_ld(unsigned* p) { return __hip_atomic_load(p, __ATOMIC_RELAXED, __HIP_MEMORY_SCOPE_AGENT); }
DEVI unsigned xb_add(unsigned* p, unsigned v) { return __hip_atomic_fetch_add(p, v, __ATOMIC_RELAXED, __HIP_MEMORY_SCOPE_AGENT); }
DEVI unsigned xb_xcc_id() { return (unsigned)__builtin_amdgcn_s_getreg((3 << 11) | 20) & 0xFu; }
#define XB_SPIN(cond, bar) do { unsigned _sp = 0; while (cond) { __builtin_amdgcn_s_sleep(1); \
    if ((++_sp & 255u) == 0u) { if (xb_ld(&(bar)[XB_TMO])) break; if (_sp > XB_SPIN_CAP) { atomicAdd(&(bar)[XB_TMO], 1u); break; } } } } while (0)
struct XcdBarrier { unsigned* bar; unsigned x; volatile LAS unsigned* st; };
DEVI XcdBarrier xcd_barrier_post(unsigned* bar, volatile LAS unsigned* st) {
  XcdBarrier b; b.bar = bar; b.x = xb_xcc_id(); b.st = st;
  if (threadIdx.x == 0) (void)xb_add(&bar[XB_XCNT(b.x)], 1u);
  return b;
}
DEVI void xcd_barrier_complete(unsigned* bar, unsigned x, unsigned& nloc, unsigned& nx) {
  const unsigned G = gridDim.x * gridDim.y * gridDim.z;
  unsigned sum, cnt, mine, sp = 0u;
  for (;;) {
    sum = 0u; cnt = 0u; mine = 0u;
#pragma unroll
    for (unsigned j = 0; j < 16; ++j) { const unsigned c = xb_ld(&bar[XB_XCNT(j)]); sum += c; cnt += (c > 0u) ? 1u : 0u; mine = (j == x) ? c : mine; }
    if (sum == G) break;
    __builtin_amdgcn_s_sleep(1);
    if ((++sp & 255u) == 0u) { if (xb_ld(&bar[XB_TMO])) break; if (sp > XB_SPIN_CAP) { atomicAdd(&bar[XB_TMO], 1u); break; } }
  }
  nloc = mine > 0u ? mine : 1u; nx = cnt > 0u ? cnt : 1u;
}
DEVI void xcd_barrier(const XcdBarrier& b) {
  asm volatile("s_waitcnt vmcnt(0)" ::: "memory");
  __syncthreads();
  if (threadIdx.x == 0) {
    unsigned* bar = b.bar;
    __builtin_amdgcn_s_waitcnt(0);
    unsigned nloc = b.st[0], nx = b.st[1];
    if (nloc == 0u) { xcd_barrier_complete(bar, b.x, nloc, nx); b.st[0] = nloc; b.st[1] = nx; }
    const unsigned old = xb_add(&bar[XB_XSUB(b.x)], 1u);
    const unsigned gen = old / nloc;
    if (old + 1u == (gen + 1u) * nloc) {
      __builtin_amdgcn_fence(__ATOMIC_RELEASE, "agent");
      asm volatile("s_waitcnt vmcnt(0)" ::: "memory");
      const unsigned og = xb_add(&bar[XB_TOP], 1u);
      const unsigned tg = og / nx;
      if (og + 1u == (tg + 1u) * nx) xb_add(&bar[XB_TOPGEN], 1u);
      else XB_SPIN(xb_ld(&bar[XB_TOPGEN]) == tg, bar);
      __builtin_amdgcn_fence(__ATOMIC_ACQUIRE, "agent");
      xb_add(&bar[XB_XGEN(b.x)], 1u);
      asm volatile("s_waitcnt vmcnt(0)" ::: "memory");
    } else {
      XB_SPIN(xb_ld(&bar[XB_XGEN(b.x)]) == gen, bar);
      __builtin_amdgcn_fence(__ATOMIC_ACQUIRE, "agent");
      asm volatile("s_waitcnt vmcnt(0)" ::: "memory");
    }
  }
  __syncthreads();
}

#ifndef PROBE_PHASE
#define PROBE_PHASE -1
#endif
#define GSYNC() do { if (use_cg) grid.sync(); else xcd_barrier(xb); } while (0)
__global__ void __launch_bounds__(512, 2) mega_kernel(Params p_unused) {
  extern __shared__ __attribute__((aligned(16))) char lds[];
  cg::grid_group grid = cg::this_grid();
  volatile LAS unsigned* xst = (volatile LAS unsigned*)(lds + LDS_BYTES - 16);
  if (threadIdx.x == 0) { xst[0] = 0u; xst[1] = 0u; }
  __syncthreads();
  unsigned* barw; int use_cg;
  { PR p = *get_params(); barw = p.bar; use_cg = p.use_cg; }
  const XcdBarrier xb = xcd_barrier_post(barw, xst);
  { PR p = *get_params(); conv_weights_phase(p, 0, p.njobsA, p.ntilesA, lds); }
  { PR p = *get_params(); rownorm_phase(p.x, nullptr, p.norm_mix, nullptr, p.hn); }
  { PR p = *get_params(); misc_init(p); }
  GSYNC();
#if PROBE_PHASE == 0
  { PR p = *get_params(); conv_weights_phase(p, 0, p.njobsA, p.ntilesA, lds); }
  { PR p = *get_params(); rownorm_phase(p.x, nullptr, p.norm_mix, nullptr, p.hn); }
  GSYNC();
#endif
  { PR p = *get_params(); gemm_bf16out_phase(p.hn, 1024, p.W1t, 1024, 12, p.proj0, 1440, 1440, lds); }
  { PR p = *get_params(); conv_weights_phase(p, p.njobsA, p.njobs0, p.ntiles0, lds); }
  GSYNC();
#if PROBE_PHASE == 1
  { PR p = *get_params(); gemm_bf16out_phase(p.hn, 1024, p.W1t, 1024, 12, p.proj0, 1440, 1440, lds); }
  GSYNC();
#endif
  { PR p = *get_params(); l0_phase2(p, lds); }
  GSYNC();
#if PROBE_PHASE == 2
  { PR p = *get_params(); l0_phase2(p, lds); }
  GSYNC();
#endif
  { PR p = *get_params(); mla_attn_phase(p, lds); }
  GSYNC();
#if PROBE_PHASE == 3
  { PR p = *get_params(); mla_attn_phase(p, lds); }
  GSYNC();
#endif
  { PR p = *get_params(); gemm_resid_phase(p.hn, p.Wo0t, p.x, p.xr, lds); }
  GSYNC();
#if PROBE_PHASE == 4
  { PR p = *get_params(); gemm_resid_phase(p.hn, p.Wo0t, p.x, p.xr, lds); }
  GSYNC();
#endif
#if PROBE_PHASE == 5
  { PR p = *get_params(); router_phase(p, 1, lds); }
  GSYNC();
  { PR p = *get_params(); if (blockIdx.x == 0 && threadIdx.x < 32) p.gcnt[32 + threadIdx.x] = 0; }
#endif
  { PR p = *get_params(); router_phase(p, 0, lds); }
  GSYNC();
  { PR p = *get_params(); moe_gateup_phase(p, 0, lds); }
  GSYNC();
#if PROBE_PHASE == 6
  { PR p = *get_params(); moe_gateup_phase(p, 0, lds); }
  GSYNC();
#endif
  { PR p = *get_params(); moe_down_phase(p, 0, lds); }
  GSYNC();
#if PROBE_PHASE == 7
  { PR p = *get_params(); moe_down_phase(p, 0, lds); }
  GSYNC();
#endif
  { PR p = *get_params(); rownorm_phase(p.xr, p.ybuf, p.norm_mix + 1024, p.xr, p.hn); }
  GSYNC();
  { PR p = *get_params(); nsa_proj_phase(p, lds); }
  GSYNC();
#if PROBE_PHASE == 9
  { PR p = *get_params(); nsa_proj_phase(p, lds); }
  GSYNC();
#endif
  { PR p = *get_params(); compress_phase(p, lds); }
  { PR p = *get_params(); conv_weights_phase(p, p.njobs1_begin, p.njobs1_begin + 3, p.ntiles1, lds); }
  GSYNC();
#if PROBE_PHASE == 10
  { PR p = *get_params(); compress_phase(p, lds); }
  GSYNC();
#endif
  { PR p = *get_params(); nsa_attn_phase(p, lds); }
  GSYNC();
#if PROBE_PHASE == 11
  { PR p = *get_params(); nsa_attn_phase(p, lds); }
  GSYNC();
#endif
  { PR p = *get_params(); gemm_resid_phase(p.hn, p.Wo1t, p.xr, p.xr, lds); }
  GSYNC();
  { PR p = *get_params(); router_phase(p, 1, lds); }
  GSYNC();
  { PR p = *get_params(); moe_gateup_phase(p, 1, lds); }
  GSYNC();
  { PR p = *get_params(); moe_down_phase(p, 1, lds); }
  GSYNC();
  { PR p = *get_params(); final_phase(p); }
}

static inline size_t align_up(size_t v, size_t a) { return (v + a - 1) / a * a; }

extern "C" void kernel_launch(void* const* d_in, const int* in_sizes, int n_in, void* d_out, int out_size, void* d_ws, size_t ws_size,
                              hipStream_t stream) {
  (void)in_sizes; (void)n_in; (void)out_size;
  Params p;
  memset(&p, 0, sizeof(p));
  const float* const* in = (const float* const*)d_in;
  p.x = in[0]; p.pos = (const int*)d_in[1]; p.norm_mix = in[2]; p.norm_ffn = in[3];
  const float* mix0_w_in = in[4]; const float* mla_q_a_norm = in[5]; const float* mla_w_uq = in[6];
  const float* mla_kv_a_norm = in[7]; const float* mla_w_ukv = in[8];
  p.mla_q_norm = in[9]; p.mla_k_norm = in[10];
  p.conv_dw_w = in[11]; p.conv_dw_b = in[12]; p.conv_ln_g = in[13]; p.conv_ln_b = in[14];
  const float* mix0_w_out = in[15]; const float* nsa_w_in = in[16];
  p.nsa_q_norm = in[17]; p.nsa_k_norm_cmp = in[18]; p.nsa_k_norm_slc = in[19]; p.nsa_k_norm_win = in[20];
  p.cmp_pe_k = in[21]; p.cmp_w1_k = in[22]; const float* cmp_w2_k = in[23];
  p.cmp_pe_v = in[24]; p.cmp_w1_v = in[25]; const float* cmp_w2_v = in[26];
  const float* nsa_w_out = in[27];
  p.r_group = in[28]; p.r_group_b = in[29]; p.r_expert = in[30]; p.r_expert_b = in[31];
  const float* w_gate = in[32]; const float* w_up = in[33]; const float* w_down = in[34];
  p.out = (float*)d_out;

  char* ws = (char*)d_ws; size_t off = 0;
  auto take = [&](size_t bytes) { char* r = ws + off; off = align_up(off + bytes, 256); return r; };
  p.W1t = (bf16_t*)take((size_t)1536 * 1024 * 2);
  p.Wuqt = (bf16_t*)take((size_t)768 * 256 * 2);
  p.Wukvt = (bf16_t*)take((size_t)1024 * 128 * 2);
  p.Wo0t = (bf16_t*)take((size_t)1024 * 1024 * 2);
  p.W5t = (bf16_t*)take((size_t)1920 * 1024 * 2);
  p.Wc1kt = (bf16_t*)take((size_t)128 * 2048 * 2);
  p.Wc1vt = (bf16_t*)take((size_t)128 * 2048 * 2);
  p.Wc2kt = (bf16_t*)take((size_t)64 * 128 * 2);
  p.Wc2vt = (bf16_t*)take((size_t)64 * 128 * 2);
  p.Wo1t = (bf16_t*)take((size_t)1024 * 1024 * 2);
  p.Wgut = (bf16_t*)take((size_t)32 * 512 * 1024 * 2);
  p.Wdt = (bf16_t*)take((size_t)32 * 1024 * 256 * 2);
  p.xr = (float*)take((size_t)T_ * 1024 * 4);
  p.hn = (bf16_t*)take((size_t)T_ * 1024 * 2);
  p.RWh = (bf16_t*)take((size_t)2 * 48 * 1024 * 2);
  p.RWl = (bf16_t*)take((size_t)2 * 48 * 1024 * 2);
  p.rs = (float*)take((size_t)T_ * 4);
  p.row_aux = (float2*)take((size_t)32 * T_ * 8);
  p.row_tok = (int*)take((size_t)32 * T_ * 4);
  p.gcnt = (int*)take(256);
  p.bias1 = (float*)take(1024);
  p.bar = (unsigned*)take((size_t)XCD_BAR_WORDS * 4);
  p.use_cg = 0;
  p.KCMP = (bf16_t*)take((size_t)32 * 128 * 64 * 2);
  p.VCMPt = (bf16_t*)take((size_t)32 * 64 * 128 * 2);
  char* scr = ws + off;
  {
    size_t o = 0;
    auto tk = [&](size_t bytes) { char* r = scr + o; o = align_up(o + bytes, 256); return r; };
    p.proj0 = (bf16_t*)tk((size_t)T_ * 1440 * 2);
    p.Q0 = (bf16_t*)tk((size_t)T_ * 768 * 2);
    p.K0 = (bf16_t*)tk((size_t)T_ * 768 * 2);
    p.V0t = (bf16_t*)tk((size_t)T_ * 512 * 2);
  }
  {
    size_t o = 0;
    auto tk = [&](size_t bytes) { char* r = scr + o; o = align_up(o + bytes, 256); return r; };
    p.ybuf = (bf16_t*)tk((size_t)2 * T_ * 1024 * 2);
    p.hbuf = (bf16_t*)tk((size_t)(2 * T_ + 8192) * 256 * 2);
  }
  {
    size_t o = 0;
    auto tk = [&](size_t bytes) { char* r = scr + o; o = align_up(o + bytes, 256); return r; };
    p.Q1 = (bf16_t*)tk((size_t)T_ * 1024 * 2);
    p.KC = (bf16_t*)tk((size_t)T_ * 128 * 2);
    p.VC = (bf16_t*)tk((size_t)T_ * 128 * 2);
    p.KS = (bf16_t*)tk((size_t)T_ * 128 * 2);
    p.VSt = (bf16_t*)tk((size_t)T_ * 128 * 2);
    p.KW = (bf16_t*)tk((size_t)T_ * 128 * 2);
    p.VWt = (bf16_t*)tk((size_t)T_ * 128 * 2);
    p.GATES = (float*)tk((size_t)T_ * 48 * 4);
  }
  const size_t need = off + (size_t)T_ * (1440 + 768 + 768 + 512) * 2 + 4096;
  if (need > ws_size) { fprintf(stderr, "workspace too small: need %zu have %zu\n", need, ws_size); return; }
  for (int i = 0; i < 16; ++i) p.inv_freq[i] = (float)pow(10000.0, -(double)i / 16.0);

  int nj = 0, tiles = 0;
  auto add = [&](const float* src, bf16_t* dst, const float* gain, int K, int N, int Npad, int mode, int batch, long long ss, long long ds) {
    ConvJob& j = p.jobs[nj++];
    j.src = src; j.dst = dst; j.gain = gain; j.K = K; j.N = N; j.Npad = Npad; j.mode = mode; j.batch = batch; j.tile_start = tiles; j.pad0 = 0;
    j.sstride = ss; j.dstride = ds;
    tiles += batch * (K / 64) * (Npad / 64);
  };
  add(mix0_w_in, p.W1t, nullptr, 1024, 1440, 1536, 0, 1, 0, 0);
  add(mla_w_uq, p.Wuqt, mla_q_a_norm, 256, 768, 768, 0, 1, 0, 0);
  add(mla_w_ukv, p.Wukvt, mla_kv_a_norm, 128, 1024, 1024, 0, 1, 0, 0);
  add(mix0_w_out, p.Wo0t, nullptr, 1024, 1024, 1024, 0, 1, 0, 0);
  add(nsa_w_in, p.W5t, nullptr, 1024, 1840, 1920, 0, 1, 0, 0);
  add(p.cmp_w1_k, p.Wc1kt, nullptr, 2048, 128, 128, 0, 1, 0, 0);
  add(p.cmp_w1_v, p.Wc1vt, nullptr, 2048, 128, 128, 0, 1, 0, 0);
  add(cmp_w2_k, p.Wc2kt, nullptr, 128, 64, 64, 0, 1, 0, 0);
  add(cmp_w2_v, p.Wc2vt, nullptr, 128, 64, 64, 0, 1, 0, 0);
  add(nsa_w_out, p.Wo1t, nullptr, 1024, 1024, 1024, 0, 1, 0, 0);
  p.njobsA = nj; p.ntilesA = tiles;
  tiles = 0;
  add(w_gate, p.Wgut, p.norm_ffn, 1024, 256, 256, 1, 32, 1024LL * 256, 512LL * 1024);
  add(w_up, p.Wgut, p.norm_ffn, 1024, 256, 256, 2, 32, 1024LL * 256, 512LL * 1024);
  add(w_down, p.Wdt, nullptr, 256, 1024, 1024, 0, 32, 256LL * 1024, 1024LL * 256);
  p.njobs0 = nj; p.ntiles0 = tiles;
  p.njobs1_begin = nj;
  tiles = 0;
  const size_t l1 = (size_t)32 * 1024 * 256;
  add(w_gate + l1, p.Wgut, p.norm_ffn + 1024, 1024, 256, 256, 1, 32, 1024LL * 256, 512LL * 1024);
  add(w_up + l1, p.Wgut, p.norm_ffn + 1024, 1024, 256, 256, 2, 32, 1024LL * 256, 512LL * 1024);
  add(w_down + l1, p.Wdt, nullptr, 256, 1024, 1024, 0, 32, 256LL * 1024, 1024LL * 256);
  p.ntiles1 = tiles;

  static int grid_blocks = 0;
  if (!grid_blocks) {
    (void)hipFuncSetAttribute((const void*)mega_kernel, hipFuncAttributeMaxDynamicSharedMemorySize, LDS_BYTES);
    int dev = 0, cus = 0, per_cu = 0;
    (void)hipGetDevice(&dev);
    (void)hipDeviceGetAttribute(&cus, hipDeviceAttributeMultiprocessorCount, dev);
    (void)hipOccupancyMaxActiveBlocksPerMultiprocessor(&per_cu, mega_kernel, 512, LDS_BYTES);
    if (per_cu > 1) per_cu = 1;
    if (per_cu < 1) per_cu = 1;
    grid_blocks = cus * per_cu;
  }
  (void)hipMemsetAsync(p.bar, 0, (size_t)XCD_BAR_WORDS * 4, stream);
  void* args[] = {&p};
  hipError_t e = hipLaunchCooperativeKernel((const void*)mega_kernel, dim3(grid_blocks), dim3(512), args, LDS_BYTES, stream);
  if (e != hipSuccess) fprintf(stderr, "cooperative launch failed: %s (grid %d)\n", hipGetErrorString(e), grid_blocks);
}
```

```cpp
#include <hip/hip_runtime.h>
#include <hip/hip_cooperative_groups.h>
#include <stdint.h>
#include <math.h>
#include <stdio.h>
#include <string.h>
namespace cg = cooperative_groups;

typedef unsigned short bf16_t;
typedef short bf16x8 __attribute__((ext_vector_type(8)));
typedef float f32x4 __attribute__((ext_vector_type(4)));
typedef unsigned u32x4 __attribute__((ext_vector_type(4)));
typedef unsigned u32x2 __attribute__((ext_vector_type(2)));

#define DEVI __device__ __forceinline__
#define AS4 __attribute__((address_space(4)))

constexpr int T_ = 32768;
constexpr int S_ = 2048;
constexpr int LDS_BYTES = 73728;
constexpr float LOG2E = 1.4426950408889634f;
constexpr float NEGBIG = -1e30f;

struct ConvJob {
  const float* src; bf16_t* dst; const float* gain;
  int K, N, Npad, mode, batch, tile_start, pad0;
  long long sstride, dstride;
};
constexpr int MAXJOBS = 16;

struct Params {
  const float* x; const int* pos; const float* norm_mix; const float* norm_ffn;
  const float* mla_q_norm; const float* mla_k_norm;
  const float* conv_dw_w; const float* conv_dw_b; const float* conv_ln_g; const float* conv_ln_b;
  const float* nsa_q_norm; const float* nsa_k_norm_cmp; const float* nsa_k_norm_slc; const float* nsa_k_norm_win;
  const float* cmp_pe_k; const float* cmp_w1_k; const float* cmp_pe_v; const float* cmp_w1_v;
  const float* r_group; const float* r_group_b; const float* r_expert; const float* r_expert_b;
  float* out;
  bf16_t* W1t; bf16_t* Wuqt; bf16_t* Wukvt; bf16_t* Wo0t; bf16_t* W5t;
  bf16_t* Wc1kt; bf16_t* Wc1vt; bf16_t* Wc2kt; bf16_t* Wc2vt; bf16_t* Wo1t;
  bf16_t* Wgut; bf16_t* Wdt;
  bf16_t* xr;
  bf16_t* hn;
  bf16_t* proj0; bf16_t* Q0; bf16_t* K0; bf16_t* V0t;
  bf16_t* ybuf; bf16_t* hbuf;
  bf16_t* Q1; bf16_t* KC; bf16_t* VC; bf16_t* KS; bf16_t* VSt; bf16_t* KW; bf16_t* VWt; float* GATES;
  bf16_t* KCMP; bf16_t* VCMPt;
  bf16_t* RWh; bf16_t* RWl; float* rs; float2* row_aux; int* row_tok; int* gcnt; float* bias1; unsigned* bar;
  float inv_freq[16];
  ConvJob jobs[MAXJOBS];
  int njobs0, ntiles0, njobs1_begin, ntiles1, use_cg, njobsA, ntilesA, pad3;
};

typedef const AS4 Params& PR;
DEVI const AS4 Params* get_params() {
  const AS4 Params* kp = (const AS4 Params*)__builtin_amdgcn_kernarg_segment_ptr();
  asm volatile("" : "+s"(kp));
  return kp;
}

DEVI int get_tid() { int t = threadIdx.x; asm volatile("" : "+v"(t)); return t; }

typedef float f32x2_ __attribute__((ext_vector_type(2)));
typedef __bf16 bf16x2_ __attribute__((ext_vector_type(2)));
DEVI unsigned pack2(float lo, float hi) { const f32x2_ v = {lo, hi}; return __builtin_bit_cast(unsigned, __builtin_convertvector(v, bf16x2_)); }
DEVI float bflo(unsigned w) { return __uint_as_float(w << 16); }
DEVI float bfhi(unsigned w) { return __uint_as_float(w & 0xffff0000u); }
DEVI float bf2f(bf16_t h) { return __uint_as_float(((unsigned)h) << 16); }
DEVI bf16_t f2bf(float f) { return (bf16_t)(pack2(f, 0.f) & 0xffffu); }
DEVI float fast_exp2(float x) { return __builtin_amdgcn_exp2f(x); }
DEVI float fast_rcp(float x) { return __builtin_amdgcn_rcpf(x); }
DEVI float sigmoidf_(float x) { return fast_rcp(1.0f + fast_exp2(-x * LOG2E)); }
DEVI float wave_sum(float v) {
  v += __shfl_xor(v, 32); v += __shfl_xor(v, 16); v += __shfl_xor(v, 8);
  v += __shfl_xor(v, 4); v += __shfl_xor(v, 2); v += __shfl_xor(v, 1); return v;
}
DEVI void sincos_rev(float ang, float& s, float& c) {
  float rev = ang * 0.15915494309189535f;
  rev = rev - floorf(rev);
  s = __builtin_amdgcn_sinf(rev); c = __builtin_amdgcn_cosf(rev);
}

struct XcdIter {
  int xcd, lb, nlb;
  DEVI void init() { xcd = blockIdx.x & 7; lb = blockIdx.x >> 3; nlb = gridDim.x >> 3; }
};

DEVI int swz(int r, int c16) { return r * 128 + ((c16 ^ ((r >> 1) & 7)) << 4); }

template <int NT>
DEVI void mma_stage(const char* As, const char* Bs, f32x4 (&acc)[4][NT], int wr, int wc, int fr, int fq) {
  bf16x8 a[2][4], b[2][NT];
#pragma unroll
  for (int ks = 0; ks < 2; ++ks) {
#pragma unroll
    for (int m = 0; m < 4; ++m) a[ks][m] = *(const bf16x8*)(As + swz(wr * 64 + m * 16 + fr, ks * 4 + fq));
#pragma unroll
    for (int n = 0; n < NT; ++n) b[ks][n] = *(const bf16x8*)(Bs + swz(wc * (NT * 16) + n * 16 + fr, ks * 4 + fq));
  }
  __builtin_amdgcn_sched_barrier(0);
#pragma unroll
  for (int ks = 0; ks < 2; ++ks) {
#pragma unroll
    for (int m = 0; m < 4; ++m)
#pragma unroll
      for (int n = 0; n < NT; ++n) acc[m][n] = __builtin_amdgcn_mfma_f32_16x16x32_bf16(a[ks][m], b[ks][n], acc[m][n], 0, 0, 0);
    __builtin_amdgcn_sched_barrier(0);
  }
}

template <int NT, class ARow, class BRow>
DEVI void gemm_mainloop2(f32x4 (&acc)[4][NT], ARow arow, BRow brow, int K, char* lds);

template <int NT, class ARow>
DEVI void gemm_mainloop(f32x4 (&acc)[4][NT], ARow arow, const bf16_t* __restrict__ Bt, int ldb, int K, char* lds) {
  gemm_mainloop2<NT>(acc, arow, [&](int r) { return Bt + (size_t)r * ldb; }, K, lds);
}

template <int NT, class ARow, class BRow>
DEVI void gemm_mainloop2(f32x4 (&acc)[4][NT], ARow arow, BRow brow, int K, char* lds) {
  constexpr int NBR = NT;
  constexpr int STAGE = 16384 + NT * 32 * 128;
  const int tid = get_tid(), lane = tid & 63, wid = tid >> 6, wr = wid >> 1, wc = wid & 1, fr = lane & 15, fq = lane >> 4;
  const int lr = tid >> 3, lc = (tid & 7) ^ ((lr >> 1) & 7);
  const bf16_t* ap[4]; const bf16_t* bp[NBR];
#pragma unroll
  for (int i = 0; i < 4; ++i) ap[i] = arow(lr + 32 * i) + lc * 8;
#pragma unroll
  for (int i = 0; i < NBR; ++i) bp[i] = brow(lr + 32 * i) + lc * 8;
#pragma unroll
  for (int m = 0; m < 4; ++m)
#pragma unroll
    for (int n = 0; n < NT; ++n) acc[m][n] = (f32x4){0.f, 0.f, 0.f, 0.f};
  const int nk = K >> 6;
  auto issue = [&](int kt) {
    char* As = lds + (kt & 1) * STAGE + tid * 16; char* Bs = As + 16384;
#pragma unroll
    for (int i = 0; i < 4; ++i) __builtin_amdgcn_global_load_lds((const unsigned*)(ap[i] + kt * 64), (unsigned*)(As + i * 4096), 16, 0, 0);
#pragma unroll
    for (int i = 0; i < NBR; ++i) __builtin_amdgcn_global_load_lds((const unsigned*)(bp[i] + kt * 64), (unsigned*)(Bs + i * 4096), 16, 0, 0);
  };
  issue(0);
  for (int kt = 0; kt < nk; ++kt) {
    asm volatile("s_waitcnt vmcnt(0)" ::: "memory");
    __syncthreads();
    if (kt + 1 < nk) issue(kt + 1);
    const char* As = lds + (kt & 1) * STAGE; const char* Bs = As + 16384;
    mma_stage<NT>(As, Bs, acc, wr, wc, fr, fq);
  }
  __syncthreads();
}

template <int NT>
DEVI void acc_to_lds(const f32x4 (&acc)[4][NT], float* Cs) {
  constexpr int LDC = NT * 32 + 4;
  const int lane = get_tid() & 63, wid = get_tid() >> 6, wr = wid >> 1, wc = wid & 1, fr = lane & 15, fq = lane >> 4;
#pragma unroll
  for (int m = 0; m < 4; ++m)
#pragma unroll
    for (int n = 0; n < NT; ++n)
#pragma unroll
      for (int j = 0; j < 4; ++j) Cs[(wr * 64 + m * 16 + fq * 4 + j) * LDC + wc * (NT * 16) + n * 16 + fr] = acc[m][n][j];
  __syncthreads();
}

DEVI void conv_weight_tile(const AS4 ConvJob& jb, int local, char* lds) {
  float* tile = (float*)lds;
  const int tid = get_tid();
  const int nkt = jb.K >> 6, nnt = jb.Npad >> 6;
  const int per = nkt * nnt;
  const int bi = local / per; const int rem = local - bi * per;
  const int ktile = rem / nnt, ntile = rem - ktile * nnt;
  const int k0 = ktile * 64, n0 = ntile * 64;
  const float* src = jb.src + (size_t)bi * jb.sstride;
  bf16_t* dst = jb.dst + (size_t)bi * jb.dstride;
  {
    const int c4 = (tid & 15) * 4; const int r0 = tid >> 4;
#pragma unroll
    for (int i = 0; i < 4; ++i) {
      const int k = r0 + 16 * i; const int n = n0 + c4;
      float4 v = make_float4(0.f, 0.f, 0.f, 0.f);
      if (n < jb.N) v = *(const float4*)(src + (size_t)(k0 + k) * jb.N + n);
      if (jb.gain) { const float g = jb.gain[k0 + k]; v.x *= g; v.y *= g; v.z *= g; v.w *= g; }
      tile[k * 65 + c4 + 0] = v.x; tile[k * 65 + c4 + 1] = v.y; tile[k * 65 + c4 + 2] = v.z; tile[k * 65 + c4 + 3] = v.w;
    }
  }
  __syncthreads();
  {
    const int n = tid >> 2, kseg = (tid & 3) * 16;
    unsigned w[8];
#pragma unroll
    for (int i = 0; i < 8; ++i) w[i] = pack2(tile[(kseg + 2 * i) * 65 + n], tile[(kseg + 2 * i + 1) * 65 + n]);
    const int ng = n0 + n;
    int row = ng;
    if (jb.mode == 1) row = (ng >> 6) * 128 + (ng & 63);
    else if (jb.mode == 2) row = (ng >> 6) * 128 + 64 + (ng & 63);
    bf16_t* d = dst + (size_t)row * jb.K + k0 + kseg;
    *(u32x4*)(d) = (u32x4){w[0], w[1], w[2], w[3]};
    *(u32x4*)(d + 8) = (u32x4){w[4], w[5], w[6], w[7]};
  }
  __syncthreads();
}

DEVI void conv_weights_phase(PR p, int jbegin, int jend, int ntiles, char* lds) {
  for (int t = blockIdx.x; t < ntiles; t += gridDim.x) {
    int j = jbegin;
    while (j + 1 < jend && p.jobs[j + 1].tile_start <= t) ++j;
    conv_weight_tile(p.jobs[j], t - p.jobs[j].tile_start, lds);
  }
}

DEVI float4 ld4(const float* q) { return *(const float4*)q; }
DEVI float4 ld4(const bf16_t* q) { const u32x2 w = *(const u32x2*)q; return make_float4(bflo(w.x), bfhi(w.x), bflo(w.y), bfhi(w.y)); }
DEVI void st4(float* q, float4 v) { *(float4*)q = v; }
DEVI void st4(bf16_t* q, float4 v) { u32x2 w; w.x = pack2(v.x, v.y); w.y = pack2(v.z, v.w); *(u32x2*)q = w; }

template <class SrcT, class DstT>
DEVI void rownorm_phase(const SrcT* __restrict__ src, const bf16_t* __restrict__ y, const float* __restrict__ gain,
                        DstT* dstx, bf16_t* dsth) {
  const int lane = get_tid() & 63;
  const int wave = blockIdx.x * 4 + (get_tid() >> 6), nw = gridDim.x * 4;
  for (int row = wave; row < T_; row += nw) {
    float4 v[4];
#pragma unroll
    for (int i = 0; i < 4; ++i) v[i] = ld4(src + (size_t)row * 1024 + i * 256 + lane * 4);
    if (y) {
#pragma unroll
      for (int s = 0; s < 2; ++s)
#pragma unroll
        for (int i = 0; i < 4; ++i) {
          u32x2 w = *(const u32x2*)(y + (size_t)(row * 2 + s) * 1024 + i * 256 + lane * 4);
          v[i].x += bflo(w.x); v[i].y += bfhi(w.x); v[i].z += bflo(w.y); v[i].w += bfhi(w.y);
        }
    }
    if (dstx) {
#pragma unroll
      for (int i = 0; i < 4; ++i) st4(dstx + (size_t)row * 1024 + i * 256 + lane * 4, v[i]);
    }
    if (dsth) {
      float ss = 0.f;
#pragma unroll
      for (int i = 0; i < 4; ++i) ss += v[i].x * v[i].x + v[i].y * v[i].y + v[i].z * v[i].z + v[i].w * v[i].w;
      ss = wave_sum(ss);
      const float r = 1.0f / sqrtf(ss * (1.0f / 1024.0f) + 1e-6f);
#pragma unroll
      for (int i = 0; i < 4; ++i) {
        const float4 g = *(const float4*)(gain + i * 256 + lane * 4);
        u32x2 w; w.x = pack2(v[i].x * r * g.x, v[i].y * r * g.y); w.y = pack2(v[i].z * r * g.z, v[i].w * r * g.w);
        *(u32x2*)(dsth + (size_t)row * 1024 + i * 256 + lane * 4) = w;
      }
    }
  }
}

DEVI void gemm_bf16out_phase(const bf16_t* A, int lda, const bf16_t* Bt, int K, int ncolt, bf16_t* out, int ldo, int nvalid, char* lds) {
  float* Cs = (float*)lds;
  XcdIter xi; xi.init();
  const int gsz = (ncolt > 8) ? 6 : ncolt, ngrp = ncolt / gsz;
  for (int n = xi.lb; n < 32 * ncolt; n += xi.nlb) {
    const int grp = n / (32 * gsz), rem = n - grp * (32 * gsz);
    const int rl = rem / gsz, jn = grp * gsz + (rem - rl * gsz);
    const int rt = xi.xcd * 32 + rl;
    f32x4 acc[4][4];
    const bf16_t* Ab = A + (size_t)rt * 128 * lda;
    gemm_mainloop<4>(acc, [&](int r) { return Ab + (size_t)r * lda; }, Bt + (size_t)jn * 128 * K, K, K, lds);
    acc_to_lds<4>(acc, Cs);
    const int c4 = get_tid() & 31, r0 = get_tid() >> 5;
    const int col = jn * 128 + c4 * 4;
    if (col < nvalid) {
#pragma unroll
      for (int i = 0; i < 16; ++i) {
        const int row = r0 + 8 * i;
        const f32x4 v = *(const f32x4*)(Cs + row * 132 + c4 * 4);
        u32x2 w; w.x = pack2(v[0], v[1]); w.y = pack2(v[2], v[3]);
        *(u32x2*)(out + (size_t)(rt * 128 + row) * ldo + col) = w;
      }
    }
    __syncthreads();
  }
}

template <class BaseT>
DEVI void gemm_resid_phase(const bf16_t* A, const bf16_t* Bt, const BaseT* base, bf16_t* xr, char* lds) {
  float* Cs = (float*)lds;
  XcdIter xi; xi.init();
  for (int n = xi.lb; n < 32 * 8; n += xi.nlb) {
    const int rt = xi.xcd * 32 + (n >> 3), jn = n & 7;
    f32x4 acc[4][4];
    const bf16_t* Ab = A + (size_t)rt * 128 * 1024;
    gemm_mainloop<4>(acc, [&](int r) { return Ab + (size_t)r * 1024; }, Bt + (size_t)jn * 128 * 1024, 1024, 1024, lds);
    const int c4 = get_tid() & 31, r0 = get_tid() >> 5;
    const int col = jn * 128 + c4 * 4;
    float4 bres[16];
#pragma unroll
    for (int i = 0; i < 16; ++i) bres[i] = ld4(base + (size_t)(rt * 128 + r0 + 8 * i) * 1024 + col);
    acc_to_lds<4>(acc, Cs);
#pragma unroll
    for (int i = 0; i < 16; ++i) {
      const int row = r0 + 8 * i;
      const f32x4 v = *(const f32x4*)(Cs + row * 132 + c4 * 4);
      const size_t o = (size_t)(rt * 128 + row) * 1024 + col;
      const float4 b = bres[i];
      st4(xr + o, make_float4(b.x + v[0], b.y + v[1], b.z + v[2], b.w + v[3]));
    }
    __syncthreads();
  }
}

template <int KW>
DEVI void row_rms_scale(const bf16_t* Ab, int lda, float* rsA) {
  const int row = get_tid() >> 1, half = get_tid() & 1;
  const bf16_t* q = Ab + (size_t)row * lda + half * (KW / 2);
  float ss = 0.f;
#pragma unroll
  for (int i = 0; i < KW / 16; ++i) {
    const u32x4 w = *(const u32x4*)(q + i * 8);
#pragma unroll
    for (int e = 0; e < 4; ++e) { const float a = bflo(w[e]), b = bfhi(w[e]); ss += a * a + b * b; }
  }
  ss += __shfl_xor(ss, 1);
  if (half == 0) rsA[row] = 1.0f / sqrtf(ss * (1.0f / KW) + 1e-6f);
}

DEVI void qup_tile(PR p, int rt, int h, char* lds) {
  float* Cs = (float*)lds;
  float* rsA = (float*)(lds + 72704);
  const bf16_t* Ab = p.proj0 + (size_t)rt * 128 * 1440;
  row_rms_scale<256>(Ab, 1440, rsA);
  f32x4 acc[4][3];
  gemm_mainloop<3>(acc, [&](int r) { return Ab + (size_t)r * 1440; }, p.Wuqt + (size_t)h * 96 * 256, 256, 256, lds);
  acc_to_lds<3>(acc, Cs);
  const int row = get_tid() >> 1, half = get_tid() & 1;
  const int t = rt * 128 + row, b = t >> 11, s = t & 2047;
  const float rq = rsA[row];
  float v[48];
#pragma unroll
  for (int i = 0; i < 12; ++i) {
    const f32x4 c = *(const f32x4*)(Cs + row * 100 + half * 48 + i * 4);
    v[4 * i] = c[0] * rq; v[4 * i + 1] = c[1] * rq; v[4 * i + 2] = c[2] * rq; v[4 * i + 3] = c[3] * rq;
  }
  float ss = 0.f;
#pragma unroll
  for (int i = 0; i < 48; ++i) ss += v[i] * v[i];
  ss += __shfl_xor(ss, 1);
  const float rn = 1.0f / sqrtf(ss * (1.0f / 96.0f) + 1e-6f);
  const float osc = 0.10206207261596575f * LOG2E;
#pragma unroll
  for (int i = 0; i < 48; ++i) v[i] = v[i] * rn * p.mla_q_norm[half * 48 + i];
  if (half == 1) {
    const float fpos = (float)p.pos[t];
#pragma unroll
    for (int i = 0; i < 16; ++i) {
      float sn, cs; sincos_rev(fpos * p.inv_freq[i], sn, cs);
      const float x1 = v[16 + i], x2 = v[32 + i];
      v[16 + i] = x1 * cs - x2 * sn; v[32 + i] = x1 * sn + x2 * cs;
    }
  }
  bf16_t* dst = p.Q0 + ((size_t)(b * 8 + h) * 2048 + s) * 96 + half * 48;
#pragma unroll
  for (int i = 0; i < 6; ++i) {
    u32x4 w;
    w[0] = pack2(v[8 * i] * osc, v[8 * i + 1] * osc); w[1] = pack2(v[8 * i + 2] * osc, v[8 * i + 3] * osc);
    w[2] = pack2(v[8 * i + 4] * osc, v[8 * i + 5] * osc); w[3] = pack2(v[8 * i + 6] * osc, v[8 * i + 7] * osc);
    *(u32x4*)(dst + i * 8) = w;
  }
  __syncthreads();
}

DEVI void kvup_tile(PR p, int rt, int h, char* lds) {
  float* Cs = (float*)lds;
  float* rsA = (float*)(lds + 72704);
  const bf16_t* Ab = p.proj0 + (size_t)rt * 128 * 1440 + 256;
  row_rms_scale<128>(Ab, 1440, rsA);
  f32x4 acc[4][4];
  gemm_mainloop<4>(acc, [&](int r) { return Ab + (size_t)r * 1440; }, p.Wukvt + (size_t)h * 128 * 128, 128, 128, lds);
  acc_to_lds<4>(acc, Cs);
  const int row = get_tid() >> 1, half = get_tid() & 1;
  const int t = rt * 128 + row, b = t >> 11, s = t & 2047;
  const float rkv = rsA[row];
  if (half == 0) {
    float kr[32];
    const bf16_t* rp = p.proj0 + (size_t)t * 1440 + 384;
#pragma unroll
    for (int i = 0; i < 4; ++i) {
      const u32x4 w = *(const u32x4*)(rp + i * 8);
#pragma unroll
      for (int e = 0; e < 4; ++e) { kr[8 * i + 2 * e] = bflo(w[e]); kr[8 * i + 2 * e + 1] = bfhi(w[e]); }
    }
    float ss = 0.f;
#pragma unroll
    for (int i = 0; i < 32; ++i) ss += kr[i] * kr[i];
#pragma unroll
    for (int i = 0; i < 16; ++i) {
      const f32x4 c = *(const f32x4*)(Cs + row * 132 + i * 4);
#pragma unroll
      for (int e = 0; e < 4; ++e) { const float a = c[e] * rkv; ss += a * a; }
    }
    const float rn = 1.0f / sqrtf(ss * (1.0f / 96.0f) + 1e-6f);
    bf16_t* dst = p.K0 + ((size_t)(b * 8 + h) * 2048 + s) * 96;
#pragma unroll
    for (int i = 0; i < 8; ++i) {
      const f32x4 c0 = *(const f32x4*)(Cs + row * 132 + i * 8);
      const f32x4 c1 = *(const f32x4*)(Cs + row * 132 + i * 8 + 4);
      const float4 g0 = *(const float4*)(p.mla_k_norm + i * 8);
      const float4 g1 = *(const float4*)(p.mla_k_norm + i * 8 + 4);
      const float f = rkv * rn;
      u32x4 w;
      w[0] = pack2(c0[0] * f * g0.x, c0[1] * f * g0.y); w[1] = pack2(c0[2] * f * g0.z, c0[3] * f * g0.w);
      w[2] = pack2(c1[0] * f * g1.x, c1[1] * f * g1.y); w[3] = pack2(c1[2] * f * g1.z, c1[3] * f * g1.w);
      *(u32x4*)(dst + i * 8) = w;
    }
#pragma unroll
    for (int i = 0; i < 32; ++i) kr[i] = kr[i] * rn * p.mla_k_norm[64 + i];
    const float fpos = (float)p.pos[t];
#pragma unroll
    for (int i = 0; i < 16; ++i) {
      float sn, cs; sincos_rev(fpos * p.inv_freq[i], sn, cs);
      const float x1 = kr[i], x2 = kr[16 + i];
      kr[i] = x1 * cs - x2 * sn; kr[16 + i] = x1 * sn + x2 * cs;
    }
#pragma unroll
    for (int i = 0; i < 4; ++i) {
      u32x4 w;
      w[0] = pack2(kr[8 * i], kr[8 * i + 1]); w[1] = pack2(kr[8 * i + 2], kr[8 * i + 3]);
      w[2] = pack2(kr[8 * i + 4], kr[8 * i + 5]); w[3] = pack2(kr[8 * i + 6], kr[8 * i + 7]);
      *(u32x4*)(dst + 64 + i * 8) = w;
    }
  } else {
    bf16_t* dst = p.V0t + ((size_t)(b * 8 + h) * 64) * 2048 + s;
#pragma unroll
    for (int i = 0; i < 16; ++i) {
      const f32x4 c = *(const f32x4*)(Cs + row * 132 + 64 + i * 4);
#pragma unroll
      for (int e = 0; e < 4; ++e) dst[(size_t)(i * 4 + e) * 2048] = f2bf(c[e] * rkv);
    }
  }
  __syncthreads();
}

DEVI void conv_tile(PR p, int tile, char* lds) {
  const int tid = get_tid(), lane = tid & 63, wid = tid >> 6;
  const int b = tile >> 6, t0 = (tile & 63) * 32;
  unsigned* glu = (unsigned*)lds;
#pragma unroll 1
  for (int i0 = 0; i0 < 62; i0 += 16) {
    unsigned av[16], gv[16];
#pragma unroll
    for (int k = 0; k < 16; ++k) {
      const int i = i0 + k; const int tt = max(t0 - 30 + i, 0);
      const bf16_t* rp = p.proj0 + (size_t)(b * 2048 + tt) * 1440;
      av[k] = (i < 62) ? *(const unsigned*)(rp + 416 + 2 * tid) : 0u;
      gv[k] = (i < 62) ? *(const unsigned*)(rp + 928 + 2 * tid) : 0u;
    }
#pragma unroll
    for (int k = 0; k < 16; ++k) {
      const int i = i0 + k;
      const unsigned a = av[k], g = gv[k];
      const unsigned w = (t0 - 30 + i >= 0) ? pack2(bflo(a) * sigmoidf_(bflo(g)), bfhi(a) * sigmoidf_(bfhi(g))) : 0u;
      if (i < 62) glu[i * 256 + tid] = w;
    }
  }
  __syncthreads();
  float y0[32], y1[32];
  {
    const float2 bb = *(const float2*)(p.conv_dw_b + 2 * tid);
#pragma unroll
    for (int t = 0; t < 32; ++t) { y0[t] = bb.x; y1[t] = bb.y; }
  }
  {
    float2 w[31];
#pragma unroll
    for (int j = 0; j < 31; ++j) w[j] = *(const float2*)(p.conv_dw_w + j * 512 + 2 * tid);
#pragma unroll
    for (int i = 0; i < 62; ++i) {
      const unsigned g2 = glu[i * 256 + tid];
      const float lo = bflo(g2), hi = bfhi(g2);
#pragma unroll
      for (int t = (i > 30 ? i - 30 : 0); t <= (i < 31 ? i : 31); ++t) { y0[t] += w[i - t].x * lo; y1[t] += w[i - t].y * hi; }
    }
  }
  __syncthreads();
  float* ys = (float*)lds;
#pragma unroll
  for (int t = 0; t < 32; ++t) *(float2*)(ys + t * 516 + 2 * tid) = make_float2(y0[t], y1[t]);
  __syncthreads();
  for (int k = 0; k < 8; ++k) {
    const int tl = wid * 8 + k;
    const f32x4 a0 = *(const f32x4*)(ys + tl * 516 + lane * 8);
    const f32x4 a1 = *(const f32x4*)(ys + tl * 516 + lane * 8 + 4);
    float v[8] = {a0[0], a0[1], a0[2], a0[3], a1[0], a1[1], a1[2], a1[3]};
    float sm = 0.f;
#pragma unroll
    for (int e = 0; e < 8; ++e) sm += v[e];
    const float mu = wave_sum(sm) * (1.0f / 512.0f);
    float sq = 0.f;
#pragma unroll
    for (int e = 0; e < 8; ++e) { v[e] -= mu; sq += v[e] * v[e]; }
    const float rstd = 1.0f / sqrtf(wave_sum(sq) * (1.0f / 512.0f) + 1e-5f);
    const float4 g0 = *(const float4*)(p.conv_ln_g + lane * 8), g1 = *(const float4*)(p.conv_ln_g + lane * 8 + 4);
    const float4 b0 = *(const float4*)(p.conv_ln_b + lane * 8), b1 = *(const float4*)(p.conv_ln_b + lane * 8 + 4);
    const float gg[8] = {g0.x, g0.y, g0.z, g0.w, g1.x, g1.y, g1.z, g1.w};
    const float bb[8] = {b0.x, b0.y, b0.z, b0.w, b1.x, b1.y, b1.z, b1.w};
    float o[8];
#pragma unroll
    for (int e = 0; e < 8; ++e) { const float z = v[e] * rstd * gg[e] + bb[e]; o[e] = z * sigmoidf_(z); }
    u32x4 w; w[0] = pack2(o[0], o[1]); w[1] = pack2(o[2], o[3]); w[2] = pack2(o[4], o[5]); w[3] = pack2(o[6], o[7]);
    *(u32x4*)(p.hn + (size_t)(b * 2048 + t0 + tl) * 1024 + 512 + lane * 8) = w;
  }
  __syncthreads();
}

DEVI void l0_phase2(PR p, char* lds) {
  XcdIter xi; xi.init();
  for (int n = xi.lb; n < 640; n += xi.nlb) {
    if (n < 256) qup_tile(p, xi.xcd * 32 + (n >> 3), n & 7, lds);
    else if (n < 512) kvup_tile(p, xi.xcd * 32 + ((n - 256) >> 3), (n - 256) & 7, lds);
    else conv_tile(p, xi.xcd * 128 + (n - 512), lds);
  }
}

template <int NKS, int KSTR>
DEVI void qk_tile(const char* Ks, const bf16x8 (&qf)[2][NKS], f32x4 (&s)[4][2], int fr, int fq) {
#pragma unroll
  for (int kt = 0; kt < 4; ++kt) {
    s[kt][0] = (f32x4){0.f, 0.f, 0.f, 0.f}; s[kt][1] = (f32x4){0.f, 0.f, 0.f, 0.f};
#pragma unroll
    for (int ks = 0; ks < NKS; ++ks) {
      const bf16x8 a = *(const bf16x8*)(Ks + (kt * 16 + fr) * KSTR + ks * 64 + fq * 16);
      s[kt][0] = __builtin_amdgcn_mfma_f32_16x16x32_bf16(a, qf[0][ks], s[kt][0], 0, 0, 0);
      s[kt][1] = __builtin_amdgcn_mfma_f32_16x16x32_bf16(a, qf[1][ks], s[kt][1], 0, 0, 0);
    }
  }
}
template <int VSTR>
DEVI void pv_tile(const char* Vs, const f32x4 (&pr)[4][2], f32x4 (&o)[4][2], int fr, int fq) {
#pragma unroll
  for (int u = 0; u < 2; ++u) {
    bf16x8 bfr[2];
#pragma unroll
    for (int qt = 0; qt < 2; ++qt) {
      u32x4 w;
      w[0] = pack2(pr[2 * u][qt][0], pr[2 * u][qt][1]); w[1] = pack2(pr[2 * u][qt][2], pr[2 * u][qt][3]);
      w[2] = pack2(pr[2 * u + 1][qt][0], pr[2 * u + 1][qt][1]); w[3] = pack2(pr[2 * u + 1][qt][2], pr[2 * u + 1][qt][3]);
      bfr[qt] = __builtin_bit_cast(bf16x8, w);
    }
#pragma unroll
    for (int dt = 0; dt < 4; ++dt) {
      const char* vp = Vs + (dt * 16 + fr) * VSTR + (32 * u + 4 * fq) * 2;
      const u32x2 lo = *(const u32x2*)(vp);
      const u32x2 hi = *(const u32x2*)(vp + 32);
      const u32x4 aw = (u32x4){lo[0], lo[1], hi[0], hi[1]};
      const bf16x8 a = __builtin_bit_cast(bf16x8, aw);
      o[dt][0] = __builtin_amdgcn_mfma_f32_16x16x32_bf16(a, bfr[0], o[dt][0], 0, 0, 0);
      o[dt][1] = __builtin_amdgcn_mfma_f32_16x16x32_bf16(a, bfr[1], o[dt][1], 0, 0, 0);
    }
  }
}
DEVI void softmax_update(f32x4 (&s)[4][2], float (&m)[2], float (&l)[2], f32x4 (&o)[4][2]) {
#pragma unroll
  for (int qt = 0; qt < 2; ++qt) {
    float mx = NEGBIG;
#pragma unroll
    for (int kt = 0; kt < 4; ++kt)
#pragma unroll
      for (int j = 0; j < 4; ++j) mx = fmaxf(mx, s[kt][qt][j]);
    mx = fmaxf(mx, __shfl_xor(mx, 16)); mx = fmaxf(mx, __shfl_xor(mx, 32));
    const float mn = fmaxf(m[qt], mx);
    const float alpha = fast_exp2(m[qt] - mn);
    m[qt] = mn;
    const float mnc = fmaxf(mn, -1e29f);
    float rsum = 0.f;
#pragma unroll
    for (int kt = 0; kt < 4; ++kt)
#pragma unroll
      for (int j = 0; j < 4; ++j) {
        const float pv = fast_exp2(s[kt][qt][j] - mnc);
        s[kt][qt][j] = pv; rsum += pv;
      }
    l[qt] = l[qt] * alpha + rsum;
#pragma unroll
    for (int dt = 0; dt < 4; ++dt) { o[dt][qt][0] *= alpha; o[dt][qt][1] *= alpha; o[dt][qt][2] *= alpha; o[dt][qt][3] *= alpha; }
  }
}

DEVI void exp_accum(f32x4 (&s)[4][2], float (&l)[2]) {
#pragma unroll
  for (int qt = 0; qt < 2; ++qt) {
    float rsum = 0.f;
#pragma unroll
    for (int kt = 0; kt < 4; ++kt)
#pragma unroll
      for (int j = 0; j < 4; ++j) { const float pv = fast_exp2(s[kt][qt][j]); s[kt][qt][j] = pv; rsum += pv; }
    l[qt] += rsum;
  }
}

DEVI unsigned bf_hi_bits(float v) { return pack2(v, 0.f) & 0xffffu; }
DEVI float bf_round(float v) { return __uint_as_float(bf_hi_bits(v) << 16); }
template <int NKS, int KSTR>
DEVI void qk_tile_aug(const char* Ks, const char* Kaug, const bf16x8 (&qf)[2][NKS], const bf16x8 (&qa)[2], f32x4 (&s)[4][2], int fr, int fq) {
#pragma unroll
  for (int kt = 0; kt < 4; ++kt) {
    s[kt][0] = (f32x4){0.f, 0.f, 0.f, 0.f}; s[kt][1] = (f32x4){0.f, 0.f, 0.f, 0.f};
#pragma unroll
    for (int ks = 0; ks < NKS; ++ks) {
      const bf16x8 a = *(const bf16x8*)(Ks + (kt * 16 + fr) * KSTR + ks * 64 + fq * 16);
      s[kt][0] = __builtin_amdgcn_mfma_f32_16x16x32_bf16(a, qf[0][ks], s[kt][0], 0, 0, 0);
      s[kt][1] = __builtin_amdgcn_mfma_f32_16x16x32_bf16(a, qf[1][ks], s[kt][1], 0, 0, 0);
    }
    u32x4 aw = *(const u32x4*)(Kaug + (kt * 16 + fr) * 16);
    if (fq != 0) aw = (u32x4){0u, 0u, 0u, 0u};
    const bf16x8 a = __builtin_bit_cast(bf16x8, aw);
    s[kt][0] = __builtin_amdgcn_mfma_f32_16x16x32_bf16(a, qa[0], s[kt][0], 0, 0, 0);
    s[kt][1] = __builtin_amdgcn_mfma_f32_16x16x32_bf16(a, qa[1], s[kt][1], 0, 0, 0);
  }
}
DEVI bf16x8 make_qaug(float slope2, float colc, int fq) {
  const float sh = bf_round(slope2), sl = slope2 - sh;
  const float c1 = bf_round(colc), r1 = colc - c1, c2 = bf_round(r1), c3 = r1 - c2;
  u32x4 w;
  w[0] = pack2(sh, sh); w[1] = pack2(sl, sl); w[2] = pack2(c1, c2); w[3] = pack2(c3, 0.f);
  if (fq != 0) w = (u32x4){0u, 0u, 0u, 0u};
  return __builtin_bit_cast(bf16x8, w);
}
DEVI u32x4 make_kaug(float v) {
  const float ph = bf_round(v), pl = v - ph;
  u32x4 w; w[0] = pack2(ph, pl); w[1] = pack2(ph, pl); w[2] = 0x3f803f80u; w[3] = 0x00003f80u;
  return w;
}
DEVI void exp_tile(f32x4 (&s)[4][2]) {
#pragma unroll
  for (int kt = 0; kt < 4; ++kt)
#pragma unroll
    for (int qt = 0; qt < 2; ++qt)
#pragma unroll
      for (int j = 0; j < 4; ++j) s[kt][qt][j] = fast_exp2(s[kt][qt][j]);
}
template <int VSTR>
DEVI void pv_tile_l(const char* Vs, const f32x4 (&pr)[4][2], f32x4 (&o)[4][2], f32x4 (&ol)[2], int fr, int fq) {
  const u32x4 onesw = (u32x4){0x3f803f80u, 0x3f803f80u, 0x3f803f80u, 0x3f803f80u};
  const bf16x8 ones = __builtin_bit_cast(bf16x8, onesw);
#pragma unroll
  for (int u = 0; u < 2; ++u) {
    bf16x8 bfr[2];
#pragma unroll
    for (int qt = 0; qt < 2; ++qt) {
      u32x4 w;
      w[0] = pack2(pr[2 * u][qt][0], pr[2 * u][qt][1]); w[1] = pack2(pr[2 * u][qt][2], pr[2 * u][qt][3]);
      w[2] = pack2(pr[2 * u + 1][qt][0], pr[2 * u + 1][qt][1]); w[3] = pack2(pr[2 * u + 1][qt][2], pr[2 * u + 1][qt][3]);
      bfr[qt] = __builtin_bit_cast(bf16x8, w);
    }
#pragma unroll
    for (int dt = 0; dt < 4; ++dt) {
      const char* vp = Vs + (dt * 16 + fr) * VSTR + (32 * u + 4 * fq) * 2;
      const u32x2 lo = *(const u32x2*)(vp);
      const u32x2 hi = *(const u32x2*)(vp + 32);
      const u32x4 aw = (u32x4){lo[0], lo[1], hi[0], hi[1]};
      const bf16x8 a = __builtin_bit_cast(bf16x8, aw);
      o[dt][0] = __builtin_amdgcn_mfma_f32_16x16x32_bf16(a, bfr[0], o[dt][0], 0, 0, 0);
      o[dt][1] = __builtin_amdgcn_mfma_f32_16x16x32_bf16(a, bfr[1], o[dt][1], 0, 0, 0);
    }
    ol[0] = __builtin_amdgcn_mfma_f32_16x16x32_bf16(ones, bfr[0], ol[0], 0, 0, 0);
    ol[1] = __builtin_amdgcn_mfma_f32_16x16x32_bf16(ones, bfr[1], ol[1], 0, 0, 0);
  }
}

DEVI float head8_sum(float v) {
  v += __builtin_bit_cast(float, __builtin_amdgcn_update_dpp(0, __builtin_bit_cast(int, v), 0xB1, 0xF, 0xF, true));
  v += __builtin_bit_cast(float, __builtin_amdgcn_update_dpp(0, __builtin_bit_cast(int, v), 0x4E, 0xF, 0xF, true));
  v += __builtin_bit_cast(float, __builtin_amdgcn_update_dpp(0, __builtin_bit_cast(int, v), 0x141, 0xF, 0xF, true));
  return v;
}

DEVI void rowsum_tile(const f32x4 (&pr)[4][2], f32x4 (&ol)[2]) {
  const u32x4 onesw = (u32x4){0x3f803f80u, 0x3f803f80u, 0x3f803f80u, 0x3f803f80u};
  const bf16x8 ones = __builtin_bit_cast(bf16x8, onesw);
#pragma unroll
  for (int u = 0; u < 2; ++u)
#pragma unroll
    for (int qt = 0; qt < 2; ++qt) {
      u32x4 w;
      w[0] = pack2(pr[2 * u][qt][0], pr[2 * u][qt][1]); w[1] = pack2(pr[2 * u][qt][2], pr[2 * u][qt][3]);
      w[2] = pack2(pr[2 * u + 1][qt][0], pr[2 * u + 1][qt][1]); w[3] = pack2(pr[2 * u + 1][qt][2], pr[2 * u + 1][qt][3]);
      ol[qt] = __builtin_amdgcn_mfma_f32_16x16x32_bf16(ones, __builtin_bit_cast(bf16x8, w), ol[qt], 0, 0, 0);
    }
}

DEVI void mla_attn_phase(PR p, char* lds) {
  constexpr int KSTR = 208, VSTR = 144;
  const int tid = get_tid(), lane = tid & 63, wid = tid >> 6, fr = lane & 15, fq = lane >> 4;
  XcdIter xi; xi.init();
  for (int n = xi.lb; n < 256; n += xi.nlb) {
    __syncthreads();
    const int r = n >> 6, li = n & 63, jq = li & 15;
    const int bh = xi.xcd * 16 + r * 4 + (li >> 4);
    const int j8 = (jq + 8) & 15;
    const int qt128 = (r == 0) ? jq : (r == 1) ? 15 - jq : (r == 2) ? j8 : 15 - j8;
    const int q0 = qt128 * 128 + wid * 32;
    const bf16_t* Qb = p.Q0 + (size_t)bh * 2048 * 96;
    const bf16_t* Kb = p.K0 + (size_t)bh * 2048 * 96;
    const bf16_t* Vb = p.V0t + (size_t)bh * 64 * 2048;
    bf16x8 qf[2][3];
#pragma unroll
    for (int qt = 0; qt < 2; ++qt)
#pragma unroll
      for (int ks = 0; ks < 3; ++ks) qf[qt][ks] = *(const bf16x8*)(Qb + (size_t)(q0 + 16 * qt + fr) * 96 + ks * 32 + fq * 8);
    f32x4 o[4][2]; f32x4 ol[2];
    ol[0] = (f32x4){0.f, 0.f, 0.f, 0.f}; ol[1] = (f32x4){0.f, 0.f, 0.f, 0.f};
#pragma unroll
    for (int dt = 0; dt < 4; ++dt) { o[dt][0] = (f32x4){0.f, 0.f, 0.f, 0.f}; o[dt][1] = (f32x4){0.f, 0.f, 0.f, 0.f}; }
    const int nkt = 2 * (qt128 + 1);
    u32x4 rk[3], rv[2];
    const int kr0 = tid / 12, kc0 = tid - kr0 * 12;
    const int kr1 = (tid + 256) / 12, kc1 = (tid + 256) - kr1 * 12;
    const int kr2 = (tid + 512) / 12, kc2 = (tid + 512) - kr2 * 12;
    const int vr0 = tid >> 3, vc0 = tid & 7;
    auto fetch = [&](int key0) {
      rk[0] = *(const u32x4*)(Kb + (size_t)(key0 + kr0) * 96 + kc0 * 8);
      rk[1] = *(const u32x4*)(Kb + (size_t)(key0 + kr1) * 96 + kc1 * 8);
      rk[2] = *(const u32x4*)(Kb + (size_t)(key0 + kr2) * 96 + kc2 * 8);
      rv[0] = *(const u32x4*)(Vb + (size_t)vr0 * 2048 + key0 + vc0 * 8);
      rv[1] = *(const u32x4*)(Vb + (size_t)(vr0 + 32) * 2048 + key0 + vc0 * 8);
    };
    fetch(0);
    for (int kt64 = 0; kt64 < nkt; ++kt64) {
      const int key0 = kt64 * 64;
      char* Kc = lds + (kt64 & 1) * 22528; char* Vc = Kc + 64 * KSTR;
      *(u32x4*)(Kc + kr0 * KSTR + kc0 * 16) = rk[0];
      *(u32x4*)(Kc + kr1 * KSTR + kc1 * 16) = rk[1];
      *(u32x4*)(Kc + kr2 * KSTR + kc2 * 16) = rk[2];
      *(u32x4*)(Vc + vr0 * VSTR + vc0 * 16) = rv[0];
      *(u32x4*)(Vc + (vr0 + 32) * VSTR + vc0 * 16) = rv[1];
      __syncthreads();
      if (kt64 + 1 < nkt) fetch(key0 + 64);
      if (key0 <= q0 + 31) {
        f32x4 s[4][2];
        qk_tile<3, KSTR>(Kc, qf, s, fr, fq);
        if (key0 + 63 > q0) {
#pragma unroll
          for (int kt = 0; kt < 4; ++kt)
#pragma unroll
            for (int qt = 0; qt < 2; ++qt)
#pragma unroll
              for (int j = 0; j < 4; ++j) {
                const int key = key0 + 16 * kt + 4 * fq + j, qq = q0 + 16 * qt + fr;
                if (key > qq) s[kt][qt][j] = NEGBIG;
              }
        }
        exp_tile(s);
        pv_tile_l<VSTR>(Vc, s, o, ol, fr, fq);
      }
    }
    const int b = bh >> 3, h = bh & 7;
#pragma unroll
    for (int qt = 0; qt < 2; ++qt) {
      const float inv = 1.0f / ol[qt][0];
      bf16_t* dst = p.hn + (size_t)(b * 2048 + q0 + 16 * qt + fr) * 1024 + h * 64 + 4 * fq;
#pragma unroll
      for (int dt = 0; dt < 4; ++dt) {
        u32x2 w; w[0] = pack2(o[dt][qt][0] * inv, o[dt][qt][1] * inv); w[1] = pack2(o[dt][qt][2] * inv, o[dt][qt][3] * inv);
        *(u32x2*)(dst + dt * 16) = w;
      }
    }
  }
  __syncthreads();
}

DEVI void router_phase(PR p, int layer, char* lds) {
  constexpr int WSTR = 528;
  char* Wh = lds;
  char* Wl = lds + 48 * WSTR;
  float* lg = (float*)(lds + 50688);
  float* ssL = (float*)(lds + 50688 + 12288);
  int* cntL = (int*)(lds + 50688 + 12288 + 256);
  int* baseL = cntL + 32;
  const int tid = get_tid(), lane = tid & 63, wid = tid >> 6, fr = lane & 15, fq = lane >> 4;
  const bf16_t* gWh = p.RWh + (size_t)layer * 48 * 1024;
  const bf16_t* gWl = p.RWl + (size_t)layer * 48 * 1024;
  int* gcnt = p.gcnt + layer * 32;
  for (int tile = blockIdx.x; tile < T_ / 64; tile += gridDim.x) {
    const int row = tile * 64 + wid * 16 + fr;
    const bf16_t* xrow = p.xr + (size_t)row * 1024;
    f32x4 acc[3]; acc[0] = acc[1] = acc[2] = (f32x4){0.f, 0.f, 0.f, 0.f};
    float ss = 0.f;
    if (tid < 32) cntL[tid] = 0;
    for (int kc = 0; kc < 4; ++kc) {
      u32x4 xq[8];
#pragma unroll
      for (int i = 0; i < 8; ++i) xq[i] = *(const u32x4*)(xrow + kc * 256 + (i >> 1) * 64 + fq * 16 + (i & 1) * 8);
      u32x4 wq[12];
#pragma unroll
      for (int i = 0; i < 6; ++i) {
        const int q = tid + 256 * i; const int n = q >> 5, c = q & 31;
        wq[i] = *(const u32x4*)(gWh + (size_t)n * 1024 + kc * 256 + c * 8);
        wq[6 + i] = *(const u32x4*)(gWl + (size_t)n * 1024 + kc * 256 + c * 8);
      }
      __syncthreads();
#pragma unroll
      for (int i = 0; i < 6; ++i) {
        const int q = tid + 256 * i; const int n = q >> 5, c = q & 31;
        *(u32x4*)(Wh + n * WSTR + c * 16) = wq[i];
        *(u32x4*)(Wl + n * WSTR + c * 16) = wq[6 + i];
      }
      __syncthreads();
#pragma unroll
      for (int s4 = 0; s4 < 4; ++s4) {
#pragma unroll
        for (int m = 0; m < 2; ++m) {
          const u32x4 xw = xq[s4 * 2 + m];
#pragma unroll
          for (int i = 0; i < 4; ++i) { const float a = bflo(xw[i]), b = bfhi(xw[i]); ss += a * a + b * b; }
          const bf16x8 ah = __builtin_bit_cast(bf16x8, xw);
          const int koff = (s4 * 64 + fq * 16 + 8 * m) * 2;
#pragma unroll
          for (int nt = 0; nt < 3; ++nt) {
            const bf16x8 bh = *(const bf16x8*)(Wh + (nt * 16 + fr) * WSTR + koff);
            const bf16x8 bl = *(const bf16x8*)(Wl + (nt * 16 + fr) * WSTR + koff);
            acc[nt] = __builtin_amdgcn_mfma_f32_16x16x32_bf16(ah, bh, acc[nt], 0, 0, 0);
            acc[nt] = __builtin_amdgcn_mfma_f32_16x16x32_bf16(ah, bl, acc[nt], 0, 0, 0);
          }
        }
      }
    }
    ss += __shfl_xor(ss, 16); ss += __shfl_xor(ss, 32);
    if (fq == 0) ssL[wid * 16 + fr] = ss;
#pragma unroll
    for (int nt = 0; nt < 3; ++nt)
#pragma unroll
      for (int j = 0; j < 4; ++j) lg[(wid * 16 + 4 * fq + j) * 48 + nt * 16 + fr] = acc[nt][j];
    __syncthreads();
    int e0 = 0, e1 = 0, rk0 = 0, rk1 = 0; float w0 = 0.f, w1 = 0.f;
    const int tok = tile * 64 + tid;
    if (tid < 64) {
      const float r = 1.0f / sqrtf(ssL[tid] * (1.0f / 1024.0f) + 1e-6f);
      p.rs[tok] = r;
      const float* L = lg + tid * 48;
      float gl[4];
#pragma unroll
      for (int i = 0; i < 4; ++i) gl[i] = L[i] * r + p.r_group_b[layer * 4 + i];
      int grp = 0; float gm = gl[0];
#pragma unroll
      for (int i = 1; i < 4; ++i) if (gl[i] > gm) { gm = gl[i]; grp = i; }
      float gs = 0.f;
#pragma unroll
      for (int i = 0; i < 4; ++i) gs += expf(gl[i] - gm);
      const float gw = 1.0f / gs;
      float el[8];
#pragma unroll
      for (int i = 0; i < 8; ++i) el[i] = L[4 + grp * 8 + i] * r + p.r_expert_b[layer * 32 + grp * 8 + i];
      int i0 = 0; float v0 = el[0];
#pragma unroll
      for (int i = 1; i < 8; ++i) if (el[i] > v0) { v0 = el[i]; i0 = i; }
      int i1 = (i0 == 0) ? 1 : 0; float v1 = -3e38f;
#pragma unroll
      for (int i = 0; i < 8; ++i) if (i != i0 && el[i] > v1) { v1 = el[i]; i1 = i; }
      const float ex = expf(v1 - v0);
      w0 = gw / (1.0f + ex); w1 = gw * ex / (1.0f + ex);
      e0 = grp * 8 + i0; e1 = grp * 8 + i1;
      rk0 = atomicAdd(&cntL[e0], 1);
      rk1 = atomicAdd(&cntL[e1], 1);
    }
    __syncthreads();
    if (tid < 32) { const int c = cntL[tid]; baseL[tid] = c ? atomicAdd(&gcnt[tid], c) : 0; }
    __syncthreads();
    if (tid < 64) {
      const size_t s0 = (size_t)e0 * T_ + baseL[e0] + rk0, s1 = (size_t)e1 * T_ + baseL[e1] + rk1;
      p.row_tok[s0] = tok * 2;
      p.row_tok[s1] = tok * 2 + 1;
      const float rr = p.rs[tok];
      p.row_aux[s0] = make_float2(w0, rr);
      p.row_aux[s1] = make_float2(w1, rr);
    }
    __syncthreads();
  }
}

DEVI void moe_prefix(const int* gcnt, int* preL) {
  __syncthreads();
  if (get_tid() == 0) {
    int a = 0;
    for (int e = 0; e < 32; ++e) { preL[e] = a; a += (gcnt[e] + 127) >> 7; }
    preL[32] = a;
  }
  __syncthreads();
}
DEVI int find_expert(const int* preL, int rt) {
  int e = 0;
  for (int i = 1; i < 32; ++i) if (preL[i] <= rt) e = i;
  return e;
}

DEVI void moe_gateup_phase(PR p, int layer, char* lds) {
  int* preL = (int*)(lds + 72704 + 512);
  const int* gcnt = p.gcnt + layer * 32;
  moe_prefix(gcnt, preL);
  const int nrt = preL[32];
  float* Cs = (float*)lds;
  XcdIter xi; xi.init();
  const int rlo = (nrt * xi.xcd) >> 3, rhi = (nrt * (xi.xcd + 1)) >> 3;
  const int total = (rhi - rlo) * 4, G = xi.nlb;
  const int nfull_rounds = total / G, left = total - nfull_rounds * G;
  const bool split = (left > 0) && (2 * left <= G);
  const int nfull = split ? nfull_rounds * G : total;
  const int row = get_tid() >> 1, half = get_tid() & 1;
  for (int it = xi.lb; it < nfull + (split ? 2 * left : 0); it += G) {
    const bool ishalf = it >= nfull;
    const int item = ishalf ? nfull + ((it - nfull) >> 1) : it;
    const int ch = (it - nfull) & 1;
    const int rt = rlo + (item >> 2), j = item & 3;
    const int e = find_expert(preL, rt);
    const int blk = rt - preL[e];
    const int valid = min(128, gcnt[e] - blk * 128);
    const int* rtk = p.row_tok + (size_t)e * T_ + blk * 128;
    const float rsc = (row < valid) ? p.row_aux[(size_t)e * T_ + blk * 128 + row].y : 0.f;
    const bf16_t* Wb = p.Wgut + ((size_t)e * 512 + j * 128) * 1024;
    auto arow = [&](int r) { const int tok = (r < valid) ? (rtk[r] >> 1) : 0; return p.xr + (size_t)tok * 1024; };
    if (!ishalf) {
      f32x4 acc[4][4];
      gemm_mainloop<4>(acc, arow, Wb, 1024, 1024, lds);
      acc_to_lds<4>(acc, Cs);
      if (row < valid) {
        bf16_t* dst = p.hbuf + (size_t)(rt * 128 + row) * 256 + j * 64 + half * 32;
#pragma unroll
        for (int i = 0; i < 4; ++i) {
          float hv[8];
#pragma unroll
          for (int q = 0; q < 2; ++q) {
            const f32x4 g = *(const f32x4*)(Cs + row * 132 + half * 32 + i * 8 + q * 4);
            const f32x4 u = *(const f32x4*)(Cs + row * 132 + 64 + half * 32 + i * 8 + q * 4);
#pragma unroll
            for (int c = 0; c < 4; ++c) { const float gg = g[c] * rsc; hv[q * 4 + c] = gg * sigmoidf_(gg) * (u[c] * rsc); }
          }
          u32x4 w; w[0] = pack2(hv[0], hv[1]); w[1] = pack2(hv[2], hv[3]); w[2] = pack2(hv[4], hv[5]); w[3] = pack2(hv[6], hv[7]);
          *(u32x4*)(dst + i * 8) = w;
        }
      }
    } else {
      f32x4 acc[4][2];
      gemm_mainloop2<2>(acc, arow, [&](int r) { return Wb + (size_t)((r < 32) ? (32 * ch + r) : (64 + 32 * ch + (r - 32))) * 1024; }, 1024, lds);
      acc_to_lds<2>(acc, Cs);
      if (row < valid) {
        bf16_t* dst = p.hbuf + (size_t)(rt * 128 + row) * 256 + j * 64 + ch * 32 + half * 16;
#pragma unroll
        for (int i = 0; i < 2; ++i) {
          float hv[8];
#pragma unroll
          for (int q = 0; q < 2; ++q) {
            const f32x4 g = *(const f32x4*)(Cs + row * 68 + half * 16 + i * 8 + q * 4);
            const f32x4 u = *(const f32x4*)(Cs + row * 68 + 32 + half * 16 + i * 8 + q * 4);
#pragma unroll
            for (int c = 0; c < 4; ++c) { const float gg = g[c] * rsc; hv[q * 4 + c] = gg * sigmoidf_(gg) * (u[c] * rsc); }
          }
          u32x4 w; w[0] = pack2(hv[0], hv[1]); w[1] = pack2(hv[2], hv[3]); w[2] = pack2(hv[4], hv[5]); w[3] = pack2(hv[6], hv[7]);
          *(u32x4*)(dst + i * 8) = w;
        }
      }
    }
    __syncthreads();
  }
}

DEVI void moe_down_phase(PR p, int layer, char* lds) {
  int* preL = (int*)(lds + 72704 + 512);
  int* tabA = (int*)(lds + 67584);
  float* tabW = (float*)(lds + 68096);
  const int* gcnt = p.gcnt + layer * 32;
  moe_prefix(gcnt, preL);
  const int nrt = preL[32];
  float* Cs = (float*)lds;
  XcdIter xi; xi.init();
  const int rlo = (nrt * xi.xcd) >> 3, rhi = (nrt * (xi.xcd + 1)) >> 3;
  for (int it = xi.lb; it < (rhi - rlo) * 8; it += xi.nlb) {
    const int rt = rlo + (it >> 3), j = it & 7;
    const int e = find_expert(preL, rt);
    const int blk = rt - preL[e];
    const int valid = min(128, gcnt[e] - blk * 128);
    const int tid = get_tid();
    int a_r = 0; float w_r = 0.f;
    if (tid < valid) { a_r = p.row_tok[(size_t)e * T_ + blk * 128 + tid]; w_r = p.row_aux[(size_t)e * T_ + blk * 128 + tid].x; }
    f32x4 acc[4][4];
    const bf16_t* Ab = p.hbuf + (size_t)rt * 128 * 256;
    gemm_mainloop<4>(acc, [&](int r) { return Ab + (size_t)r * 256; }, p.Wdt + ((size_t)e * 1024 + j * 128) * 256, 256, 256, lds);
    if (tid < 128) { tabA[tid] = a_r; tabW[tid] = w_r; }
    acc_to_lds<4>(acc, Cs);
    const int c4 = tid & 31, r0 = tid >> 5;
#pragma unroll
    for (int i = 0; i < 16; ++i) {
      const int row = r0 + 8 * i;
      if (row < valid) {
        const int a = tabA[row];
        const float w = tabW[row];
        const f32x4 v = *(const f32x4*)(Cs + row * 132 + c4 * 4);
        u32x2 o; o[0] = pack2(v[0] * w, v[1] * w); o[1] = pack2(v[2] * w, v[3] * w);
        *(u32x2*)(p.ybuf + (size_t)a * 1024 + j * 128 + c4 * 4) = o;
      }
    }
    __syncthreads();
  }
}

DEVI void final_phase(PR p) {
  rownorm_phase(p.xr, p.ybuf, nullptr, p.out, nullptr);
}

DEVI void nsa_proj_phase(PR p, char* lds) {
  float* Cs = (float*)lds;
  XcdIter xi; xi.init();
  for (int n = xi.lb; n < 32 * 15; n += xi.nlb) {
    const int grp = n / 160, rem = n - grp * 160;
    const int rl = rem / 5, jn = grp * 5 + (rem - rl * 5);
    const int rt = xi.xcd * 32 + rl;
    f32x4 acc[4][4];
    const bf16_t* Ab = p.hn + (size_t)rt * 128 * 1024;
    gemm_mainloop<4>(acc, [&](int r) { return Ab + (size_t)r * 1024; }, p.W5t + (size_t)jn * 128 * 1024, 1024, 1024, lds);
    acc_to_lds<4>(acc, Cs);
    const int row = get_tid() >> 1, half = get_tid() & 1;
    const int t = rt * 128 + row, b = t >> 11, s = t & 2047;
    const float* cr = Cs + row * 132 + half * 64;
    if (jn == 14) {
      if (half == 0) {
#pragma unroll
        for (int i = 0; i < 12; ++i) {
          const f32x4 c = *(const f32x4*)(cr + i * 4);
          *(float4*)(p.GATES + (size_t)t * 48 + i * 4) = make_float4(sigmoidf_(c[0]), sigmoidf_(c[1]), sigmoidf_(c[2]), sigmoidf_(c[3]));
        }
      }
    } else if (jn == 11 || jn == 13) {
      bf16_t* dst = (jn == 11 ? p.VSt : p.VWt) + ((size_t)(b * 2 + half) * 64) * 2048 + s;
#pragma unroll
      for (int i = 0; i < 16; ++i) {
        const f32x4 c = *(const f32x4*)(cr + i * 4);
#pragma unroll
        for (int e = 0; e < 4; ++e) dst[(size_t)(i * 4 + e) * 2048] = f2bf(c[e]);
      }
    } else {
      const float* gn = nullptr; bf16_t* dst; float osc = 1.0f;
      if (jn < 8) { gn = p.nsa_q_norm; dst = p.Q1 + ((size_t)(b * 16 + jn * 2 + half) * 2048 + s) * 64; osc = 0.125f * LOG2E; }
      else {
        bf16_t* base = (jn == 8) ? p.KC : (jn == 9) ? p.VC : (jn == 10) ? p.KS : p.KW;
        if (jn == 10) gn = p.nsa_k_norm_slc; else if (jn == 12) gn = p.nsa_k_norm_win;
        dst = base + ((size_t)(b * 2 + half) * 2048 + s) * 64;
      }
      float rn = 1.0f;
      if (gn) {
        float ss = 0.f;
#pragma unroll
        for (int i = 0; i < 16; ++i) { const f32x4 c = *(const f32x4*)(cr + i * 4); ss += c[0] * c[0] + c[1] * c[1] + c[2] * c[2] + c[3] * c[3]; }
        rn = osc / sqrtf(ss * (1.0f / 64.0f) + 1e-6f);
      }
#pragma unroll
      for (int i = 0; i < 8; ++i) {
        const f32x4 c0 = *(const f32x4*)(cr + i * 8), c1 = *(const f32x4*)(cr + i * 8 + 4);
        float4 g0 = make_float4(1.f, 1.f, 1.f, 1.f), g1 = g0;
        if (gn) { g0 = *(const float4*)(gn + i * 8); g1 = *(const float4*)(gn + i * 8 + 4); }
        u32x4 w;
        w[0] = pack2(c0[0] * rn * g0.x, c0[1] * rn * g0.y); w[1] = pack2(c0[2] * rn * g0.z, c0[3] * rn * g0.w);
        w[2] = pack2(c1[0] * rn * g1.x, c1[1] * rn * g1.y); w[3] = pack2(c1[2] * rn * g1.z, c1[3] * rn * g1.w);
        *(u32x4*)(dst + i * 8) = w;
      }
    }
    __syncthreads();
  }
}

DEVI void compress_phase(PR p, char* lds) {
  const int tid = get_tid(), lane = tid & 63, wid = tid >> 6, wr = wid >> 1, wc = wid & 1, fr = lane & 15, fq = lane >> 4;
  for (int it = blockIdx.x; it < 64; it += gridDim.x) {
    const int kv = it >> 5, bg = it & 31;
    const bf16_t* base = (kv ? p.VC : p.KC) + (size_t)bg * 2048 * 64;
    const bf16_t* W1 = kv ? p.Wc1vt : p.Wc1kt;
    const bf16_t* W2 = kv ? p.Wc2vt : p.Wc2kt;
    const float* bias = p.bias1 + kv * 128;
    f32x4 acc[4][4];
    gemm_mainloop<4>(acc, [&](int r) { return base + (size_t)min(r, 126) * 1024; }, W1, 2048, 2048, lds);
#pragma unroll
    for (int m = 0; m < 4; ++m)
#pragma unroll
      for (int n = 0; n < 4; ++n)
#pragma unroll
        for (int j = 0; j < 4; ++j) {
          const int row = wr * 64 + m * 16 + fq * 4 + j, col = wc * 64 + n * 16 + fr;
          const float xv = acc[m][n][j] + bias[col];
          const float u2 = 1.5957691216057308f * (xv + 0.044715f * xv * xv * xv);
          const float hv = xv * sigmoidf_(u2);
          const int c = col & 63;
          *(bf16_t*)(lds + (col >> 6) * 16384 + swz(row, c >> 3) + (c & 7) * 2) = f2bf(hv);
        }
#pragma unroll
    for (int i = 0; i < 4; ++i) {
      const int q = tid + 256 * i; const int r = q >> 4, c16 = q & 15;
      *(u32x4*)(lds + 32768 + (c16 >> 3) * 8192 + swz(r, c16 & 7)) = *(const u32x4*)(W2 + (size_t)r * 128 + c16 * 8);
    }
    __syncthreads();
    f32x4 a2[4][2];
#pragma unroll
    for (int m = 0; m < 4; ++m) { a2[m][0] = (f32x4){0.f, 0.f, 0.f, 0.f}; a2[m][1] = (f32x4){0.f, 0.f, 0.f, 0.f}; }
#pragma unroll
    for (int ktile = 0; ktile < 2; ++ktile) mma_stage<2>(lds + ktile * 16384, lds + 32768 + ktile * 8192, a2, wr, wc, fr, fq);
    __syncthreads();
    float* C2 = (float*)lds;
#pragma unroll
    for (int m = 0; m < 4; ++m)
#pragma unroll
      for (int n = 0; n < 2; ++n)
#pragma unroll
        for (int j = 0; j < 4; ++j) C2[(wr * 64 + m * 16 + fq * 4 + j) * 68 + wc * 32 + n * 16 + fr] = a2[m][n][j];
    __syncthreads();
    const int row = tid >> 1, half = tid & 1;
    float v[32];
#pragma unroll
    for (int i = 0; i < 8; ++i) { const f32x4 c = *(const f32x4*)(C2 + row * 68 + half * 32 + i * 4); v[4 * i] = c[0]; v[4 * i + 1] = c[1]; v[4 * i + 2] = c[2]; v[4 * i + 3] = c[3]; }
    if (kv == 0) {
      float ss = 0.f;
#pragma unroll
      for (int i = 0; i < 32; ++i) ss += v[i] * v[i];
      ss += __shfl_xor(ss, 1);
      const float rn = (row < 127) ? 1.0f / sqrtf(ss * (1.0f / 64.0f) + 1e-6f) : 0.f;
      bf16_t* dst = p.KCMP + ((size_t)bg * 128 + row) * 64 + half * 32;
#pragma unroll
      for (int i = 0; i < 4; ++i) {
        u32x4 w;
#pragma unroll
        for (int e = 0; e < 4; ++e) { const int c = 8 * i + 2 * e; w[e] = pack2(v[c] * rn * p.nsa_k_norm_cmp[half * 32 + c], v[c + 1] * rn * p.nsa_k_norm_cmp[half * 32 + c + 1]); }
        *(u32x4*)(dst + i * 8) = w;
      }
    } else {
      const float z = (row < 127) ? 1.0f : 0.f;
      bf16_t* dst = p.VCMPt + ((size_t)bg * 64 + half * 32) * 128 + row;
#pragma unroll
      for (int i = 0; i < 32; ++i) dst[(size_t)i * 128] = f2bf(v[i] * z);
    }
    __syncthreads();
  }
}

DEVI void nsa_stage_tile(char* lds, int st, const bf16_t* Kg  , const bf16_t* Vg  , int vld) {
  const int tid = get_tid();
  char* Ks = lds + st * 18432; char* Vs = Ks + 9216;
#pragma unroll
  for (int i = 0; i < 2; ++i) {
    const int q = tid + 256 * i; const int r = q >> 3, c = q & 7;
    *(u32x4*)(Ks + r * 144 + c * 16) = *(const u32x4*)(Kg + (size_t)r * 64 + c * 8);
    *(u32x4*)(Vs + r * 144 + c * 16) = *(const u32x4*)(Vg + (size_t)r * vld + c * 8);
  }
}

DEVI void out_rmw2(bf16_t* const (&dst)[2], const f32x4 (&o)[4][2], float f0, float f1, bool accumulate) {
  u32x2 w[2][4];
  if (accumulate) {
#pragma unroll
    for (int qt = 0; qt < 2; ++qt)
#pragma unroll
      for (int dt = 0; dt < 4; ++dt) w[qt][dt] = *(const u32x2*)(dst[qt] + dt * 16);
  }
#pragma unroll
  for (int qt = 0; qt < 2; ++qt) {
    const float f = qt ? f1 : f0;
#pragma unroll
    for (int dt = 0; dt < 4; ++dt) {
      float a0 = o[dt][qt][0] * f, a1 = o[dt][qt][1] * f, a2 = o[dt][qt][2] * f, a3 = o[dt][qt][3] * f;
      if (accumulate) { a0 += bflo(w[qt][dt][0]); a1 += bfhi(w[qt][dt][0]); a2 += bflo(w[qt][dt][1]); a3 += bfhi(w[qt][dt][1]); }
      u32x2 r; r[0] = pack2(a0, a1); r[1] = pack2(a2, a3);
      w[qt][dt] = r;
    }
  }
#pragma unroll
  for (int qt = 0; qt < 2; ++qt)
#pragma unroll
    for (int dt = 0; dt < 4; ++dt) *(u32x2*)(dst[qt] + dt * 16) = w[qt][dt];
}

DEVI void nsa_attn_phase(PR p, char* lds) {
  constexpr int STR = 144, STG = 19456;
  constexpr int OSTR = 136;
  const int tid = get_tid(), lane = tid & 63, wid = tid >> 6, fr = lane & 15, fq = lane >> 4;
  float* Ptok = (float*)(lds + 2 * STG);
  unsigned* maskL = (unsigned*)(lds + 2 * STG + 8192);
  char* Ot = lds + 2 * STG + 8192 + 64;
  float cbound;
  {
    float gq = fabsf(p.nsa_q_norm[lane]);
    float gk = fmaxf(fabsf(p.nsa_k_norm_cmp[lane]), fmaxf(fabsf(p.nsa_k_norm_slc[lane]), fabsf(p.nsa_k_norm_win[lane])));
#pragma unroll
    for (int m = 32; m >= 1; m >>= 1) { gq = fmaxf(gq, __shfl_xor(gq, m)); gk = fmaxf(gk, __shfl_xor(gk, m)); }
    cbound = 8.0f * LOG2E * gq * gk * 1.01f;
  }
  XcdIter xi; xi.init();
  for (int n = xi.lb; n < 512; n += xi.nlb) {
    const int bg = xi.xcd * 4 + (n >> 7), b = bg >> 1, g = bg & 1;
    const int tl128 = n & 127;
    const int t0 = (((n >> 6) & 1) ? (127 - (tl128 & 63)) : (tl128 & 63)) * 16;
    const int head = fr & 7;
    const int hg = g * 8 + head;
    const int pbase = p.pos[b * 2048 + t0];
    int tq[2]; float colc[2]; bf16x8 qf[2][2]; bf16x8 qa[2]; float gate[3][2];
    const float slope2 = exp2f(-0.5f * (float)(hg + 1)) * LOG2E;
#pragma unroll
    for (int qt = 0; qt < 2; ++qt) {
      tq[qt] = t0 + 4 * wid + 2 * qt + (fr >> 3);
      colc[qt] = -slope2 * (float)(p.pos[b * 2048 + tq[qt]] - pbase) - cbound;
      qa[qt] = make_qaug(slope2, colc[qt], fq);
      const bf16_t* qp = p.Q1 + ((size_t)(b * 16 + hg) * 2048 + tq[qt]) * 64;
      qf[qt][0] = *(const bf16x8*)(qp + fq * 8);
      qf[qt][1] = *(const bf16x8*)(qp + 32 + fq * 8);
      const float* gp = p.GATES + (size_t)(b * 2048 + tq[qt]) * 48 + hg;
      gate[0][qt] = gp[0]; gate[1][qt] = gp[16]; gate[2][qt] = gp[32];
    }
    char* orow[2];
#pragma unroll
    for (int qt = 0; qt < 2; ++qt) orow[qt] = Ot + (32 * wid + 16 * qt + fr) * OSTR + 8 * fq;
    auto out_acc = [&](const f32x4 (&o)[4][2], float f0, float f1, bool first) {
#pragma unroll
      for (int qt = 0; qt < 2; ++qt) {
        const float f = qt ? f1 : f0;
#pragma unroll
        for (int dt = 0; dt < 4; ++dt) {
          float a0 = o[dt][qt][0] * f, a1 = o[dt][qt][1] * f, a2 = o[dt][qt][2] * f, a3 = o[dt][qt][3] * f;
          if (!first) {
            const u32x2 w = *(const u32x2*)(orow[qt] + dt * 32);
            a0 += bflo(w[0]); a1 += bfhi(w[0]); a2 += bflo(w[1]); a3 += bfhi(w[1]);
          }
          u32x2 r; r[0] = pack2(a0, a1); r[1] = pack2(a2, a3);
          *(u32x2*)(orow[qt] + dt * 32) = r;
        }
      }
    };

    u32x4 rk[2], rv[2]; int rpos = 0;
    const int sr = tid >> 3, sc = tid & 7;
    auto fetch = [&](const bf16_t* Kg, const bf16_t* Vg, int vstride, const int* posg, int pstride, int pmax) {
      rk[0] = *(const u32x4*)(Kg + (size_t)sr * 64 + sc * 8);
      rk[1] = *(const u32x4*)(Kg + (size_t)(sr + 32) * 64 + sc * 8);
      rv[0] = *(const u32x4*)(Vg + (size_t)sr * vstride + sc * 8);
      rv[1] = *(const u32x4*)(Vg + (size_t)(sr + 32) * vstride + sc * 8);
      if (tid < 64) rpos = posg[min(tid * pstride, pmax)];
    };
    auto commit = [&](int st) {
      char* Ks = lds + st * STG; char* Vs = Ks + 9216;
      *(u32x4*)(Ks + sr * 144 + sc * 16) = rk[0];
      *(u32x4*)(Ks + (sr + 32) * 144 + sc * 16) = rk[1];
      *(u32x4*)(Vs + sr * 144 + sc * 16) = rv[0];
      *(u32x4*)(Vs + (sr + 32) * 144 + sc * 16) = rv[1];
      if (tid < 64) *(u32x4*)(Ks + 18432 + tid * 16) = make_kaug((float)(rpos - pbase));
    };
    auto fetch_win = [&](int key0) { PR q = *get_params(); fetch(q.KW + ((size_t)bg * 2048 + key0) * 64, q.VWt + (size_t)bg * 64 * 2048 + key0, 2048, q.pos + b * 2048 + key0, 1, 63); };
    auto fetch_slc = [&](int key0) { PR q = *get_params(); fetch(q.KS + ((size_t)bg * 2048 + key0) * 64, q.VSt + (size_t)bg * 64 * 2048 + key0, 2048, q.pos + b * 2048 + key0, 1, 63); };
    auto fetch_cmp = [&](int tile) { PR q = *get_params(); fetch(q.KCMP + ((size_t)bg * 128 + tile * 64) * 64, q.VCMPt + (size_t)bg * 64 * 128 + tile * 64, 128,
                                                                    q.pos + b * 2048 + 1024 * tile + 31, 16, 2047 - 1024 * tile - 31); };

    int stw;
    {
      __syncthreads();
      f32x4 o[4][2], ol[2];
      ol[0] = (f32x4){0.f, 0.f, 0.f, 0.f}; ol[1] = (f32x4){0.f, 0.f, 0.f, 0.f};
#pragma unroll
      for (int dt = 0; dt < 4; ++dt) { o[dt][0] = (f32x4){0.f, 0.f, 0.f, 0.f}; o[dt][1] = (f32x4){0.f, 0.f, 0.f, 0.f}; }
      const int kfirst = max(0, t0 - 255) >> 6, klast = t0 >> 6;
      stw = (klast - kfirst) & 1;
      fetch_win(kfirst * 64);
      for (int k64 = kfirst; k64 <= klast; ++k64) {
        const int key0 = k64 * 64;
        const int st = (k64 - kfirst) & 1;
        commit(st);
        __syncthreads();
        if (k64 < klast) fetch_win(key0 + 64); else fetch_cmp(0);
        const char* Kc = lds + st * STG;
        f32x4 s[4][2];
        qk_tile_aug<2, STR>(Kc, Kc + 18432, qf, qa, s, fr, fq);
        if (key0 < t0 + 15 - 255 || key0 + 63 > t0) {
#pragma unroll
          for (int kt = 0; kt < 4; ++kt)
#pragma unroll
            for (int j = 0; j < 4; ++j) {
              const int key = key0 + 16 * kt + 4 * fq + j;
#pragma unroll
              for (int qt = 0; qt < 2; ++qt) {
                const unsigned rel = (unsigned)(tq[qt] - key);
                s[kt][qt][j] = (rel < 256u) ? s[kt][qt][j] : NEGBIG;
              }
            }
        }
        exp_tile(s);
        pv_tile_l<STR>(Kc + 9216, s, o, ol, fr, fq);
      }
      {
        const float l0 = ol[0][0], l1 = ol[1][0];
        out_acc(o, (l0 > 0.f) ? gate[2][0] / l0 : 0.f, (l1 > 0.f) ? gate[2][1] / l1 : 0.f, true);
      }
    }

    {
      const int clim[2] = {(tq[0] - 31) >> 4, (tq[1] - 31) >> 4};
      const int sA = stw ^ 1, sB = stw;
      f32x4 ol[2];
      ol[0] = (f32x4){0.f, 0.f, 0.f, 0.f}; ol[1] = (f32x4){0.f, 0.f, 0.f, 0.f};
#pragma unroll
      for (int tl2 = 0; tl2 < 2; ++tl2) {
        const int st = tl2 ? sB : sA;
        commit(st);
        __syncthreads();
        if (tl2 == 0) fetch_cmp(1); else fetch_slc(0);
        f32x4 s[4][2];
        qk_tile_aug<2, STR>(lds + st * STG, lds + st * STG + 18432, qf, qa, s, fr, fq);
#pragma unroll
        for (int kt = 0; kt < 4; ++kt)
#pragma unroll
          for (int j = 0; j < 4; ++j) {
            const int c0 = tl2 * 64 + 16 * kt + 4 * fq + j;
#pragma unroll
            for (int qt = 0; qt < 2; ++qt) s[kt][qt][j] = fast_exp2((c0 <= clim[qt]) ? s[kt][qt][j] : NEGBIG);
          }
        rowsum_tile(s, ol);
      }
      float linv[2];
#pragma unroll
      for (int qt = 0; qt < 2; ++qt) { const float r = ol[qt][0]; linv[qt] = (r > 0.f) ? 1.0f / r : 0.f; }
      f32x4 o[4][2];
#pragma unroll
      for (int dt = 0; dt < 4; ++dt) { o[dt][0] = (f32x4){0.f, 0.f, 0.f, 0.f}; o[dt][1] = (f32x4){0.f, 0.f, 0.f, 0.f}; }
#pragma unroll
      for (int tl2 = 0; tl2 < 2; ++tl2) {
        const int st = tl2 ? sB : sA;
        f32x4 s[4][2];
        qk_tile_aug<2, STR>(lds + st * STG, lds + st * STG + 18432, qf, qa, s, fr, fq);
#pragma unroll
        for (int kt = 0; kt < 4; ++kt)
#pragma unroll
          for (int j = 0; j < 4; ++j) {
            const int c0 = tl2 * 64 + 16 * kt + 4 * fq + j;
#pragma unroll
            for (int qt = 0; qt < 2; ++qt) s[kt][qt][j] = fast_exp2((c0 <= clim[qt]) ? s[kt][qt][j] : NEGBIG);
          }
        pv_tile<STR>(lds + st * STG + 9216, s, o, fr, fq);
#pragma unroll
        for (int qt = 0; qt < 2; ++qt) {
          const int tl = 4 * wid + 2 * qt + (fr >> 3);
#pragma unroll
          for (int kt = 0; kt < 4; ++kt) {
            f32x4 hs;
#pragma unroll
            for (int j = 0; j < 4; ++j) hs[j] = head8_sum(s[kt][qt][j] * linv[qt]);
            if (head == 0) *(f32x4*)(Ptok + tl * 128 + tl2 * 64 + 16 * kt + 4 * fq) = hs;
          }
        }
      }
      out_acc(o, gate[0][0] * linv[0], gate[0][1] * linv[1], false);
      __syncthreads();
      const int cur = t0 >> 6;
      const int j = tid & 31;
#pragma unroll
      for (int i = 0; i < 2; ++i) {
        const int tl = (tid >> 5) + 8 * i;
        float im = 0.f;
        for (int c = max(4 * j - 1, 0); c <= 4 * j + 3; ++c) im += Ptok[tl * 128 + c];
        const bool forced = (j == 0) || (j == cur) || (j == cur - 1);
        const float v = forced ? 1e4f : ((j <= cur) ? im : -1.0f);
        unsigned key = ((v < 0.f) ? 0u : (__float_as_uint(v) | 0x80000000u));
        key = (key & ~31u) | (unsigned)(31 - j);
        bool sel = false;
#pragma unroll
        for (int rnd = 0; rnd < 8; ++rnd) {
          unsigned m = key;
          m = max(m, (unsigned)__builtin_amdgcn_update_dpp(0, (int)m, 0xB1, 0xF, 0xF, true));
          m = max(m, (unsigned)__builtin_amdgcn_update_dpp(0, (int)m, 0x4E, 0xF, 0xF, true));
          m = max(m, (unsigned)__builtin_amdgcn_update_dpp(0, (int)m, 0x141, 0xF, 0xF, true));
          m = max(m, (unsigned)__builtin_amdgcn_update_dpp(0, (int)m, 0x140, 0xF, 0xF, true));
          m = max(m, (unsigned)__shfl_xor((int)m, 16));
          const bool win = (key == m);
          sel = sel || win;
          key = win ? 0u : key;
        }
        const unsigned long long bal = __ballot(sel);
        if (j == 0) maskL[tl] = (unsigned)(bal >> (lane & 32));
      }
      __syncthreads();
    }

    {
      const int cur = t0 >> 6;
      const unsigned curmask = (cur >= 31) ? 0xffffffffu : ((2u << cur) - 1u);
      unsigned um = 0u;
#pragma unroll
      for (int i = 0; i < 16; ++i) um |= maskL[i];
      um &= curmask;
      unsigned mq[2];
#pragma unroll
      for (int qt = 0; qt < 2; ++qt) mq[qt] = maskL[4 * wid + 2 * qt + (fr >> 3)];
      const unsigned wm = (maskL[4 * wid] | maskL[4 * wid + 1] | maskL[4 * wid + 2] | maskL[4 * wid + 3]) & curmask;
      f32x4 o[4][2], ol[2];
      ol[0] = (f32x4){0.f, 0.f, 0.f, 0.f}; ol[1] = (f32x4){0.f, 0.f, 0.f, 0.f};
#pragma unroll
      for (int dt = 0; dt < 4; ++dt) { o[dt][0] = (f32x4){0.f, 0.f, 0.f, 0.f}; o[dt][1] = (f32x4){0.f, 0.f, 0.f, 0.f}; }
      unsigned rem = um;
      for (int step = 0; rem != 0u; ++step) {
        const int jb = __builtin_ctz(rem); rem &= rem - 1u;
        const int key0 = jb * 64;
        const int st = step & 1;
        commit(st);
        __syncthreads();
        if (rem != 0u) fetch_slc(__builtin_ctz(rem) * 64);
        if ((wm >> jb) & 1u) {
          const char* Kc = lds + st * STG;
          f32x4 s[4][2];
          bf16x8 qs[2];
          qs[0] = make_qaug(slope2, ((mq[0] >> jb) & 1u) ? colc[0] : NEGBIG, fq);
          qs[1] = make_qaug(slope2, ((mq[1] >> jb) & 1u) ? colc[1] : NEGBIG, fq);
          qk_tile_aug<2, STR>(Kc, Kc + 18432, qf, qs, s, fr, fq);
          {
#pragma unroll
            for (int kt = 0; kt < 4; ++kt)
#pragma unroll
              for (int j = 0; j < 4; ++j) {
                const int key = key0 + 16 * kt + 4 * fq + j;
#pragma unroll
                for (int qt = 0; qt < 2; ++qt) s[kt][qt][j] = (key <= tq[qt]) ? s[kt][qt][j] : NEGBIG;
              }
          }
          exp_tile(s);
          pv_tile_l<STR>(Kc + 9216, s, o, ol, fr, fq);
        }
      }
      {
        const float l0 = ol[0][0], l1 = ol[1][0];
        out_acc(o, (l0 > 0.f) ? gate[1][0] / l0 : 0.f, (l1 > 0.f) ? gate[1][1] / l1 : 0.f, false);
      }
    }
    {
      const int c16 = lane & 7;
#pragma unroll
      for (int i = 0; i < 4; ++i) {
        const int r = (lane >> 3) + 8 * i;
        const int tok = t0 + 4 * wid + 2 * (r >> 4) + ((r & 15) >> 3), hh = g * 8 + (r & 7);
        const char* src = Ot + (32 * wid + r) * OSTR + c16 * 16;
        const u32x2 lo = *(const u32x2*)(src), hi = *(const u32x2*)(src + 8);
        *(u32x4*)(p.hn + (size_t)(b * 2048 + tok) * 1024 + hh * 64 + c16 * 8) = (u32x4){lo[0], lo[1], hi[0], hi[1]};
      }
    }
    __syncthreads();
  }
}

DEVI void misc_init(PR p) {
  if (blockIdx.x >= gridDim.x - 9 && blockIdx.x < gridDim.x - 1) {
    const int part = blockIdx.x - (gridDim.x - 9);
    const int layer = part >> 2, k = (part & 3) * 256 + get_tid();
    const float g = p.norm_ffn[layer * 1024 + k];
    for (int n = 0; n < 48; ++n) {
      float w = 0.f;
      if (n < 4) w = p.r_group[((size_t)layer * 1024 + k) * 4 + n];
      else if (n < 36) w = p.r_expert[((size_t)layer * 1024 + k) * 32 + (n - 4)];
      w *= g;
      const float hi = bf_round(w);
      p.RWh[((size_t)layer * 48 + n) * 1024 + k] = f2bf(hi);
      p.RWl[((size_t)layer * 48 + n) * 1024 + k] = f2bf(w - hi);
    }
  }
  if (blockIdx.x == gridDim.x - 1) {
    const int tid = get_tid();
    if (tid < 64) p.gcnt[tid] = 0;
    const int kv = tid >> 7, n = tid & 127;
    const float* pe = kv ? p.cmp_pe_v : p.cmp_pe_k;
    const float* w1 = kv ? p.cmp_w1_v : p.cmp_w1_k;
    float a = 0.f;
    for (int i = 0; i < 2048; ++i) a += pe[i] * w1[(size_t)i * 128 + n];
    p.bias1[tid] = a;
  }
}


#define XB_TMO      128
#define XB_XCNT(j)  (256  + 64 * (j))
#define XB_XSUB(j)  (1280 + 64 * (j))
#define XB_XGEN(j)  (2304 + 64 * (j))
#define XB_TOP      3328
#define XB_TOPGEN   3392
#define XCD_BAR_WORDS 3456
#define XB_SPIN_CAP (1u << 20)
#define LAS __attribute__((address_space(3)))
DEVI unsigned xb_ld(unsigned* p) { return __hip_atomic_load(p, __ATOMIC_RELAXED, __HIP_MEMORY_SCOPE_AGENT); }
DEVI unsigned xb_add(unsigned* p, unsigned v) { return __hip_atomic_fetch_add(p, v, __ATOMIC_RELAXED, __HIP_MEMORY_SCOPE_AGENT); }
DEVI unsigned xb_xcc_id() { return (unsigned)__builtin_amdgcn_s_getreg((3 << 11) | 20) & 0xFu; }
#define XB_SPIN(cond, bar) do { unsigned _sp = 0; while (cond) { __builtin_amdgcn_s_sleep(1); \
    if ((++_sp & 255u) == 0u) { if (xb_ld(&(bar)[XB_TMO])) break; if (_sp > XB_SPIN_CAP) { atomicAdd(&(bar)[XB_TMO], 1u); break; } } } } while (0)
struct XcdBarrier { unsigned* bar; unsigned x; volatile LAS unsigned* st; };
DEVI XcdBarrier xcd_barrier_post(unsigned* bar, volatile LAS unsigned* st) {
  XcdBarrier b; b.bar = bar; b.x = xb_xcc_id(); b.st = st;
  if (threadIdx.x == 0) (void)xb_add(&bar[XB_XCNT(b.x)], 1u);
  return b;
}
DEVI void xcd_barrier_complete(unsigned* bar, unsigned x, unsigned& nloc, unsigned& nx) {
  const unsigned G = gridDim.x * gridDim.y * gridDim.z;
  unsigned sum, cnt, mine, sp = 0u;
  for (;;) {
    sum = 0u; cnt = 0u; mine = 0u;
#pragma unroll
    for (unsigned j = 0; j < 16; ++j) { const unsigned c = xb_ld(&bar[XB_XCNT(j)]); sum += c; cnt += (c > 0u) ? 1u : 0u; mine = (j == x) ? c : mine; }
    if (sum == G) break;
    __builtin_amdgcn_s_sleep(1);
    if ((++sp & 255u) == 0u) { if (xb_ld(&bar[XB_TMO])) break; if (sp > XB_SPIN_CAP) { atomicAdd(&bar[XB_TMO], 1u); break; } }
  }
  nloc = mine > 0u ? mine : 1u; nx = cnt > 0u ? cnt : 1u;
}
DEVI void xcd_barrier(const XcdBarrier& b) {
  asm volatile("s_waitcnt vmcnt(0)" ::: "memory");
  __syncthreads();
  if (threadIdx.x == 0) {
    unsigned* bar = b.bar;
    __builtin_amdgcn_s_waitcnt(0);
    unsigned nloc = b.st[0], nx = b.st[1];
    if (nloc == 0u) { xcd_barrier_complete(bar, b.x, nloc, nx); b.st[0] = nloc; b.st[1] = nx; }
    const unsigned old = xb_add(&bar[XB_XSUB(b.x)], 1u);
    const unsigned gen = old / nloc;
    if (old + 1u == (gen + 1u) * nloc) {
      __builtin_amdgcn_fence(__ATOMIC_RELEASE, "agent");
      asm volatile("s_waitcnt vmcnt(0)" ::: "memory");
      const unsigned og = xb_add(&bar[XB_TOP], 1u);
      const unsigned tg = og / nx;
      if (og + 1u == (tg + 1u) * nx) xb_add(&bar[XB_TOPGEN], 1u);
      else XB_SPIN(xb_ld(&bar[XB_TOPGEN]) == tg, bar);
      __builtin_amdgcn_fence(__ATOMIC_ACQUIRE, "agent");
      xb_add(&bar[XB_XGEN(b.x)], 1u);
      asm volatile("s_waitcnt vmcnt(0)" ::: "memory");
    } else {
      XB_SPIN(xb_ld(&bar[XB_XGEN(b.x)]) == gen, bar);
      __builtin_amdgcn_fence(__ATOMIC_ACQUIRE, "agent");
      asm volatile("s_waitcnt vmcnt(0)" ::: "memory");
    }
  }
  __syncthreads();
}

#ifndef PROBE_PHASE
#define PROBE_PHASE -1
#endif
#define GSYNC() do { if (use_cg) grid.sync(); else xcd_barrier(xb); } while (0)
__global__ void __launch_bounds__(256, 2) mega_kernel(Params p_unused) {
  extern __shared__ __attribute__((aligned(16))) char lds[];
  cg::grid_group grid = cg::this_grid();
  volatile LAS unsigned* xst = (volatile LAS unsigned*)(lds + LDS_BYTES - 16);
  if (threadIdx.x == 0) { xst[0] = 0u; xst[1] = 0u; }
  __syncthreads();
  unsigned* barw; int use_cg;
  { PR p = *get_params(); barw = p.bar; use_cg = p.use_cg; }
  const XcdBarrier xb = xcd_barrier_post(barw, xst);
  { PR p = *get_params(); conv_weights_phase(p, 0, p.njobsA, p.ntilesA, lds); }
  { PR p = *get_params(); rownorm_phase(p.x, nullptr, p.norm_mix, (float*)nullptr, p.hn); }
  { PR p = *get_params(); misc_init(p); }
  GSYNC();
#if PROBE_PHASE == 0
  { PR p = *get_params(); conv_weights_phase(p, 0, p.njobsA, p.ntilesA, lds); }
  { PR p = *get_params(); rownorm_phase(p.x, nullptr, p.norm_mix, (float*)nullptr, p.hn); }
  GSYNC();
#endif
  { PR p = *get_params(); gemm_bf16out_phase(p.hn, 1024, p.W1t, 1024, 12, p.proj0, 1440, 1440, lds); }
  { PR p = *get_params(); conv_weights_phase(p, p.njobsA, p.njobs0, p.ntiles0, lds); }
  GSYNC();
#if PROBE_PHASE == 1
  { PR p = *get_params(); gemm_bf16out_phase(p.hn, 1024, p.W1t, 1024, 12, p.proj0, 1440, 1440, lds); }
  GSYNC();
#endif
  { PR p = *get_params(); l0_phase2(p, lds); }
  GSYNC();
#if PROBE_PHASE == 2
  { PR p = *get_params(); l0_phase2(p, lds); }
  GSYNC();
#endif
  { PR p = *get_params(); mla_attn_phase(p, lds); }
  GSYNC();
#if PROBE_PHASE == 3
  { PR p = *get_params(); mla_attn_phase(p, lds); }
  GSYNC();
#endif
  { PR p = *get_params(); gemm_resid_phase(p.hn, p.Wo0t, p.x, p.xr, lds); }
  GSYNC();
#if PROBE_PHASE == 4
  { PR p = *get_params(); gemm_resid_phase(p.hn, p.Wo0t, p.x, p.xr, lds); }
  GSYNC();
#endif
#if PROBE_PHASE == 5
  { PR p = *get_params(); router_phase(p, 1, lds); }
  GSYNC();
  { PR p = *get_params(); if (blockIdx.x == 0 && threadIdx.x < 32) p.gcnt[32 + threadIdx.x] = 0; }
#endif
  { PR p = *get_params(); router_phase(p, 0, lds); }
  GSYNC();
  { PR p = *get_params(); moe_gateup_phase(p, 0, lds); }
  GSYNC();
#if PROBE_PHASE == 6
  { PR p = *get_params(); moe_gateup_phase(p, 0, lds); }
  GSYNC();
#endif
  { PR p = *get_params(); moe_down_phase(p, 0, lds); }
  GSYNC();
#if PROBE_PHASE == 7
  { PR p = *get_params(); moe_down_phase(p, 0, lds); }
  GSYNC();
#endif
  { PR p = *get_params(); rownorm_phase(p.xr, p.ybuf, p.norm_mix + 1024, p.xr, p.hn); }
  GSYNC();
  { PR p = *get_params(); nsa_proj_phase(p, lds); }
  GSYNC();
#if PROBE_PHASE == 9
  { PR p = *get_params(); nsa_proj_phase(p, lds); }
  GSYNC();
#endif
  { PR p = *get_params(); compress_phase(p, lds); }
  { PR p = *get_params(); conv_weights_phase(p, p.njobs1_begin, p.njobs1_begin + 3, p.ntiles1, lds); }
  GSYNC();
#if PROBE_PHASE == 10
  { PR p = *get_params(); compress_phase(p, lds); }
  GSYNC();
#endif
  { PR p = *get_params(); nsa_attn_phase(p, lds); }
  GSYNC();
#if PROBE_PHASE == 11
  { PR p = *get_params(); nsa_attn_phase(p, lds); }
  GSYNC();
#endif
  { PR p = *get_params(); gemm_resid_phase(p.hn, p.Wo1t, p.xr, p.xr, lds); }
  GSYNC();
  { PR p = *get_params(); router_phase(p, 1, lds); }
  GSYNC();
  { PR p = *get_params(); moe_gateup_phase(p, 1, lds); }
  GSYNC();
  { PR p = *get_params(); moe_down_phase(p, 1, lds); }
  GSYNC();
  { PR p = *get_params(); final_phase(p); }
}

static inline size_t align_up(size_t v, size_t a) { return (v + a - 1) / a * a; }

extern "C" void kernel_launch(void* const* d_in, const int* in_sizes, int n_in, void* d_out, int out_size, void* d_ws, size_t ws_size,
                              hipStream_t stream) {
  (void)in_sizes; (void)n_in; (void)out_size;
  Params p;
  memset(&p, 0, sizeof(p));
  const float* const* in = (const float* const*)d_in;
  p.x = in[0]; p.pos = (const int*)d_in[1]; p.norm_mix = in[2]; p.norm_ffn = in[3];
  const float* mix0_w_in = in[4]; const float* mla_q_a_norm = in[5]; const float* mla_w_uq = in[6];
  const float* mla_kv_a_norm = in[7]; const float* mla_w_ukv = in[8];
  p.mla_q_norm = in[9]; p.mla_k_norm = in[10];
  p.conv_dw_w = in[11]; p.conv_dw_b = in[12]; p.conv_ln_g = in[13]; p.conv_ln_b = in[14];
  const float* mix0_w_out = in[15]; const float* nsa_w_in = in[16];
  p.nsa_q_norm = in[17]; p.nsa_k_norm_cmp = in[18]; p.nsa_k_norm_slc = in[19]; p.nsa_k_norm_win = in[20];
  p.cmp_pe_k = in[21]; p.cmp_w1_k = in[22]; const float* cmp_w2_k = in[23];
  p.cmp_pe_v = in[24]; p.cmp_w1_v = in[25]; const float* cmp_w2_v = in[26];
  const float* nsa_w_out = in[27];
  p.r_group = in[28]; p.r_group_b = in[29]; p.r_expert = in[30]; p.r_expert_b = in[31];
  const float* w_gate = in[32]; const float* w_up = in[33]; const float* w_down = in[34];
  p.out = (float*)d_out;

  char* ws = (char*)d_ws; size_t off = 0;
  auto take = [&](size_t bytes) { char* r = ws + off; off = align_up(off + bytes, 256); return r; };
  p.W1t = (bf16_t*)take((size_t)1536 * 1024 * 2);
  p.Wuqt = (bf16_t*)take((size_t)768 * 256 * 2);
  p.Wukvt = (bf16_t*)take((size_t)1024 * 128 * 2);
  p.Wo0t = (bf16_t*)take((size_t)1024 * 1024 * 2);
  p.W5t = (bf16_t*)take((size_t)1920 * 1024 * 2);
  p.Wc1kt = (bf16_t*)take((size_t)128 * 2048 * 2);
  p.Wc1vt = (bf16_t*)take((size_t)128 * 2048 * 2);
  p.Wc2kt = (bf16_t*)take((size_t)64 * 128 * 2);
  p.Wc2vt = (bf16_t*)take((size_t)64 * 128 * 2);
  p.Wo1t = (bf16_t*)take((size_t)1024 * 1024 * 2);
  p.Wgut = (bf16_t*)take((size_t)32 * 512 * 1024 * 2);
  p.Wdt = (bf16_t*)take((size_t)32 * 1024 * 256 * 2);
  p.xr = (bf16_t*)take((size_t)T_ * 1024 * 2);
  p.hn = (bf16_t*)take((size_t)T_ * 1024 * 2);
  p.RWh = (bf16_t*)take((size_t)2 * 48 * 1024 * 2);
  p.RWl = (bf16_t*)take((size_t)2 * 48 * 1024 * 2);
  p.rs = (float*)take((size_t)T_ * 4);
  p.row_aux = (float2*)take((size_t)32 * T_ * 8);
  p.row_tok = (int*)take((size_t)32 * T_ * 4);
  p.gcnt = (int*)take(256);
  p.bias1 = (float*)take(1024);
  p.bar = (unsigned*)take((size_t)XCD_BAR_WORDS * 4);
  p.use_cg = 0;
  p.KCMP = (bf16_t*)take((size_t)32 * 128 * 64 * 2);
  p.VCMPt = (bf16_t*)take((size_t)32 * 64 * 128 * 2);
  char* scr = ws + off;
  {
    size_t o = 0;
    auto tk = [&](size_t bytes) { char* r = scr + o; o = align_up(o + bytes, 256); return r; };
    p.proj0 = (bf16_t*)tk((size_t)T_ * 1440 * 2);
    p.Q0 = (bf16_t*)tk((size_t)T_ * 768 * 2);
    p.K0 = (bf16_t*)tk((size_t)T_ * 768 * 2);
    p.V0t = (bf16_t*)tk((size_t)T_ * 512 * 2);
  }
  {
    size_t o = 0;
    auto tk = [&](size_t bytes) { char* r = scr + o; o = align_up(o + bytes, 256); return r; };
    p.ybuf = (bf16_t*)tk((size_t)2 * T_ * 1024 * 2);
    p.hbuf = (bf16_t*)tk((size_t)(2 * T_ + 4096) * 256 * 2);
  }
  {
    size_t o = 0;
    auto tk = [&](size_t bytes) { char* r = scr + o; o = align_up(o + bytes, 256); return r; };
    p.Q1 = (bf16_t*)tk((size_t)T_ * 1024 * 2);
    p.KC = (bf16_t*)tk((size_t)T_ * 128 * 2);
    p.VC = (bf16_t*)tk((size_t)T_ * 128 * 2);
    p.KS = (bf16_t*)tk((size_t)T_ * 128 * 2);
    p.VSt = (bf16_t*)tk((size_t)T_ * 128 * 2);
    p.KW = (bf16_t*)tk((size_t)T_ * 128 * 2);
    p.VWt = (bf16_t*)tk((size_t)T_ * 128 * 2);
    p.GATES = (float*)tk((size_t)T_ * 48 * 4);
  }
  const size_t need = off + (size_t)T_ * (1440 + 768 + 768 + 512) * 2 + 4096;
  if (need > ws_size) { fprintf(stderr, "workspace too small: need %zu have %zu\n", need, ws_size); return; }
  for (int i = 0; i < 16; ++i) p.inv_freq[i] = (float)pow(10000.0, -(double)i / 16.0);

  int nj = 0, tiles = 0;
  auto add = [&](const float* src, bf16_t* dst, const float* gain, int K, int N, int Npad, int mode, int batch, long long ss, long long ds) {
    ConvJob& j = p.jobs[nj++];
    j.src = src; j.dst = dst; j.gain = gain; j.K = K; j.N = N; j.Npad = Npad; j.mode = mode; j.batch = batch; j.tile_start = tiles; j.pad0 = 0;
    j.sstride = ss; j.dstride = ds;
    tiles += batch * (K / 64) * (Npad / 64);
  };
  add(mix0_w_in, p.W1t, nullptr, 1024, 1440, 1536, 0, 1, 0, 0);
  add(mla_w_uq, p.Wuqt, mla_q_a_norm, 256, 768, 768, 0, 1, 0, 0);
  add(mla_w_ukv, p.Wukvt, mla_kv_a_norm, 128, 1024, 1024, 0, 1, 0, 0);
  add(mix0_w_out, p.Wo0t, nullptr, 1024, 1024, 1024, 0, 1, 0, 0);
  add(nsa_w_in, p.W5t, nullptr, 1024, 1840, 1920, 0, 1, 0, 0);
  add(p.cmp_w1_k, p.Wc1kt, nullptr, 2048, 128, 128, 0, 1, 0, 0);
  add(p.cmp_w1_v, p.Wc1vt, nullptr, 2048, 128, 128, 0, 1, 0, 0);
  add(cmp_w2_k, p.Wc2kt, nullptr, 128, 64, 64, 0, 1, 0, 0);
  add(cmp_w2_v, p.Wc2vt, nullptr, 128, 64, 64, 0, 1, 0, 0);
  add(nsa_w_out, p.Wo1t, nullptr, 1024, 1024, 1024, 0, 1, 0, 0);
  p.njobsA = nj; p.ntilesA = tiles;
  tiles = 0;
  add(w_gate, p.Wgut, p.norm_ffn, 1024, 256, 256, 1, 32, 1024LL * 256, 512LL * 1024);
  add(w_up, p.Wgut, p.norm_ffn, 1024, 256, 256, 2, 32, 1024LL * 256, 512LL * 1024);
  add(w_down, p.Wdt, nullptr, 256, 1024, 1024, 0, 32, 256LL * 1024, 1024LL * 256);
  p.njobs0 = nj; p.ntiles0 = tiles;
  p.njobs1_begin = nj;
  tiles = 0;
  const size_t l1 = (size_t)32 * 1024 * 256;
  add(w_gate + l1, p.Wgut, p.norm_ffn + 1024, 1024, 256, 256, 1, 32, 1024LL * 256, 512LL * 1024);
  add(w_up + l1, p.Wgut, p.norm_ffn + 1024, 1024, 256, 256, 2, 32, 1024LL * 256, 512LL * 1024);
  add(w_down + l1, p.Wdt, nullptr, 256, 1024, 1024, 0, 32, 256LL * 1024, 1024LL * 256);
  p.ntiles1 = tiles;

  static int grid_blocks = 0;
  if (!grid_blocks) {
    (void)hipFuncSetAttribute((const void*)mega_kernel, hipFuncAttributeMaxDynamicSharedMemorySize, LDS_BYTES);
    int dev = 0, cus = 0, per_cu = 0;
    (void)hipGetDevice(&dev);
    (void)hipDeviceGetAttribute(&cus, hipDeviceAttributeMultiprocessorCount, dev);
    (void)hipOccupancyMaxActiveBlocksPerMultiprocessor(&per_cu, mega_kernel, 256, LDS_BYTES);
    if (per_cu > 2) per_cu = 2;
    if (per_cu < 1) per_cu = 1;
    grid_blocks = cus * per_cu;
  }
  (void)hipMemsetAsync(p.bar, 0, (size_t)XCD_BAR_WORDS * 4, stream);
  void* args[] = {&p};
  hipError_t e = hipLaunchCooperativeKernel((const void*)mega_kernel, dim3(grid_blocks), dim3(256), args, LDS_BYTES, stream);
  if (e != hipSuccess) fprintf(stderr, "cooperative launch failed: %s (grid %d)\n", hipGetErrorString(e), grid_blocks);
}
```

```cpp
#include <hip/hip_runtime.h>
#include <hip/hip_cooperative_groups.h>
#include <stdint.h>
#include <math.h>
#include <stdio.h>
#include <string.h>
namespace cg = cooperative_groups;

typedef unsigned short bf16_t;
typedef short bf16x8 __attribute__((ext_vector_type(8)));
typedef float f32x4 __attribute__((ext_vector_type(4)));
typedef unsigned u32x4 __attribute__((ext_vector_type(4)));
typedef unsigned u32x2 __attribute__((ext_vector_type(2)));

#define DEVI __device__ __forceinline__
#define AS4 __attribute__((address_space(4)))

constexpr int T_ = 32768;
constexpr int S_ = 2048;
constexpr int LDS_BYTES = 73728;
constexpr float LOG2E = 1.4426950408889634f;
constexpr float NEGBIG = -1e30f;

struct ConvJob {
  const float* src; bf16_t* dst; const float* gain;
  int K, N, Npad, mode, batch, tile_start, pad0;
  long long sstride, dstride;
};
constexpr int MAXJOBS = 16;

struct Params {
  const float* x; const int* pos; const float* norm_mix; const float* norm_ffn;
  const float* mla_q_norm; const float* mla_k_norm;
  const float* conv_dw_w; const float* conv_dw_b; const float* conv_ln_g; const float* conv_ln_b;
  const float* nsa_q_norm; const float* nsa_k_norm_cmp; const float* nsa_k_norm_slc; const float* nsa_k_norm_win;
  const float* cmp_pe_k; const float* cmp_w1_k; const float* cmp_pe_v; const float* cmp_w1_v;
  const float* r_group; const float* r_group_b; const float* r_expert; const float* r_expert_b;
  float* out;
  bf16_t* W1t; bf16_t* Wuqt; bf16_t* Wukvt; bf16_t* Wo0t; bf16_t* W5t;
  bf16_t* Wc1kt; bf16_t* Wc1vt; bf16_t* Wc2kt; bf16_t* Wc2vt; bf16_t* Wo1t;
  bf16_t* Wgut; bf16_t* Wdt;
  bf16_t* xr;
  bf16_t* hn;
  bf16_t* proj0; bf16_t* Q0; bf16_t* K0; bf16_t* V0t;
  bf16_t* hbuf;
  bf16_t* Q1; bf16_t* KC; bf16_t* VC; bf16_t* KS; bf16_t* VSt; bf16_t* KW; bf16_t* VWt; float* GATES;
  bf16_t* KCMP; bf16_t* VCMPt;
  bf16_t* RWh; bf16_t* RWl; float* rs; float2* row_aux; int* row_tok; int* gcnt; float* bias1; unsigned* bar;
  int* pair_tok; int2* pair_rk; int* gcntP;
  float inv_freq[16];
  ConvJob jobs[MAXJOBS];
  int njobs0, ntiles0, njobs1_begin, ntiles1, use_cg, njobsA, ntilesA, pad3;
};

typedef const AS4 Params& PR;
DEVI const AS4 Params* get_params() {
  const AS4 Params* kp = (const AS4 Params*)__builtin_amdgcn_kernarg_segment_ptr();
  asm volatile("" : "+s"(kp));
  return kp;
}

DEVI int get_tid() { int t = threadIdx.x; asm volatile("" : "+v"(t)); return t; }

typedef float f32x2_ __attribute__((ext_vector_type(2)));
typedef __bf16 bf16x2_ __attribute__((ext_vector_type(2)));
DEVI unsigned pack2(float lo, float hi) { const f32x2_ v = {lo, hi}; return __builtin_bit_cast(unsigned, __builtin_convertvector(v, bf16x2_)); }
DEVI float bflo(unsigned w) { return __uint_as_float(w << 16); }
DEVI float bfhi(unsigned w) { return __uint_as_float(w & 0xffff0000u); }
DEVI float bf2f(bf16_t h) { return __uint_as_float(((unsigned)h) << 16); }
DEVI bf16_t f2bf(float f) { return (bf16_t)(pack2(f, 0.f) & 0xffffu); }
DEVI float fast_exp2(float x) { return __builtin_amdgcn_exp2f(x); }
DEVI float fast_rcp(float x) { return __builtin_amdgcn_rcpf(x); }
DEVI float sigmoidf_(float x) { return fast_rcp(1.0f + fast_exp2(-x * LOG2E)); }
DEVI float wave_sum(float v) {
  v += __shfl_xor(v, 32); v += __shfl_xor(v, 16); v += __shfl_xor(v, 8);
  v += __shfl_xor(v, 4); v += __shfl_xor(v, 2); v += __shfl_xor(v, 1); return v;
}
DEVI void sincos_rev(float ang, float& s, float& c) {
  float rev = ang * 0.15915494309189535f;
  rev = rev - floorf(rev);
  s = __builtin_amdgcn_sinf(rev); c = __builtin_amdgcn_cosf(rev);
}

struct XcdIter {
  int xcd, lb, nlb;
  DEVI void init() { xcd = blockIdx.x & 7; lb = blockIdx.x >> 3; nlb = gridDim.x >> 3; }
};

DEVI int swz(int r, int c16) { return r * 128 + ((c16 ^ ((r >> 1) & 7)) << 4); }

template <int NT>
DEVI void mma_stage(const char* As, const char* Bs, f32x4 (&acc)[4][NT], int wr, int wc, int fr, int fq) {
  bf16x8 a[2][4], b[2][NT];
#pragma unroll
  for (int ks = 0; ks < 2; ++ks) {
#pragma unroll
    for (int m = 0; m < 4; ++m) a[ks][m] = *(const bf16x8*)(As + swz(wr * 64 + m * 16 + fr, ks * 4 + fq));
#pragma unroll
    for (int n = 0; n < NT; ++n) b[ks][n] = *(const bf16x8*)(Bs + swz(wc * (NT * 16) + n * 16 + fr, ks * 4 + fq));
  }
  __builtin_amdgcn_sched_barrier(0);
#pragma unroll
  for (int ks = 0; ks < 2; ++ks) {
#pragma unroll
    for (int m = 0; m < 4; ++m)
#pragma unroll
      for (int n = 0; n < NT; ++n) acc[m][n] = __builtin_amdgcn_mfma_f32_16x16x32_bf16(a[ks][m], b[ks][n], acc[m][n], 0, 0, 0);
    __builtin_amdgcn_sched_barrier(0);
  }
}

template <int NT, class ARow, class BRow>
DEVI void gemm_mainloop2(f32x4 (&acc)[4][NT], ARow arow, BRow brow, int K, char* lds);

template <int NT, class ARow>
DEVI void gemm_mainloop(f32x4 (&acc)[4][NT], ARow arow, const bf16_t* __restrict__ Bt, int ldb, int K, char* lds) {
  gemm_mainloop2<NT>(acc, arow, [&](int r) { return Bt + (size_t)r * ldb; }, K, lds);
}

template <int NT, class ARow, class BRow>
DEVI void gemm_mainloop2(f32x4 (&acc)[4][NT], ARow arow, BRow brow, int K, char* lds) {
  constexpr int NBR = NT;
  constexpr int STAGE = 16384 + NT * 32 * 128;
  const int tid = get_tid(), lane = tid & 63, wid = tid >> 6, wr = wid >> 1, wc = wid & 1, fr = lane & 15, fq = lane >> 4;
  const int lr = tid >> 3, lc = (tid & 7) ^ ((lr >> 1) & 7);
  const bf16_t* ap[4]; const bf16_t* bp[NBR];
#pragma unroll
  for (int i = 0; i < 4; ++i) ap[i] = arow(lr + 32 * i) + lc * 8;
#pragma unroll
  for (int i = 0; i < NBR; ++i) bp[i] = brow(lr + 32 * i) + lc * 8;
#pragma unroll
  for (int m = 0; m < 4; ++m)
#pragma unroll
    for (int n = 0; n < NT; ++n) acc[m][n] = (f32x4){0.f, 0.f, 0.f, 0.f};
  const int nk = K >> 6;
  auto issue = [&](int kt) {
    char* As = lds + (kt & 1) * STAGE + tid * 16; char* Bs = As + 16384;
#pragma unroll
    for (int i = 0; i < 4; ++i) __builtin_amdgcn_global_load_lds((const unsigned*)(ap[i] + kt * 64), (unsigned*)(As + i * 4096), 16, 0, 0);
#pragma unroll
    for (int i = 0; i < NBR; ++i) __builtin_amdgcn_global_load_lds((const unsigned*)(bp[i] + kt * 64), (unsigned*)(Bs + i * 4096), 16, 0, 0);
  };
  issue(0);
  for (int kt = 0; kt < nk; ++kt) {
    asm volatile("s_waitcnt vmcnt(0)" ::: "memory");
    __syncthreads();
    if (kt + 1 < nk) issue(kt + 1);
    const char* As = lds + (kt & 1) * STAGE; const char* Bs = As + 16384;
    mma_stage<NT>(As, Bs, acc, wr, wc, fr, fq);
  }
  __syncthreads();
}

template <class Rows2>
DEVI void gemm_mainloop_pair(f32x4 (&acc)[4][4], Rows2 rows2, const bf16_t* WA, const bf16_t* WB, char* lds) {
  constexpr int STAGE = 32768;
  const int tid = get_tid(), lane = tid & 63, wid = tid >> 6, wr = wid >> 1, wc = wid & 1, fr = lane & 15, fq = lane >> 4;
  const int lr = tid >> 3, lc = (tid & 7) ^ ((lr >> 1) & 7);
  const bf16_t* ap[4]; const bf16_t* ap2[4]; const bf16_t* bp[4]; const bf16_t* bp2[4];
#pragma unroll
  for (int i = 0; i < 4; ++i) {
    const bf16_t* pa; const bf16_t* pb;
    rows2(lr + 32 * i, pa, pb);
    ap[i] = pa + lc * 8; ap2[i] = pb + lc * 8 - 256;
    bp[i] = WA + (size_t)(lr + 32 * i) * 256 + lc * 8; bp2[i] = WB + (size_t)(lr + 32 * i) * 256 + lc * 8 - 256;
  }
#pragma unroll
  for (int m = 0; m < 4; ++m)
#pragma unroll
    for (int n = 0; n < 4; ++n) acc[m][n] = (f32x4){0.f, 0.f, 0.f, 0.f};
  auto issue = [&](int kt) {
    char* As = lds + (kt & 1) * STAGE + tid * 16; char* Bs = As + 16384;
    const bool second = kt >= 4;
#pragma unroll
    for (int i = 0; i < 4; ++i) __builtin_amdgcn_global_load_lds((const unsigned*)((second ? ap2[i] : ap[i]) + kt * 64), (unsigned*)(As + i * 4096), 16, 0, 0);
#pragma unroll
    for (int i = 0; i < 4; ++i) __builtin_amdgcn_global_load_lds((const unsigned*)((second ? bp2[i] : bp[i]) + kt * 64), (unsigned*)(Bs + i * 4096), 16, 0, 0);
  };
  issue(0);
  for (int kt = 0; kt < 8; ++kt) {
    asm volatile("s_waitcnt vmcnt(0)" ::: "memory");
    __syncthreads();
    if (kt + 1 < 8) issue(kt + 1);
    const char* As = lds + (kt & 1) * STAGE; const char* Bs = As + 16384;
    mma_stage<4>(As, Bs, acc, wr, wc, fr, fq);
  }
  __syncthreads();
}

template <int NT>
DEVI void acc_to_lds(const f32x4 (&acc)[4][NT], float* Cs) {
  constexpr int LDC = NT * 32 + 4;
  const int lane = get_tid() & 63, wid = get_tid() >> 6, wr = wid >> 1, wc = wid & 1, fr = lane & 15, fq = lane >> 4;
#pragma unroll
  for (int m = 0; m < 4; ++m)
#pragma unroll
    for (int n = 0; n < NT; ++n)
#pragma unroll
      for (int j = 0; j < 4; ++j) Cs[(wr * 64 + m * 16 + fq * 4 + j) * LDC + wc * (NT * 16) + n * 16 + fr] = acc[m][n][j];
  __syncthreads();
}

DEVI void conv_weight_tile(const AS4 ConvJob& jb, int local, char* lds) {
  float* tile = (float*)lds;
  const int tid = get_tid();
  const int nkt = jb.K >> 6, nnt = jb.Npad >> 6;
  const int per = nkt * nnt;
  const int bi = local / per; const int rem = local - bi * per;
  const int ktile = rem / nnt, ntile = rem - ktile * nnt;
  const int k0 = ktile * 64, n0 = ntile * 64;
  const float* src = jb.src + (size_t)bi * jb.sstride;
  bf16_t* dst = jb.dst + (size_t)bi * jb.dstride;
  {
    const int c4 = (tid & 15) * 4; const int r0 = tid >> 4;
#pragma unroll
    for (int i = 0; i < 4; ++i) {
      const int k = r0 + 16 * i; const int n = n0 + c4;
      float4 v = make_float4(0.f, 0.f, 0.f, 0.f);
      if (n < jb.N) v = *(const float4*)(src + (size_t)(k0 + k) * jb.N + n);
      if (jb.gain) { const float g = jb.gain[k0 + k]; v.x *= g; v.y *= g; v.z *= g; v.w *= g; }
      tile[k * 65 + c4 + 0] = v.x; tile[k * 65 + c4 + 1] = v.y; tile[k * 65 + c4 + 2] = v.z; tile[k * 65 + c4 + 3] = v.w;
    }
  }
  __syncthreads();
  {
    const int n = tid >> 2, kseg = (tid & 3) * 16;
    unsigned w[8];
#pragma unroll
    for (int i = 0; i < 8; ++i) w[i] = pack2(tile[(kseg + 2 * i) * 65 + n], tile[(kseg + 2 * i + 1) * 65 + n]);
    const int ng = n0 + n;
    int row = ng;
    if (jb.mode == 1) row = (ng >> 6) * 128 + (ng & 63);
    else if (jb.mode == 2) row = (ng >> 6) * 128 + 64 + (ng & 63);
    bf16_t* d = dst + (size_t)row * jb.K + k0 + kseg;
    *(u32x4*)(d) = (u32x4){w[0], w[1], w[2], w[3]};
    *(u32x4*)(d + 8) = (u32x4){w[4], w[5], w[6], w[7]};
  }
  __syncthreads();
}

DEVI void conv_weights_phase(PR p, int jbegin, int jend, int ntiles, char* lds) {
  for (int t = blockIdx.x; t < ntiles; t += gridDim.x) {
    int j = jbegin;
    while (j + 1 < jend && p.jobs[j + 1].tile_start <= t) ++j;
    conv_weight_tile(p.jobs[j], t - p.jobs[j].tile_start, lds);
  }
}

DEVI float4 ld4(const float* q) { return *(const float4*)q; }
DEVI float4 ld4(const bf16_t* q) { const u32x2 w = *(const u32x2*)q; return make_float4(bflo(w.x), bfhi(w.x), bflo(w.y), bfhi(w.y)); }
DEVI void st4(float* q, float4 v) { *(float4*)q = v; }
DEVI void st4(bf16_t* q, float4 v) { u32x2 w; w.x = pack2(v.x, v.y); w.y = pack2(v.z, v.w); *(u32x2*)q = w; }

template <class SrcT, class DstT>
DEVI void rownorm_phase(const SrcT* __restrict__ src, const bf16_t* __restrict__ y, const float* __restrict__ gain,
                        DstT* dstx, bf16_t* dsth) {
  const int lane = get_tid() & 63;
  const int wave = blockIdx.x * 4 + (get_tid() >> 6), nw = gridDim.x * 4;
  for (int row = wave; row < T_; row += nw) {
    float4 v[4];
#pragma unroll
    for (int i = 0; i < 4; ++i) v[i] = ld4(src + (size_t)row * 1024 + i * 256 + lane * 4);
    if (y) {
#pragma unroll
      for (int s = 0; s < 2; ++s)
#pragma unroll
        for (int i = 0; i < 4; ++i) {
          u32x2 w = *(const u32x2*)(y + (size_t)(row * 2 + s) * 1024 + i * 256 + lane * 4);
          v[i].x += bflo(w.x); v[i].y += bfhi(w.x); v[i].z += bflo(w.y); v[i].w += bfhi(w.y);
        }
    }
    if (dstx) {
#pragma unroll
      for (int i = 0; i < 4; ++i) st4(dstx + (size_t)row * 1024 + i * 256 + lane * 4, v[i]);
    }
    if (dsth) {
      float ss = 0.f;
#pragma unroll
      for (int i = 0; i < 4; ++i) ss += v[i].x * v[i].x + v[i].y * v[i].y + v[i].z * v[i].z + v[i].w * v[i].w;
      ss = wave_sum(ss);
      const float r = 1.0f / sqrtf(ss * (1.0f / 1024.0f) + 1e-6f);
#pragma unroll
      for (int i = 0; i < 4; ++i) {
        const float4 g = *(const float4*)(gain + i * 256 + lane * 4);
        u32x2 w; w.x = pack2(v[i].x * r * g.x, v[i].y * r * g.y); w.y = pack2(v[i].z * r * g.z, v[i].w * r * g.w);
        *(u32x2*)(dsth + (size_t)row * 1024 + i * 256 + lane * 4) = w;
      }
    }
  }
}

DEVI void gemm_bf16out_phase(const bf16_t* A, int lda, const bf16_t* Bt, int K, int ncolt, bf16_t* out, int ldo, int nvalid, char* lds) {
  float* Cs = (float*)lds;
  XcdIter xi; xi.init();
  const int gsz = (ncolt > 8) ? 6 : ncolt, ngrp = ncolt / gsz;
  for (int n = xi.lb; n < 32 * ncolt; n += xi.nlb) {
    const int grp = n / (32 * gsz), rem = n - grp * (32 * gsz);
    const int rl = rem / gsz, jn = grp * gsz + (rem - rl * gsz);
    const int rt = xi.xcd * 32 + rl;
    f32x4 acc[4][4];
    const bf16_t* Ab = A + (size_t)rt * 128 * lda;
    gemm_mainloop<4>(acc, [&](int r) { return Ab + (size_t)r * lda; }, Bt + (size_t)jn * 128 * K, K, K, lds);
    acc_to_lds<4>(acc, Cs);
    const int c4 = get_tid() & 31, r0 = get_tid() >> 5;
    const int col = jn * 128 + c4 * 4;
    if (col < nvalid) {
#pragma unroll
      for (int i = 0; i < 16; ++i) {
        const int row = r0 + 8 * i;
        const f32x4 v = *(const f32x4*)(Cs + row * 132 + c4 * 4);
        u32x2 w; w.x = pack2(v[0], v[1]); w.y = pack2(v[2], v[3]);
        *(u32x2*)(out + (size_t)(rt * 128 + row) * ldo + col) = w;
      }
    }
    __syncthreads();
  }
}

template <class BaseT>
DEVI void gemm_resid_phase(const bf16_t* A, const bf16_t* Bt, const BaseT* base, bf16_t* xr, char* lds) {
  float* Cs = (float*)lds;
  XcdIter xi; xi.init();
  for (int n = xi.lb; n < 32 * 8; n += xi.nlb) {
    const int rt = xi.xcd * 32 + (n >> 3), jn = n & 7;
    f32x4 acc[4][4];
    const bf16_t* Ab = A + (size_t)rt * 128 * 1024;
    gemm_mainloop<4>(acc, [&](int r) { return Ab + (size_t)r * 1024; }, Bt + (size_t)jn * 128 * 1024, 1024, 1024, lds);
    const int c4 = get_tid() & 31, r0 = get_tid() >> 5;
    const int col = jn * 128 + c4 * 4;
    float4 bres[16];
#pragma unroll
    for (int i = 0; i < 16; ++i) bres[i] = ld4(base + (size_t)(rt * 128 + r0 + 8 * i) * 1024 + col);
    acc_to_lds<4>(acc, Cs);
#pragma unroll
    for (int i = 0; i < 16; ++i) {
      const int row = r0 + 8 * i;
      const f32x4 v = *(const f32x4*)(Cs + row * 132 + c4 * 4);
      const size_t o = (size_t)(rt * 128 + row) * 1024 + col;
      const float4 b = bres[i];
      st4(xr + o, make_float4(b.x + v[0], b.y + v[1], b.z + v[2], b.w + v[3]));
    }
    __syncthreads();
  }
}

template <int KW>
DEVI void row_rms_scale(const bf16_t* Ab, int lda, float* rsA) {
  const int row = get_tid() >> 1, half = get_tid() & 1;
  const bf16_t* q = Ab + (size_t)row * lda + half * (KW / 2);
  float ss = 0.f;
#pragma unroll
  for (int i = 0; i < KW / 16; ++i) {
    const u32x4 w = *(const u32x4*)(q + i * 8);
#pragma unroll
    for (int e = 0; e < 4; ++e) { const float a = bflo(w[e]), b = bfhi(w[e]); ss += a * a + b * b; }
  }
  ss += __shfl_xor(ss, 1);
  if (half == 0) rsA[row] = 1.0f / sqrtf(ss * (1.0f / KW) + 1e-6f);
}

DEVI void qup_tile(PR p, int rt, int h, char* lds) {
  float* Cs = (float*)lds;
  float* rsA = (float*)(lds + 72704);
  const bf16_t* Ab = p.proj0 + (size_t)rt * 128 * 1440;
  row_rms_scale<256>(Ab, 1440, rsA);
  f32x4 acc[4][3];
  gemm_mainloop<3>(acc, [&](int r) { return Ab + (size_t)r * 1440; }, p.Wuqt + (size_t)h * 96 * 256, 256, 256, lds);
  acc_to_lds<3>(acc, Cs);
  const int row = get_tid() >> 1, half = get_tid() & 1;
  const int t = rt * 128 + row, b = t >> 11, s = t & 2047;
  const float rq = rsA[row];
  float v[48];
#pragma unroll
  for (int i = 0; i < 12; ++i) {
    const f32x4 c = *(const f32x4*)(Cs + row * 100 + half * 48 + i * 4);
    v[4 * i] = c[0] * rq; v[4 * i + 1] = c[1] * rq; v[4 * i + 2] = c[2] * rq; v[4 * i + 3] = c[3] * rq;
  }
  float ss = 0.f;
#pragma unroll
  for (int i = 0; i < 48; ++i) ss += v[i] * v[i];
  ss += __shfl_xor(ss, 1);
  const float rn = 1.0f / sqrtf(ss * (1.0f / 96.0f) + 1e-6f);
  const float osc = 0.10206207261596575f * LOG2E;
#pragma unroll
  for (int i = 0; i < 48; ++i) v[i] = v[i] * rn * p.mla_q_norm[half * 48 + i];
  if (half == 1) {
    const float fpos = (float)p.pos[t];
#pragma unroll
    for (int i = 0; i < 16; ++i) {
      float sn, cs; sincos_rev(fpos * p.inv_freq[i], sn, cs);
      const float x1 = v[16 + i], x2 = v[32 + i];
      v[16 + i] = x1 * cs - x2 * sn; v[32 + i] = x1 * sn + x2 * cs;
    }
  }
  bf16_t* dst = p.Q0 + ((size_t)(b * 8 + h) * 2048 + s) * 96 + half * 48;
#pragma unroll
  for (int i = 0; i < 6; ++i) {
    u32x4 w;
    w[0] = pack2(v[8 * i] * osc, v[8 * i + 1] * osc); w[1] = pack2(v[8 * i + 2] * osc, v[8 * i + 3] * osc);
    w[2] = pack2(v[8 * i + 4] * osc, v[8 * i + 5] * osc); w[3] = pack2(v[8 * i + 6] * osc, v[8 * i + 7] * osc);
    *(u32x4*)(dst + i * 8) = w;
  }
  __syncthreads();
}

DEVI void kvup_tile(PR p, int rt, int h, char* lds) {
  float* Cs = (float*)lds;
  float* rsA = (float*)(lds + 72704);
  const bf16_t* Ab = p.proj0 + (size_t)rt * 128 * 1440 + 256;
  row_rms_scale<128>(Ab, 1440, rsA);
  f32x4 acc[4][4];
  gemm_mainloop<4>(acc, [&](int r) { return Ab + (size_t)r * 1440; }, p.Wukvt + (size_t)h * 128 * 128, 128, 128, lds);
  acc_to_lds<4>(acc, Cs);
  const int row = get_tid() >> 1, half = get_tid() & 1;
  const int t = rt * 128 + row, b = t >> 11, s = t & 2047;
  const float rkv = rsA[row];
  if (half == 0) {
    float kr[32];
    const bf16_t* rp = p.proj0 + (size_t)t * 1440 + 384;
#pragma unroll
    for (int i = 0; i < 4; ++i) {
      const u32x4 w = *(const u32x4*)(rp + i * 8);
#pragma unroll
      for (int e = 0; e < 4; ++e) { kr[8 * i + 2 * e] = bflo(w[e]); kr[8 * i + 2 * e + 1] = bfhi(w[e]); }
    }
    float ss = 0.f;
#pragma unroll
    for (int i = 0; i < 32; ++i) ss += kr[i] * kr[i];
#pragma unroll
    for (int i = 0; i < 16; ++i) {
      const f32x4 c = *(const f32x4*)(Cs + row * 132 + i * 4);
#pragma unroll
      for (int e = 0; e < 4; ++e) { const float a = c[e] * rkv; ss += a * a; }
    }
    const float rn = 1.0f / sqrtf(ss * (1.0f / 96.0f) + 1e-6f);
    bf16_t* dst = p.K0 + ((size_t)(b * 8 + h) * 2048 + s) * 96;
#pragma unroll
    for (int i = 0; i < 8; ++i) {
      const f32x4 c0 = *(const f32x4*)(Cs + row * 132 + i * 8);
      const f32x4 c1 = *(const f32x4*)(Cs + row * 132 + i * 8 + 4);
      const float4 g0 = *(const float4*)(p.mla_k_norm + i * 8);
      const float4 g1 = *(const float4*)(p.mla_k_norm + i * 8 + 4);
      const float f = rkv * rn;
      u32x4 w;
      w[0] = pack2(c0[0] * f * g0.x, c0[1] * f * g0.y); w[1] = pack2(c0[2] * f * g0.z, c0[3] * f * g0.w);
      w[2] = pack2(c1[0] * f * g1.x, c1[1] * f * g1.y); w[3] = pack2(c1[2] * f * g1.z, c1[3] * f * g1.w);
      *(u32x4*)(dst + i * 8) = w;
    }
#pragma unroll
    for (int i = 0; i < 32; ++i) kr[i] = kr[i] * rn * p.mla_k_norm[64 + i];
    const float fpos = (float)p.pos[t];
#pragma unroll
    for (int i = 0; i < 16; ++i) {
      float sn, cs; sincos_rev(fpos * p.inv_freq[i], sn, cs);
      const float x1 = kr[i], x2 = kr[16 + i];
      kr[i] = x1 * cs - x2 * sn; kr[16 + i] = x1 * sn + x2 * cs;
    }
#pragma unroll
    for (int i = 0; i < 4; ++i) {
      u32x4 w;
      w[0] = pack2(kr[8 * i], kr[8 * i + 1]); w[1] = pack2(kr[8 * i + 2], kr[8 * i + 3]);
      w[2] = pack2(kr[8 * i + 4], kr[8 * i + 5]); w[3] = pack2(kr[8 * i + 6], kr[8 * i + 7]);
      *(u32x4*)(dst + 64 + i * 8) = w;
    }
  } else {
    bf16_t* dst = p.V0t + ((size_t)(b * 8 + h) * 64) * 2048 + s;
#pragma unroll
    for (int i = 0; i < 16; ++i) {
      const f32x4 c = *(const f32x4*)(Cs + row * 132 + 64 + i * 4);
#pragma unroll
      for (int e = 0; e < 4; ++e) dst[(size_t)(i * 4 + e) * 2048] = f2bf(c[e] * rkv);
    }
  }
  __syncthreads();
}

DEVI void conv_tile(PR p, int tile, char* lds) {
  const int tid = get_tid(), lane = tid & 63, wid = tid >> 6;
  const int b = tile >> 6, t0 = (tile & 63) * 32;
  unsigned* glu = (unsigned*)lds;
#pragma unroll 1
  for (int i0 = 0; i0 < 62; i0 += 16) {
    unsigned av[16], gv[16];
#pragma unroll
    for (int k = 0; k < 16; ++k) {
      const int i = i0 + k; const int tt = max(t0 - 30 + i, 0);
      const bf16_t* rp = p.proj0 + (size_t)(b * 2048 + tt) * 1440;
      av[k] = (i < 62) ? *(const unsigned*)(rp + 416 + 2 * tid) : 0u;
      gv[k] = (i < 62) ? *(const unsigned*)(rp + 928 + 2 * tid) : 0u;
    }
#pragma unroll
    for (int k = 0; k < 16; ++k) {
      const int i = i0 + k;
      const unsigned a = av[k], g = gv[k];
      const unsigned w = (t0 - 30 + i >= 0) ? pack2(bflo(a) * sigmoidf_(bflo(g)), bfhi(a) * sigmoidf_(bfhi(g))) : 0u;
      if (i < 62) glu[i * 256 + tid] = w;
    }
  }
  __syncthreads();
  float y0[32], y1[32];
  {
    const float2 bb = *(const float2*)(p.conv_dw_b + 2 * tid);
#pragma unroll
    for (int t = 0; t < 32; ++t) { y0[t] = bb.x; y1[t] = bb.y; }
  }
  {
    float2 w[31];
#pragma unroll
    for (int j = 0; j < 31; ++j) w[j] = *(const float2*)(p.conv_dw_w + j * 512 + 2 * tid);
#pragma unroll
    for (int i = 0; i < 62; ++i) {
      const unsigned g2 = glu[i * 256 + tid];
      const float lo = bflo(g2), hi = bfhi(g2);
#pragma unroll
      for (int t = (i > 30 ? i - 30 : 0); t <= (i < 31 ? i : 31); ++t) { y0[t] += w[i - t].x * lo; y1[t] += w[i - t].y * hi; }
    }
  }
  __syncthreads();
  float* ys = (float*)lds;
#pragma unroll
  for (int t = 0; t < 32; ++t) *(float2*)(ys + t * 516 + 2 * tid) = make_float2(y0[t], y1[t]);
  __syncthreads();
  for (int k = 0; k < 8; ++k) {
    const int tl = wid * 8 + k;
    const f32x4 a0 = *(const f32x4*)(ys + tl * 516 + lane * 8);
    const f32x4 a1 = *(const f32x4*)(ys + tl * 516 + lane * 8 + 4);
    float v[8] = {a0[0], a0[1], a0[2], a0[3], a1[0], a1[1], a1[2], a1[3]};
    float sm = 0.f;
#pragma unroll
    for (int e = 0; e < 8; ++e) sm += v[e];
    const float mu = wave_sum(sm) * (1.0f / 512.0f);
    float sq = 0.f;
#pragma unroll
    for (int e = 0; e < 8; ++e) { v[e] -= mu; sq += v[e] * v[e]; }
    const float rstd = 1.0f / sqrtf(wave_sum(sq) * (1.0f / 512.0f) + 1e-5f);
    const float4 g0 = *(const float4*)(p.conv_ln_g + lane * 8), g1 = *(const float4*)(p.conv_ln_g + lane * 8 + 4);
    const float4 b0 = *(const float4*)(p.conv_ln_b + lane * 8), b1 = *(const float4*)(p.conv_ln_b + lane * 8 + 4);
    const float gg[8] = {g0.x, g0.y, g0.z, g0.w, g1.x, g1.y, g1.z, g1.w};
    const float bb[8] = {b0.x, b0.y, b0.z, b0.w, b1.x, b1.y, b1.z, b1.w};
    float o[8];
#pragma unroll
    for (int e = 0; e < 8; ++e) { const float z = v[e] * rstd * gg[e] + bb[e]; o[e] = z * sigmoidf_(z); }
    u32x4 w; w[0] = pack2(o[0], o[1]); w[1] = pack2(o[2], o[3]); w[2] = pack2(o[4], o[5]); w[3] = pack2(o[6], o[7]);
    *(u32x4*)(p.hn + (size_t)(b * 2048 + t0 + tl) * 1024 + 512 + lane * 8) = w;
  }
  __syncthreads();
}

DEVI void l0_phase2(PR p, char* lds) {
  XcdIter xi; xi.init();
  for (int n = xi.lb; n < 640; n += xi.nlb) {
    if (n < 256) qup_tile(p, xi.xcd * 32 + (n >> 3), n & 7, lds);
    else if (n < 512) kvup_tile(p, xi.xcd * 32 + ((n - 256) >> 3), (n - 256) & 7, lds);
    else conv_tile(p, xi.xcd * 128 + (n - 512), lds);
  }
}

template <int NKS, int KSTR>
DEVI void qk_tile(const char* Ks, const bf16x8 (&qf)[2][NKS], f32x4 (&s)[4][2], int fr, int fq) {
#pragma unroll
  for (int kt = 0; kt < 4; ++kt) {
    s[kt][0] = (f32x4){0.f, 0.f, 0.f, 0.f}; s[kt][1] = (f32x4){0.f, 0.f, 0.f, 0.f};
#pragma unroll
    for (int ks = 0; ks < NKS; ++ks) {
      const bf16x8 a = *(const bf16x8*)(Ks + (kt * 16 + fr) * KSTR + ks * 64 + fq * 16);
      s[kt][0] = __builtin_amdgcn_mfma_f32_16x16x32_bf16(a, qf[0][ks], s[kt][0], 0, 0, 0);
      s[kt][1] = __builtin_amdgcn_mfma_f32_16x16x32_bf16(a, qf[1][ks], s[kt][1], 0, 0, 0);
    }
  }
}
template <int VSTR>
DEVI void pv_tile(const char* Vs, const f32x4 (&pr)[4][2], f32x4 (&o)[4][2], int fr, int fq) {
#pragma unroll
  for (int u = 0; u < 2; ++u) {
    bf16x8 bfr[2];
#pragma unroll
    for (int qt = 0; qt < 2; ++qt) {
      u32x4 w;
      w[0] = pack2(pr[2 * u][qt][0], pr[2 * u][qt][1]); w[1] = pack2(pr[2 * u][qt][2], pr[2 * u][qt][3]);
      w[2] = pack2(pr[2 * u + 1][qt][0], pr[2 * u + 1][qt][1]); w[3] = pack2(pr[2 * u + 1][qt][2], pr[2 * u + 1][qt][3]);
      bfr[qt] = __builtin_bit_cast(bf16x8, w);
    }
#pragma unroll
    for (int dt = 0; dt < 4; ++dt) {
      const char* vp = Vs + (dt * 16 + fr) * VSTR + (32 * u + 4 * fq) * 2;
      const u32x2 lo = *(const u32x2*)(vp);
      const u32x2 hi = *(const u32x2*)(vp + 32);
      const u32x4 aw = (u32x4){lo[0], lo[1], hi[0], hi[1]};
      const bf16x8 a = __builtin_bit_cast(bf16x8, aw);
      o[dt][0] = __builtin_amdgcn_mfma_f32_16x16x32_bf16(a, bfr[0], o[dt][0], 0, 0, 0);
      o[dt][1] = __builtin_amdgcn_mfma_f32_16x16x32_bf16(a, bfr[1], o[dt][1], 0, 0, 0);
    }
  }
}
DEVI void softmax_update(f32x4 (&s)[4][2], float (&m)[2], float (&l)[2], f32x4 (&o)[4][2]) {
#pragma unroll
  for (int qt = 0; qt < 2; ++qt) {
    float mx = NEGBIG;
#pragma unroll
    for (int kt = 0; kt < 4; ++kt)
#pragma unroll
      for (int j = 0; j < 4; ++j) mx = fmaxf(mx, s[kt][qt][j]);
    mx = fmaxf(mx, __shfl_xor(mx, 16)); mx = fmaxf(mx, __shfl_xor(mx, 32));
    const float mn = fmaxf(m[qt], mx);
    const float alpha = fast_exp2(m[qt] - mn);
    m[qt] = mn;
    const float mnc = fmaxf(mn, -1e29f);
    float rsum = 0.f;
#pragma unroll
    for (int kt = 0; kt < 4; ++kt)
#pragma unroll
      for (int j = 0; j < 4; ++j) {
        const float pv = fast_exp2(s[kt][qt][j] - mnc);
        s[kt][qt][j] = pv; rsum += pv;
      }
    l[qt] = l[qt] * alpha + rsum;
#pragma unroll
    for (int dt = 0; dt < 4; ++dt) { o[dt][qt][0] *= alpha; o[dt][qt][1] *= alpha; o[dt][qt][2] *= alpha; o[dt][qt][3] *= alpha; }
  }
}

DEVI void exp_accum(f32x4 (&s)[4][2], float (&l)[2]) {
#pragma unroll
  for (int qt = 0; qt < 2; ++qt) {
    float rsum = 0.f;
#pragma unroll
    for (int kt = 0; kt < 4; ++kt)
#pragma unroll
      for (int j = 0; j < 4; ++j) { const float pv = fast_exp2(s[kt][qt][j]); s[kt][qt][j] = pv; rsum += pv; }
    l[qt] += rsum;
  }
}

DEVI unsigned bf_hi_bits(float v) { return pack2(v, 0.f) & 0xffffu; }
DEVI float bf_round(float v) { return __uint_as_float(bf_hi_bits(v) << 16); }
template <int NKS, int KSTR>
DEVI void qk_tile_aug(const char* Ks, const char* Kaug, const bf16x8 (&qf)[2][NKS], const bf16x8 (&qa)[2], f32x4 (&s)[4][2], int fr, int fq) {
#pragma unroll
  for (int kt = 0; kt < 4; ++kt) {
    s[kt][0] = (f32x4){0.f, 0.f, 0.f, 0.f}; s[kt][1] = (f32x4){0.f, 0.f, 0.f, 0.f};
#pragma unroll
    for (int ks = 0; ks < NKS; ++ks) {
      const bf16x8 a = *(const bf16x8*)(Ks + (kt * 16 + fr) * KSTR + ks * 64 + fq * 16);
      s[kt][0] = __builtin_amdgcn_mfma_f32_16x16x32_bf16(a, qf[0][ks], s[kt][0], 0, 0, 0);
      s[kt][1] = __builtin_amdgcn_mfma_f32_16x16x32_bf16(a, qf[1][ks], s[kt][1], 0, 0, 0);
    }
    u32x4 aw = *(const u32x4*)(Kaug + (kt * 16 + fr) * 16);
    if (fq != 0) aw = (u32x4){0u, 0u, 0u, 0u};
    const bf16x8 a = __builtin_bit_cast(bf16x8, aw);
    s[kt][0] = __builtin_amdgcn_mfma_f32_16x16x32_bf16(a, qa[0], s[kt][0], 0, 0, 0);
    s[kt][1] = __builtin_amdgcn_mfma_f32_16x16x32_bf16(a, qa[1], s[kt][1], 0, 0, 0);
  }
}
DEVI bf16x8 make_qaug(float slope2, float colc, int fq) {
  const float sh = bf_round(slope2), sl = slope2 - sh;
  const float c1 = bf_round(colc), r1 = colc - c1, c2 = bf_round(r1), c3 = r1 - c2;
  u32x4 w;
  w[0] = pack2(sh, sh); w[1] = pack2(sl, sl); w[2] = pack2(c1, c2); w[3] = pack2(c3, 0.f);
  if (fq != 0) w = (u32x4){0u, 0u, 0u, 0u};
  return __builtin_bit_cast(bf16x8, w);
}
DEVI u32x4 make_kaug(float v) {
  const float ph = bf_round(v), pl = v - ph;
  u32x4 w; w[0] = pack2(ph, pl); w[1] = pack2(ph, pl); w[2] = 0x3f803f80u; w[3] = 0x00003f80u;
  return w;
}
DEVI void exp_tile(f32x4 (&s)[4][2]) {
#pragma unroll
  for (int kt = 0; kt < 4; ++kt)
#pragma unroll
    for (int qt = 0; qt < 2; ++qt)
#pragma unroll
      for (int j = 0; j < 4; ++j) s[kt][qt][j] = fast_exp2(s[kt][qt][j]);
}
template <int VSTR>
DEVI void pv_tile_l(const char* Vs, const f32x4 (&pr)[4][2], f32x4 (&o)[4][2], f32x4 (&ol)[2], int fr, int fq) {
  const u32x4 onesw = (u32x4){0x3f803f80u, 0x3f803f80u, 0x3f803f80u, 0x3f803f80u};
  const bf16x8 ones = __builtin_bit_cast(bf16x8, onesw);
#pragma unroll
  for (int u = 0; u < 2; ++u) {
    bf16x8 bfr[2];
#pragma unroll
    for (int qt = 0; qt < 2; ++qt) {
      u32x4 w;
      w[0] = pack2(pr[2 * u][qt][0], pr[2 * u][qt][1]); w[1] = pack2(pr[2 * u][qt][2], pr[2 * u][qt][3]);
      w[2] = pack2(pr[2 * u + 1][qt][0], pr[2 * u + 1][qt][1]); w[3] = pack2(pr[2 * u + 1][qt][2], pr[2 * u + 1][qt][3]);
      bfr[qt] = __builtin_bit_cast(bf16x8, w);
    }
#pragma unroll
    for (int dt = 0; dt < 4; ++dt) {
      const char* vp = Vs + (dt * 16 + fr) * VSTR + (32 * u + 4 * fq) * 2;
      const u32x2 lo = *(const u32x2*)(vp);
      const u32x2 hi = *(const u32x2*)(vp + 32);
      const u32x4 aw = (u32x4){lo[0], lo[1], hi[0], hi[1]};
      const bf16x8 a = __builtin_bit_cast(bf16x8, aw);
      o[dt][0] = __builtin_amdgcn_mfma_f32_16x16x32_bf16(a, bfr[0], o[dt][0], 0, 0, 0);
      o[dt][1] = __builtin_amdgcn_mfma_f32_16x16x32_bf16(a, bfr[1], o[dt][1], 0, 0, 0);
    }
    ol[0] = __builtin_amdgcn_mfma_f32_16x16x32_bf16(ones, bfr[0], ol[0], 0, 0, 0);
    ol[1] = __builtin_amdgcn_mfma_f32_16x16x32_bf16(ones, bfr[1], ol[1], 0, 0, 0);
  }
}

DEVI float head8_sum(float v) {
  v += __builtin_bit_cast(float, __builtin_amdgcn_update_dpp(0, __builtin_bit_cast(int, v), 0xB1, 0xF, 0xF, true));
  v += __builtin_bit_cast(float, __builtin_amdgcn_update_dpp(0, __builtin_bit_cast(int, v), 0x4E, 0xF, 0xF, true));
  v += __builtin_bit_cast(float, __builtin_amdgcn_update_dpp(0, __builtin_bit_cast(int, v), 0x141, 0xF, 0xF, true));
  return v;
}

DEVI void rowsum_tile(const f32x4 (&pr)[4][2], f32x4 (&ol)[2]) {
  const u32x4 onesw = (u32x4){0x3f803f80u, 0x3f803f80u, 0x3f803f80u, 0x3f803f80u};
  const bf16x8 ones = __builtin_bit_cast(bf16x8, onesw);
#pragma unroll
  for (int u = 0; u < 2; ++u)
#pragma unroll
    for (int qt = 0; qt < 2; ++qt) {
      u32x4 w;
      w[0] = pack2(pr[2 * u][qt][0], pr[2 * u][qt][1]); w[1] = pack2(pr[2 * u][qt][2], pr[2 * u][qt][3]);
      w[2] = pack2(pr[2 * u + 1][qt][0], pr[2 * u + 1][qt][1]); w[3] = pack2(pr[2 * u + 1][qt][2], pr[2 * u + 1][qt][3]);
      ol[qt] = __builtin_amdgcn_mfma_f32_16x16x32_bf16(ones, __builtin_bit_cast(bf16x8, w), ol[qt], 0, 0, 0);
    }
}

DEVI void mla_attn_phase(PR p, char* lds) {
  constexpr int KSTR = 208, VSTR = 144;
  const int tid = get_tid(), lane = tid & 63, wid = tid >> 6, fr = lane & 15, fq = lane >> 4;
  XcdIter xi; xi.init();
  for (int n = xi.lb; n < 256; n += xi.nlb) {
    __syncthreads();
    const int r = n >> 6, li = n & 63, jq = li & 15;
    const int bh = xi.xcd * 16 + r * 4 + (li >> 4);
    const int j8 = (jq + 8) & 15;
    const int qt128 = (r == 0) ? jq : (r == 1) ? 15 - jq : (r == 2) ? j8 : 15 - j8;
    const int q0 = qt128 * 128 + wid * 32;
    const bf16_t* Qb = p.Q0 + (size_t)bh * 2048 * 96;
    const bf16_t* Kb = p.K0 + (size_t)bh * 2048 * 96;
    const bf16_t* Vb = p.V0t + (size_t)bh * 64 * 2048;
    bf16x8 qf[2][3];
#pragma unroll
    for (int qt = 0; qt < 2; ++qt)
#pragma unroll
      for (int ks = 0; ks < 3; ++ks) qf[qt][ks] = *(const bf16x8*)(Qb + (size_t)(q0 + 16 * qt + fr) * 96 + ks * 32 + fq * 8);
    f32x4 o[4][2]; f32x4 ol[2];
    ol[0] = (f32x4){0.f, 0.f, 0.f, 0.f}; ol[1] = (f32x4){0.f, 0.f, 0.f, 0.f};
#pragma unroll
    for (int dt = 0; dt < 4; ++dt) { o[dt][0] = (f32x4){0.f, 0.f, 0.f, 0.f}; o[dt][1] = (f32x4){0.f, 0.f, 0.f, 0.f}; }
    const int nkt = 2 * (qt128 + 1);
    u32x4 rk[3], rv[2];
    const int kr0 = tid / 12, kc0 = tid - kr0 * 12;
    const int kr1 = (tid + 256) / 12, kc1 = (tid + 256) - kr1 * 12;
    const int kr2 = (tid + 512) / 12, kc2 = (tid + 512) - kr2 * 12;
    const int vr0 = tid >> 3, vc0 = tid & 7;
    auto fetch = [&](int key0) {
      rk[0] = *(const u32x4*)(Kb + (size_t)(key0 + kr0) * 96 + kc0 * 8);
      rk[1] = *(const u32x4*)(Kb + (size_t)(key0 + kr1) * 96 + kc1 * 8);
      rk[2] = *(const u32x4*)(Kb + (size_t)(key0 + kr2) * 96 + kc2 * 8);
      rv[0] = *(const u32x4*)(Vb + (size_t)vr0 * 2048 + key0 + vc0 * 8);
      rv[1] = *(const u32x4*)(Vb + (size_t)(vr0 + 32) * 2048 + key0 + vc0 * 8);
    };
    fetch(0);
    for (int kt64 = 0; kt64 < nkt; ++kt64) {
      const int key0 = kt64 * 64;
      char* Kc = lds + (kt64 & 1) * 22528; char* Vc = Kc + 64 * KSTR;
      *(u32x4*)(Kc + kr0 * KSTR + kc0 * 16) = rk[0];
      *(u32x4*)(Kc + kr1 * KSTR + kc1 * 16) = rk[1];
      *(u32x4*)(Kc + kr2 * KSTR + kc2 * 16) = rk[2];
      *(u32x4*)(Vc + vr0 * VSTR + vc0 * 16) = rv[0];
      *(u32x4*)(Vc + (vr0 + 32) * VSTR + vc0 * 16) = rv[1];
      __syncthreads();
      if (kt64 + 1 < nkt) fetch(key0 + 64);
      if (key0 <= q0 + 31) {
        f32x4 s[4][2];
        qk_tile<3, KSTR>(Kc, qf, s, fr, fq);
        if (key0 + 63 > q0) {
#pragma unroll
          for (int kt = 0; kt < 4; ++kt)
#pragma unroll
            for (int qt = 0; qt < 2; ++qt)
#pragma unroll
              for (int j = 0; j < 4; ++j) {
                const int key = key0 + 16 * kt + 4 * fq + j, qq = q0 + 16 * qt + fr;
                if (key > qq) s[kt][qt][j] = NEGBIG;
              }
        }
        exp_tile(s);
        pv_tile_l<VSTR>(Vc, s, o, ol, fr, fq);
      }
    }
    const int b = bh >> 3, h = bh & 7;
#pragma unroll
    for (int qt = 0; qt < 2; ++qt) {
      const float inv = 1.0f / ol[qt][0];
      bf16_t* dst = p.hn + (size_t)(b * 2048 + q0 + 16 * qt + fr) * 1024 + h * 64 + 4 * fq;
#pragma unroll
      for (int dt = 0; dt < 4; ++dt) {
        u32x2 w; w[0] = pack2(o[dt][qt][0] * inv, o[dt][qt][1] * inv); w[1] = pack2(o[dt][qt][2] * inv, o[dt][qt][3] * inv);
        *(u32x2*)(dst + dt * 16) = w;
      }
    }
  }
  __syncthreads();
}

DEVI void router_phase(PR p, int layer, char* lds) {
  constexpr int WSTR = 528;
  char* Wh = lds;
  char* Wl = lds + 48 * WSTR;
  float* lg = (float*)(lds + 50688);
  float* ssL = (float*)(lds + 50688 + 12288);
  int* cntL = (int*)(lds + 50688 + 12288 + 256);
  int* baseL = cntL + 32;
  int* cntP = baseL + 32;
  int* baseP = cntP + 112;
  int* gcntP = p.gcntP + layer * 128;
  const int tid = get_tid(), lane = tid & 63, wid = tid >> 6, fr = lane & 15, fq = lane >> 4;
  const bf16_t* gWh = p.RWh + (size_t)layer * 48 * 1024;
  const bf16_t* gWl = p.RWl + (size_t)layer * 48 * 1024;
  int* gcnt = p.gcnt + layer * 32;
  for (int tile = blockIdx.x; tile < T_ / 64; tile += gridDim.x) {
    const int row = tile * 64 + wid * 16 + fr;
    const bf16_t* xrow = p.xr + (size_t)row * 1024;
    f32x4 acc[3]; acc[0] = acc[1] = acc[2] = (f32x4){0.f, 0.f, 0.f, 0.f};
    float ss = 0.f;
    if (tid < 32) cntL[tid] = 0;
    if (tid < 112) cntP[tid] = 0;
    for (int kc = 0; kc < 4; ++kc) {
      u32x4 xq[8];
#pragma unroll
      for (int i = 0; i < 8; ++i) xq[i] = *(const u32x4*)(xrow + kc * 256 + (i >> 1) * 64 + fq * 16 + (i & 1) * 8);
      u32x4 wq[12];
#pragma unroll
      for (int i = 0; i < 6; ++i) {
        const int q = tid + 256 * i; const int n = q >> 5, c = q & 31;
        wq[i] = *(const u32x4*)(gWh + (size_t)n * 1024 + kc * 256 + c * 8);
        wq[6 + i] = *(const u32x4*)(gWl + (size_t)n * 1024 + kc * 256 + c * 8);
      }
      __syncthreads();
#pragma unroll
      for (int i = 0; i < 6; ++i) {
        const int q = tid + 256 * i; const int n = q >> 5, c = q & 31;
        *(u32x4*)(Wh + n * WSTR + c * 16) = wq[i];
        *(u32x4*)(Wl + n * WSTR + c * 16) = wq[6 + i];
      }
      __syncthreads();
#pragma unroll
      for (int s4 = 0; s4 < 4; ++s4) {
#pragma unroll
        for (int m = 0; m < 2; ++m) {
          const u32x4 xw = xq[s4 * 2 + m];
#pragma unroll
          for (int i = 0; i < 4; ++i) { const float a = bflo(xw[i]), b = bfhi(xw[i]); ss += a * a + b * b; }
          const bf16x8 ah = __builtin_bit_cast(bf16x8, xw);
          const int koff = (s4 * 64 + fq * 16 + 8 * m) * 2;
#pragma unroll
          for (int nt = 0; nt < 3; ++nt) {
            const bf16x8 bh = *(const bf16x8*)(Wh + (nt * 16 + fr) * WSTR + koff);
            const bf16x8 bl = *(const bf16x8*)(Wl + (nt * 16 + fr) * WSTR + koff);
            acc[nt] = __builtin_amdgcn_mfma_f32_16x16x32_bf16(ah, bh, acc[nt], 0, 0, 0);
            acc[nt] = __builtin_amdgcn_mfma_f32_16x16x32_bf16(ah, bl, acc[nt], 0, 0, 0);
          }
        }
      }
    }
    ss += __shfl_xor(ss, 16); ss += __shfl_xor(ss, 32);
    if (fq == 0) ssL[wid * 16 + fr] = ss;
#pragma unroll
    for (int nt = 0; nt < 3; ++nt)
#pragma unroll
      for (int j = 0; j < 4; ++j) lg[(wid * 16 + 4 * fq + j) * 48 + nt * 16 + fr] = acc[nt][j];
    __syncthreads();
    int e0 = 0, e1 = 0, rk0 = 0, rk1 = 0; float w0 = 0.f, w1 = 0.f;
    int pidx = 0, rkp = 0; bool swapped = false;
    const int tok = tile * 64 + tid;
    if (tid < 64) {
      const float r = 1.0f / sqrtf(ssL[tid] * (1.0f / 1024.0f) + 1e-6f);
      p.rs[tok] = r;
      const float* L = lg + tid * 48;
      float gl[4];
#pragma unroll
      for (int i = 0; i < 4; ++i) gl[i] = L[i] * r + p.r_group_b[layer * 4 + i];
      int grp = 0; float gm = gl[0];
#pragma unroll
      for (int i = 1; i < 4; ++i) if (gl[i] > gm) { gm = gl[i]; grp = i; }
      float gs = 0.f;
#pragma unroll
      for (int i = 0; i < 4; ++i) gs += expf(gl[i] - gm);
      const float gw = 1.0f / gs;
      float el[8];
#pragma unroll
      for (int i = 0; i < 8; ++i) el[i] = L[4 + grp * 8 + i] * r + p.r_expert_b[layer * 32 + grp * 8 + i];
      int i0 = 0; float v0 = el[0];
#pragma unroll
      for (int i = 1; i < 8; ++i) if (el[i] > v0) { v0 = el[i]; i0 = i; }
      int i1 = (i0 == 0) ? 1 : 0; float v1 = -3e38f;
#pragma unroll
      for (int i = 0; i < 8; ++i) if (i != i0 && el[i] > v1) { v1 = el[i]; i1 = i; }
      const float ex = expf(v1 - v0);
      w0 = gw / (1.0f + ex); w1 = gw * ex / (1.0f + ex);
      e0 = grp * 8 + i0; e1 = grp * 8 + i1;
      rk0 = atomicAdd(&cntL[e0], 1);
      rk1 = atomicAdd(&cntL[e1], 1);
      swapped = i0 > i1;
      const int a = swapped ? i1 : i0, b = swapped ? i0 : i1;
      pidx = grp * 28 + a * 7 - ((a * (a - 1)) >> 1) + (b - a - 1);
      rkp = atomicAdd(&cntP[pidx], 1);
    }
    __syncthreads();
    if (tid < 32) { const int c = cntL[tid]; baseL[tid] = c ? atomicAdd(&gcnt[tid], c) : 0; }
    if (tid < 112) { const int c = cntP[tid]; baseP[tid] = c ? atomicAdd(&gcntP[tid], c) : 0; }
    __syncthreads();
    if (tid < 64) {
      const size_t s0 = (size_t)e0 * T_ + baseL[e0] + rk0, s1 = (size_t)e1 * T_ + baseL[e1] + rk1;
      p.row_tok[s0] = tok * 2;
      p.row_tok[s1] = tok * 2 + 1;
      const float rr = p.rs[tok];
      p.row_aux[s0] = make_float2(w0, rr);
      p.row_aux[s1] = make_float2(w1, rr);
      const int ra = baseL[e0] + rk0, rb = baseL[e1] + rk1;
      const size_t sp = (size_t)pidx * T_ + baseP[pidx] + rkp;
      p.pair_tok[sp] = tok;
      p.pair_rk[sp] = swapped ? make_int2(rb, ra) : make_int2(ra, rb);
    }
    __syncthreads();
  }
}

DEVI void moe_prefix(const int* gcnt, int* preL) {
  __syncthreads();
  if (get_tid() == 0) {
    int a = 0;
    for (int e = 0; e < 32; ++e) { preL[e] = a; a += (gcnt[e] + 127) >> 7; }
    preL[32] = a;
  }
  __syncthreads();
}
DEVI int find_expert(const int* preL, int rt) {
  int e = 0;
  for (int i = 1; i < 32; ++i) if (preL[i] <= rt) e = i;
  return e;
}

DEVI void moe_gateup_phase(PR p, int layer, char* lds) {
  int* preL = (int*)(lds + 72704 + 512);
  const int* gcnt = p.gcnt + layer * 32;
  moe_prefix(gcnt, preL);
  const int nrt = preL[32];
  float* Cs = (float*)lds;
  XcdIter xi; xi.init();
  const int rlo = (nrt * xi.xcd) >> 3, rhi = (nrt * (xi.xcd + 1)) >> 3;
  const int total = (rhi - rlo) * 4, G = xi.nlb;
  const int nfull_rounds = total / G, left = total - nfull_rounds * G;
  const bool split = (left > 0) && (2 * left <= G);
  const int nfull = split ? nfull_rounds * G : total;
  const int row = get_tid() >> 1, half = get_tid() & 1;
  for (int it = xi.lb; it < nfull + (split ? 2 * left : 0); it += G) {
    const bool ishalf = it >= nfull;
    const int item = ishalf ? nfull + ((it - nfull) >> 1) : it;
    const int ch = (it - nfull) & 1;
    const int rt = rlo + (item >> 2), j = item & 3;
    const int e = find_expert(preL, rt);
    const int blk = rt - preL[e];
    const int valid = min(128, gcnt[e] - blk * 128);
    const int* rtk = p.row_tok + (size_t)e * T_ + blk * 128;
    float2 aux = make_float2(0.f, 0.f);
    if (row < valid) aux = p.row_aux[(size_t)e * T_ + blk * 128 + row];
    const float rsc = aux.y, rsu = aux.y * aux.x;
    const bf16_t* Wb = p.Wgut + ((size_t)e * 512 + j * 128) * 1024;
    auto arow = [&](int r) { const int tok = (r < valid) ? (rtk[r] >> 1) : 0; return p.xr + (size_t)tok * 1024; };
    if (!ishalf) {
      f32x4 acc[4][4];
      gemm_mainloop<4>(acc, arow, Wb, 1024, 1024, lds);
      acc_to_lds<4>(acc, Cs);
      if (row < valid) {
        bf16_t* dst = p.hbuf + (size_t)(rt * 128 + row) * 256 + j * 64 + half * 32;
#pragma unroll
        for (int i = 0; i < 4; ++i) {
          float hv[8];
#pragma unroll
          for (int q = 0; q < 2; ++q) {
            const f32x4 g = *(const f32x4*)(Cs + row * 132 + half * 32 + i * 8 + q * 4);
            const f32x4 u = *(const f32x4*)(Cs + row * 132 + 64 + half * 32 + i * 8 + q * 4);
#pragma unroll
            for (int c = 0; c < 4; ++c) { const float gg = g[c] * rsc; hv[q * 4 + c] = gg * sigmoidf_(gg) * (u[c] * rsu); }
          }
          u32x4 w; w[0] = pack2(hv[0], hv[1]); w[1] = pack2(hv[2], hv[3]); w[2] = pack2(hv[4], hv[5]); w[3] = pack2(hv[6], hv[7]);
          *(u32x4*)(dst + i * 8) = w;
        }
      }
    } else {
      f32x4 acc[4][2];
      gemm_mainloop2<2>(acc, arow, [&](int r) { return Wb + (size_t)((r < 32) ? (32 * ch + r) : (64 + 32 * ch + (r - 32))) * 1024; }, 1024, lds);
      acc_to_lds<2>(acc, Cs);
      if (row < valid) {
        bf16_t* dst = p.hbuf + (size_t)(rt * 128 + row) * 256 + j * 64 + ch * 32 + half * 16;
#pragma unroll
        for (int i = 0; i < 2; ++i) {
          float hv[8];
#pragma unroll
          for (int q = 0; q < 2; ++q) {
            const f32x4 g = *(const f32x4*)(Cs + row * 68 + half * 16 + i * 8 + q * 4);
            const f32x4 u = *(const f32x4*)(Cs + row * 68 + 32 + half * 16 + i * 8 + q * 4);
#pragma unroll
            for (int c = 0; c < 4; ++c) { const float gg = g[c] * rsc; hv[q * 4 + c] = gg * sigmoidf_(gg) * (u[c] * rsu); }
          }
          u32x4 w; w[0] = pack2(hv[0], hv[1]); w[1] = pack2(hv[2], hv[3]); w[2] = pack2(hv[4], hv[5]); w[3] = pack2(hv[6], hv[7]);
          *(u32x4*)(dst + i * 8) = w;
        }
      }
    }
    __syncthreads();
  }
}

DEVI void moe_down_phase(PR p, int layer, char* lds) {
  int* preE = (int*)(lds + 72704 + 512);
  int* tabT = (int*)(lds + 67584);
  int* preP = (int*)(lds + 68608);
  unsigned char* tileB = (unsigned char*)(lds + 69120);
  int* cntS = (int*)(lds + 69632);
  const int* gcnt = p.gcnt + layer * 32;
  const int* gcntP = p.gcntP + layer * 128;
  const int tid = get_tid();
  moe_prefix(gcnt, preE);
  if (tid < 112) cntS[tid] = gcntP[tid];
  __syncthreads();
  if (tid == 0) {
    int a = 0;
    for (int b = 0; b < 112; ++b) {
      preP[b] = a;
      const int n = (cntS[b] + 127) >> 7;
      for (int i = 0; i < n; ++i) tileB[a + i] = (unsigned char)b;
      a += n;
    }
    preP[112] = a;
  }
  __syncthreads();
  const int nprt = preP[112];
  float* Cs = (float*)lds;
  XcdIter xi; xi.init();
  const int rlo = (nprt * xi.xcd) >> 3, rhi = (nprt * (xi.xcd + 1)) >> 3;
  for (int it = xi.lb; it < (rhi - rlo) * 8; it += xi.nlb) {
    const int prt = rlo + (it >> 3), j = it & 7;
    const int pb = tileB[prt];
    const int blk = prt - preP[pb];
    const int valid = min(128, cntS[pb] - blk * 128);
    const int g = pb / 28; int q = pb - g * 28, a = 0;
    while (q >= 7 - a) { q -= 7 - a; ++a; }
    const int eA = g * 8 + a, eB = eA + 1 + q;
    const size_t lb0 = (size_t)pb * T_ + blk * 128;
    int tok_r = 0;
    if (tid < valid) tok_r = p.pair_tok[lb0 + tid];
    const int baseA = preE[eA] * 128, baseB = preE[eB] * 128;
    f32x4 acc[4][4];
    gemm_mainloop_pair(acc, [&](int r, const bf16_t*& pa, const bf16_t*& pbp) {
      int2 rk = make_int2(0, 0); int ba = 0, bb = 0;
      if (r < valid) { rk = p.pair_rk[lb0 + r]; ba = baseA; bb = baseB; }
      pa = p.hbuf + (size_t)(ba + rk.x) * 256; pbp = p.hbuf + (size_t)(bb + rk.y) * 256;
    }, p.Wdt + ((size_t)eA * 1024 + j * 128) * 256, p.Wdt + ((size_t)eB * 1024 + j * 128) * 256, lds);
    if (tid < 128) tabT[tid] = tok_r;
    acc_to_lds<4>(acc, Cs);
    const int c4 = tid & 31, r0 = tid >> 5;
#pragma unroll
    for (int i = 0; i < 16; ++i) {
      const int row = r0 + 8 * i;
      if (row < valid) {
        const size_t o = (size_t)tabT[row] * 1024 + j * 128 + c4 * 4;
        const f32x4 v = *(const f32x4*)(Cs + row * 132 + c4 * 4);
        const float4 b = ld4(p.xr + o);
        const float4 r = make_float4(b.x + v[0], b.y + v[1], b.z + v[2], b.w + v[3]);
        if (layer == 0) st4(p.xr + o, r); else st4(p.out + o, r);
      }
    }
    __syncthreads();
  }
}

DEVI void nsa_proj_phase(PR p, char* lds) {
  float* Cs = (float*)lds;
  XcdIter xi; xi.init();
  for (int n = xi.lb; n < 32 * 15; n += xi.nlb) {
    const int grp = n / 160, rem = n - grp * 160;
    const int rl = rem / 5, jn = grp * 5 + (rem - rl * 5);
    const int rt = xi.xcd * 32 + rl;
    f32x4 acc[4][4];
    const bf16_t* Ab = p.hn + (size_t)rt * 128 * 1024;
    gemm_mainloop<4>(acc, [&](int r) { return Ab + (size_t)r * 1024; }, p.W5t + (size_t)jn * 128 * 1024, 1024, 1024, lds);
    acc_to_lds<4>(acc, Cs);
    const int row = get_tid() >> 1, half = get_tid() & 1;
    const int t = rt * 128 + row, b = t >> 11, s = t & 2047;
    const float* cr = Cs + row * 132 + half * 64;
    if (jn == 14) {
      if (half == 0) {
#pragma unroll
        for (int i = 0; i < 12; ++i) {
          const f32x4 c = *(const f32x4*)(cr + i * 4);
          *(float4*)(p.GATES + (size_t)t * 48 + i * 4) = make_float4(sigmoidf_(c[0]), sigmoidf_(c[1]), sigmoidf_(c[2]), sigmoidf_(c[3]));
        }
      }
    } else if (jn == 11 || jn == 13) {
      bf16_t* dst = (jn == 11 ? p.VSt : p.VWt) + ((size_t)(b * 2 + half) * 64) * 2048 + s;
#pragma unroll
      for (int i = 0; i < 16; ++i) {
        const f32x4 c = *(const f32x4*)(cr + i * 4);
#pragma unroll
        for (int e = 0; e < 4; ++e) dst[(size_t)(i * 4 + e) * 2048] = f2bf(c[e]);
      }
    } else {
      const float* gn = nullptr; bf16_t* dst; float osc = 1.0f;
      if (jn < 8) { gn = p.nsa_q_norm; dst = p.Q1 + ((size_t)(b * 16 + jn * 2 + half) * 2048 + s) * 64; osc = 0.125f * LOG2E; }
      else {
        bf16_t* base = (jn == 8) ? p.KC : (jn == 9) ? p.VC : (jn == 10) ? p.KS : p.KW;
        if (jn == 10) gn = p.nsa_k_norm_slc; else if (jn == 12) gn = p.nsa_k_norm_win;
        dst = base + ((size_t)(b * 2 + half) * 2048 + s) * 64;
      }
      float rn = 1.0f;
      if (gn) {
        float ss = 0.f;
#pragma unroll
        for (int i = 0; i < 16; ++i) { const f32x4 c = *(const f32x4*)(cr + i * 4); ss += c[0] * c[0] + c[1] * c[1] + c[2] * c[2] + c[3] * c[3]; }
        rn = osc / sqrtf(ss * (1.0f / 64.0f) + 1e-6f);
      }
#pragma unroll
      for (int i = 0; i < 8; ++i) {
        const f32x4 c0 = *(const f32x4*)(cr + i * 8), c1 = *(const f32x4*)(cr + i * 8 + 4);
        float4 g0 = make_float4(1.f, 1.f, 1.f, 1.f), g1 = g0;
        if (gn) { g0 = *(const float4*)(gn + i * 8); g1 = *(const float4*)(gn + i * 8 + 4); }
        u32x4 w;
        w[0] = pack2(c0[0] * rn * g0.x, c0[1] * rn * g0.y); w[1] = pack2(c0[2] * rn * g0.z, c0[3] * rn * g0.w);
        w[2] = pack2(c1[0] * rn * g1.x, c1[1] * rn * g1.y); w[3] = pack2(c1[2] * rn * g1.z, c1[3] * rn * g1.w);
        *(u32x4*)(dst + i * 8) = w;
      }
    }
    __syncthreads();
  }
}

DEVI void compress_phase(PR p, char* lds) {
  const int tid = get_tid(), lane = tid & 63, wid = tid >> 6, wr = wid >> 1, wc = wid & 1, fr = lane & 15, fq = lane >> 4;
  for (int it = blockIdx.x; it < 64; it += gridDim.x) {
    const int kv = it >> 5, bg = it & 31;
    const bf16_t* base = (kv ? p.VC : p.KC) + (size_t)bg * 2048 * 64;
    const bf16_t* W1 = kv ? p.Wc1vt : p.Wc1kt;
    const bf16_t* W2 = kv ? p.Wc2vt : p.Wc2kt;
    const float* bias = p.bias1 + kv * 128;
    f32x4 acc[4][4];
    gemm_mainloop<4>(acc, [&](int r) { return base + (size_t)min(r, 126) * 1024; }, W1, 2048, 2048, lds);
#pragma unroll
    for (int m = 0; m < 4; ++m)
#pragma unroll
      for (int n = 0; n < 4; ++n)
#pragma unroll
        for (int j = 0; j < 4; ++j) {
          const int row = wr * 64 + m * 16 + fq * 4 + j, col = wc * 64 + n * 16 + fr;
          const float xv = acc[m][n][j] + bias[col];
          const float u2 = 1.5957691216057308f * (xv + 0.044715f * xv * xv * xv);
          const float hv = xv * sigmoidf_(u2);
          const int c = col & 63;
          *(bf16_t*)(lds + (col >> 6) * 16384 + swz(row, c >> 3) + (c & 7) * 2) = f2bf(hv);
        }
#pragma unroll
    for (int i = 0; i < 4; ++i) {
      const int q = tid + 256 * i; const int r = q >> 4, c16 = q & 15;
      *(u32x4*)(lds + 32768 + (c16 >> 3) * 8192 + swz(r, c16 & 7)) = *(const u32x4*)(W2 + (size_t)r * 128 + c16 * 8);
    }
    __syncthreads();
    f32x4 a2[4][2];
#pragma unroll
    for (int m = 0; m < 4; ++m) { a2[m][0] = (f32x4){0.f, 0.f, 0.f, 0.f}; a2[m][1] = (f32x4){0.f, 0.f, 0.f, 0.f}; }
#pragma unroll
    for (int ktile = 0; ktile < 2; ++ktile) mma_stage<2>(lds + ktile * 16384, lds + 32768 + ktile * 8192, a2, wr, wc, fr, fq);
    __syncthreads();
    float* C2 = (float*)lds;
#pragma unroll
    for (int m = 0; m < 4; ++m)
#pragma unroll
      for (int n = 0; n < 2; ++n)
#pragma unroll
        for (int j = 0; j < 4; ++j) C2[(wr * 64 + m * 16 + fq * 4 + j) * 68 + wc * 32 + n * 16 + fr] = a2[m][n][j];
    __syncthreads();
    const int row = tid >> 1, half = tid & 1;
    float v[32];
#pragma unroll
    for (int i = 0; i < 8; ++i) { const f32x4 c = *(const f32x4*)(C2 + row * 68 + half * 32 + i * 4); v[4 * i] = c[0]; v[4 * i + 1] = c[1]; v[4 * i + 2] = c[2]; v[4 * i + 3] = c[3]; }
    if (kv == 0) {
      float ss = 0.f;
#pragma unroll
      for (int i = 0; i < 32; ++i) ss += v[i] * v[i];
      ss += __shfl_xor(ss, 1);
      const float rn = (row < 127) ? 1.0f / sqrtf(ss * (1.0f / 64.0f) + 1e-6f) : 0.f;
      bf16_t* dst = p.KCMP + ((size_t)bg * 128 + row) * 64 + half * 32;
#pragma unroll
      for (int i = 0; i < 4; ++i) {
        u32x4 w;
#pragma unroll
        for (int e = 0; e < 4; ++e) { const int c = 8 * i + 2 * e; w[e] = pack2(v[c] * rn * p.nsa_k_norm_cmp[half * 32 + c], v[c + 1] * rn * p.nsa_k_norm_cmp[half * 32 + c + 1]); }
        *(u32x4*)(dst + i * 8) = w;
      }
    } else {
      const float z = (row < 127) ? 1.0f : 0.f;
      bf16_t* dst = p.VCMPt + ((size_t)bg * 64 + half * 32) * 128 + row;
#pragma unroll
      for (int i = 0; i < 32; ++i) dst[(size_t)i * 128] = f2bf(v[i] * z);
    }
    __syncthreads();
  }
}

DEVI void nsa_stage_tile(char* lds, int st, const bf16_t* Kg  , const bf16_t* Vg  , int vld) {
  const int tid = get_tid();
  char* Ks = lds + st * 18432; char* Vs = Ks + 9216;
#pragma unroll
  for (int i = 0; i < 2; ++i) {
    const int q = tid + 256 * i; const int r = q >> 3, c = q & 7;
    *(u32x4*)(Ks + r * 144 + c * 16) = *(const u32x4*)(Kg + (size_t)r * 64 + c * 8);
    *(u32x4*)(Vs + r * 144 + c * 16) = *(const u32x4*)(Vg + (size_t)r * vld + c * 8);
  }
}

DEVI void out_rmw2(bf16_t* const (&dst)[2], const f32x4 (&o)[4][2], float f0, float f1, bool accumulate) {
  u32x2 w[2][4];
  if (accumulate) {
#pragma unroll
    for (int qt = 0; qt < 2; ++qt)
#pragma unroll
      for (int dt = 0; dt < 4; ++dt) w[qt][dt] = *(const u32x2*)(dst[qt] + dt * 16);
  }
#pragma unroll
  for (int qt = 0; qt < 2; ++qt) {
    const float f = qt ? f1 : f0;
#pragma unroll
    for (int dt = 0; dt < 4; ++dt) {
      float a0 = o[dt][qt][0] * f, a1 = o[dt][qt][1] * f, a2 = o[dt][qt][2] * f, a3 = o[dt][qt][3] * f;
      if (accumulate) { a0 += bflo(w[qt][dt][0]); a1 += bfhi(w[qt][dt][0]); a2 += bflo(w[qt][dt][1]); a3 += bfhi(w[qt][dt][1]); }
      u32x2 r; r[0] = pack2(a0, a1); r[1] = pack2(a2, a3);
      w[qt][dt] = r;
    }
  }
#pragma unroll
  for (int qt = 0; qt < 2; ++qt)
#pragma unroll
    for (int dt = 0; dt < 4; ++dt) *(u32x2*)(dst[qt] + dt * 16) = w[qt][dt];
}

DEVI void nsa_attn_phase(PR p, char* lds) {
  constexpr int STR = 144, STG = 19456;
  constexpr int OSTR = 136;
  const int tid = get_tid(), lane = tid & 63, wid = tid >> 6, fr = lane & 15, fq = lane >> 4;
  float* Ptok = (float*)(lds + 2 * STG);
  unsigned* maskL = (unsigned*)(lds + 2 * STG + 8192);
  char* Ot = lds + 2 * STG + 8192 + 64;
  float cbound;
  {
    float gq = fabsf(p.nsa_q_norm[lane]);
    float gk = fmaxf(fabsf(p.nsa_k_norm_cmp[lane]), fmaxf(fabsf(p.nsa_k_norm_slc[lane]), fabsf(p.nsa_k_norm_win[lane])));
#pragma unroll
    for (int m = 32; m >= 1; m >>= 1) { gq = fmaxf(gq, __shfl_xor(gq, m)); gk = fmaxf(gk, __shfl_xor(gk, m)); }
    cbound = 8.0f * LOG2E * gq * gk * 1.01f;
  }
  XcdIter xi; xi.init();
  for (int n = xi.lb; n < 512; n += xi.nlb) {
    const int bg = xi.xcd * 4 + (n >> 7), b = bg >> 1, g = bg & 1;
    const int tl128 = n & 127;
    const int t0 = (((n >> 6) & 1) ? (127 - (tl128 & 63)) : (tl128 & 63)) * 16;
    const int head = fr & 7;
    const int hg = g * 8 + head;
    const int pbase = p.pos[b * 2048 + t0];
    int tq[2]; float colc[2]; bf16x8 qf[2][2]; bf16x8 qa[2]; float gate[3][2];
    const float slope2 = exp2f(-0.5f * (float)(hg + 1)) * LOG2E;
#pragma unroll
    for (int qt = 0; qt < 2; ++qt) {
      tq[qt] = t0 + 4 * wid + 2 * qt + (fr >> 3);
      colc[qt] = -slope2 * (float)(p.pos[b * 2048 + tq[qt]] - pbase) - cbound;
      qa[qt] = make_qaug(slope2, colc[qt], fq);
      const bf16_t* qp = p.Q1 + ((size_t)(b * 16 + hg) * 2048 + tq[qt]) * 64;
      qf[qt][0] = *(const bf16x8*)(qp + fq * 8);
      qf[qt][1] = *(const bf16x8*)(qp + 32 + fq * 8);
      const float* gp = p.GATES + (size_t)(b * 2048 + tq[qt]) * 48 + hg;
      gate[0][qt] = gp[0]; gate[1][qt] = gp[16]; gate[2][qt] = gp[32];
    }
    char* orow[2];
#pragma unroll
    for (int qt = 0; qt < 2; ++qt) orow[qt] = Ot + (32 * wid + 16 * qt + fr) * OSTR + 8 * fq;
    auto out_acc = [&](const f32x4 (&o)[4][2], float f0, float f1, bool first) {
#pragma unroll
      for (int qt = 0; qt < 2; ++qt) {
        const float f = qt ? f1 : f0;
#pragma unroll
        for (int dt = 0; dt < 4; ++dt) {
          float a0 = o[dt][qt][0] * f, a1 = o[dt][qt][1] * f, a2 = o[dt][qt][2] * f, a3 = o[dt][qt][3] * f;
          if (!first) {
            const u32x2 w = *(const u32x2*)(orow[qt] + dt * 32);
            a0 += bflo(w[0]); a1 += bfhi(w[0]); a2 += bflo(w[1]); a3 += bfhi(w[1]);
          }
          u32x2 r; r[0] = pack2(a0, a1); r[1] = pack2(a2, a3);
          *(u32x2*)(orow[qt] + dt * 32) = r;
        }
      }
    };

    u32x4 rk[2], rv[2]; int rpos = 0;
    const int sr = tid >> 3, sc = tid & 7;
    auto fetch = [&](const bf16_t* Kg, const bf16_t* Vg, int vstride, const int* posg, int pstride, int pmax) {
      rk[0] = *(const u32x4*)(Kg + (size_t)sr * 64 + sc * 8);
      rk[1] = *(const u32x4*)(Kg + (size_t)(sr + 32) * 64 + sc * 8);
      rv[0] = *(const u32x4*)(Vg + (size_t)sr * vstride + sc * 8);
      rv[1] = *(const u32x4*)(Vg + (size_t)(sr + 32) * vstride + sc * 8);
      if (tid < 64) rpos = posg[min(tid * pstride, pmax)];
    };
    auto commit = [&](int st) {
      char* Ks = lds + st * STG; char* Vs = Ks + 9216;
      *(u32x4*)(Ks + sr * 144 + sc * 16) = rk[0];
      *(u32x4*)(Ks + (sr + 32) * 144 + sc * 16) = rk[1];
      *(u32x4*)(Vs + sr * 144 + sc * 16) = rv[0];
      *(u32x4*)(Vs + (sr + 32) * 144 + sc * 16) = rv[1];
      if (tid < 64) *(u32x4*)(Ks + 18432 + tid * 16) = make_kaug((float)(rpos - pbase));
    };
    auto fetch_win = [&](int key0) { PR q = *get_params(); fetch(q.KW + ((size_t)bg * 2048 + key0) * 64, q.VWt + (size_t)bg * 64 * 2048 + key0, 2048, q.pos + b * 2048 + key0, 1, 63); };
    auto fetch_slc = [&](int key0) { PR q = *get_params(); fetch(q.KS + ((size_t)bg * 2048 + key0) * 64, q.VSt + (size_t)bg * 64 * 2048 + key0, 2048, q.pos + b * 2048 + key0, 1, 63); };
    auto fetch_cmp = [&](int tile) { PR q = *get_params(); fetch(q.KCMP + ((size_t)bg * 128 + tile * 64) * 64, q.VCMPt + (size_t)bg * 64 * 128 + tile * 64, 128,
                                                                    q.pos + b * 2048 + 1024 * tile + 31, 16, 2047 - 1024 * tile - 31); };

    int stw;
    {
      __syncthreads();
      f32x4 o[4][2], ol[2];
      ol[0] = (f32x4){0.f, 0.f, 0.f, 0.f}; ol[1] = (f32x4){0.f, 0.f, 0.f, 0.f};
#pragma unroll
      for (int dt = 0; dt < 4; ++dt) { o[dt][0] = (f32x4){0.f, 0.f, 0.f, 0.f}; o[dt][1] = (f32x4){0.f, 0.f, 0.f, 0.f}; }
      const int kfirst = max(0, t0 - 255) >> 6, klast = t0 >> 6;
      stw = (klast - kfirst) & 1;
      fetch_win(kfirst * 64);
      for (int k64 = kfirst; k64 <= klast; ++k64) {
        const int key0 = k64 * 64;
        const int st = (k64 - kfirst) & 1;
        commit(st);
        __syncthreads();
        if (k64 < klast) fetch_win(key0 + 64); else fetch_cmp(0);
        const char* Kc = lds + st * STG;
        f32x4 s[4][2];
        qk_tile_aug<2, STR>(Kc, Kc + 18432, qf, qa, s, fr, fq);
        if (key0 < t0 + 15 - 255 || key0 + 63 > t0) {
#pragma unroll
          for (int kt = 0; kt < 4; ++kt)
#pragma unroll
            for (int j = 0; j < 4; ++j) {
              const int key = key0 + 16 * kt + 4 * fq + j;
#pragma unroll
              for (int qt = 0; qt < 2; ++qt) {
                const unsigned rel = (unsigned)(tq[qt] - key);
                s[kt][qt][j] = (rel < 256u) ? s[kt][qt][j] : NEGBIG;
              }
            }
        }
        exp_tile(s);
        pv_tile_l<STR>(Kc + 9216, s, o, ol, fr, fq);
      }
      {
        const float l0 = ol[0][0], l1 = ol[1][0];
        out_acc(o, (l0 > 0.f) ? gate[2][0] / l0 : 0.f, (l1 > 0.f) ? gate[2][1] / l1 : 0.f, true);
      }
    }

    {
      const int clim[2] = {(tq[0] - 31) >> 4, (tq[1] - 31) >> 4};
      const int sA = stw ^ 1, sB = stw;
      f32x4 ol[2];
      ol[0] = (f32x4){0.f, 0.f, 0.f, 0.f}; ol[1] = (f32x4){0.f, 0.f, 0.f, 0.f};
#pragma unroll
      for (int tl2 = 0; tl2 < 2; ++tl2) {
        const int st = tl2 ? sB : sA;
        commit(st);
        __syncthreads();
        if (tl2 == 0) fetch_cmp(1); else fetch_slc(0);
        f32x4 s[4][2];
        qk_tile_aug<2, STR>(lds + st * STG, lds + st * STG + 18432, qf, qa, s, fr, fq);
#pragma unroll
        for (int kt = 0; kt < 4; ++kt)
#pragma unroll
          for (int j = 0; j < 4; ++j) {
            const int c0 = tl2 * 64 + 16 * kt + 4 * fq + j;
#pragma unroll
            for (int qt = 0; qt < 2; ++qt) s[kt][qt][j] = fast_exp2((c0 <= clim[qt]) ? s[kt][qt][j] : NEGBIG);
          }
        rowsum_tile(s, ol);
      }
      float linv[2];
#pragma unroll
      for (int qt = 0; qt < 2; ++qt) { const float r = ol[qt][0]; linv[qt] = (r > 0.f) ? 1.0f / r : 0.f; }
      f32x4 o[4][2];
#pragma unroll
      for (int dt = 0; dt < 4; ++dt) { o[dt][0] = (f32x4){0.f, 0.f, 0.f, 0.f}; o[dt][1] = (f32x4){0.f, 0.f, 0.f, 0.f}; }
#pragma unroll
      for (int tl2 = 0; tl2 < 2; ++tl2) {
        const int st = tl2 ? sB : sA;
        f32x4 s[4][2];
        qk_tile_aug<2, STR>(lds + st * STG, lds + st * STG + 18432, qf, qa, s, fr, fq);
#pragma unroll
        for (int kt = 0; kt < 4; ++kt)
#pragma unroll
          for (int j = 0; j < 4; ++j) {
            const int c0 = tl2 * 64 + 16 * kt + 4 * fq + j;
#pragma unroll
            for (int qt = 0; qt < 2; ++qt) s[kt][qt][j] = fast_exp2((c0 <= clim[qt]) ? s[kt][qt][j] : NEGBIG);
          }
        pv_tile<STR>(lds + st * STG + 9216, s, o, fr, fq);
#pragma unroll
        for (int qt = 0; qt < 2; ++qt) {
          const int tl = 4 * wid + 2 * qt + (fr >> 3);
#pragma unroll
          for (int kt = 0; kt < 4; ++kt) {
            f32x4 hs;
#pragma unroll
            for (int j = 0; j < 4; ++j) hs[j] = head8_sum(s[kt][qt][j] * linv[qt]);
            if (head == 0) *(f32x4*)(Ptok + tl * 128 + tl2 * 64 + 16 * kt + 4 * fq) = hs;
          }
        }
      }
      out_acc(o, gate[0][0] * linv[0], gate[0][1] * linv[1], false);
      __syncthreads();
      const int cur = t0 >> 6;
      const int j = tid & 31;
#pragma unroll
      for (int i = 0; i < 2; ++i) {
        const int tl = (tid >> 5) + 8 * i;
        float im = 0.f;
        for (int c = max(4 * j - 1, 0); c <= 4 * j + 3; ++c) im += Ptok[tl * 128 + c];
        const bool forced = (j == 0) || (j == cur) || (j == cur - 1);
        const float v = forced ? 1e4f : ((j <= cur) ? im : -1.0f);
        unsigned key = ((v < 0.f) ? 0u : (__float_as_uint(v) | 0x80000000u));
        key = (key & ~31u) | (unsigned)(31 - j);
        bool sel = false;
#pragma unroll
        for (int rnd = 0; rnd < 8; ++rnd) {
          unsigned m = key;
          m = max(m, (unsigned)__builtin_amdgcn_update_dpp(0, (int)m, 0xB1, 0xF, 0xF, true));
          m = max(m, (unsigned)__builtin_amdgcn_update_dpp(0, (int)m, 0x4E, 0xF, 0xF, true));
          m = max(m, (unsigned)__builtin_amdgcn_update_dpp(0, (int)m, 0x141, 0xF, 0xF, true));
          m = max(m, (unsigned)__builtin_amdgcn_update_dpp(0, (int)m, 0x140, 0xF, 0xF, true));
          m = max(m, (unsigned)__shfl_xor((int)m, 16));
          const bool win = (key == m);
          sel = sel || win;
          key = win ? 0u : key;
        }
        const unsigned long long bal = __ballot(sel);
        if (j == 0) maskL[tl] = (unsigned)(bal >> (lane & 32));
      }
      __syncthreads();
    }

    {
      const int cur = t0 >> 6;
      const unsigned curmask = (cur >= 31) ? 0xffffffffu : ((2u << cur) - 1u);
      unsigned um = 0u;
#pragma unroll
      for (int i = 0; i < 16; ++i) um |= maskL[i];
      um &= curmask;
      unsigned mq[2];
#pragma unroll
      for (int qt = 0; qt < 2; ++qt) mq[qt] = maskL[4 * wid + 2 * qt + (fr >> 3)];
      const unsigned wm = (maskL[4 * wid] | maskL[4 * wid + 1] | maskL[4 * wid + 2] | maskL[4 * wid + 3]) & curmask;
      f32x4 o[4][2], ol[2];
      ol[0] = (f32x4){0.f, 0.f, 0.f, 0.f}; ol[1] = (f32x4){0.f, 0.f, 0.f, 0.f};
#pragma unroll
      for (int dt = 0; dt < 4; ++dt) { o[dt][0] = (f32x4){0.f, 0.f, 0.f, 0.f}; o[dt][1] = (f32x4){0.f, 0.f, 0.f, 0.f}; }
      unsigned rem = um;
      for (int step = 0; rem != 0u; ++step) {
        const int jb = __builtin_ctz(rem); rem &= rem - 1u;
        const int key0 = jb * 64;
        const int st = step & 1;
        commit(st);
        __syncthreads();
        if (rem != 0u) fetch_slc(__builtin_ctz(rem) * 64);
        if ((wm >> jb) & 1u) {
          const char* Kc = lds + st * STG;
          f32x4 s[4][2];
          bf16x8 qs[2];
          qs[0] = make_qaug(slope2, ((mq[0] >> jb) & 1u) ? colc[0] : NEGBIG, fq);
          qs[1] = make_qaug(slope2, ((mq[1] >> jb) & 1u) ? colc[1] : NEGBIG, fq);
          qk_tile_aug<2, STR>(Kc, Kc + 18432, qf, qs, s, fr, fq);
          {
#pragma unroll
            for (int kt = 0; kt < 4; ++kt)
#pragma unroll
              for (int j = 0; j < 4; ++j) {
                const int key = key0 + 16 * kt + 4 * fq + j;
#pragma unroll
                for (int qt = 0; qt < 2; ++qt) s[kt][qt][j] = (key <= tq[qt]) ? s[kt][qt][j] : NEGBIG;
              }
          }
          exp_tile(s);
          pv_tile_l<STR>(Kc + 9216, s, o, ol, fr, fq);
        }
      }
      {
        const float l0 = ol[0][0], l1 = ol[1][0];
        out_acc(o, (l0 > 0.f) ? gate[1][0] / l0 : 0.f, (l1 > 0.f) ? gate[1][1] / l1 : 0.f, false);
      }
    }
    {
      const int c16 = lane & 7;
#pragma unroll
      for (int i = 0; i < 4; ++i) {
        const int r = (lane >> 3) + 8 * i;
        const int tok = t0 + 4 * wid + 2 * (r >> 4) + ((r & 15) >> 3), hh = g * 8 + (r & 7);
        const char* src = Ot + (32 * wid + r) * OSTR + c16 * 16;
        const u32x2 lo = *(const u32x2*)(src), hi = *(const u32x2*)(src + 8);
        *(u32x4*)(p.hn + (size_t)(b * 2048 + tok) * 1024 + hh * 64 + c16 * 8) = (u32x4){lo[0], lo[1], hi[0], hi[1]};
      }
    }
    __syncthreads();
  }
}

DEVI void misc_init(PR p) {
  if (blockIdx.x >= gridDim.x - 9 && blockIdx.x < gridDim.x - 1) {
    const int part = blockIdx.x - (gridDim.x - 9);
    const int layer = part >> 2, k = (part & 3) * 256 + get_tid();
    const float g = p.norm_ffn[layer * 1024 + k];
    for (int n = 0; n < 48; ++n) {
      float w = 0.f;
      if (n < 4) w = p.r_group[((size_t)layer * 1024 + k) * 4 + n];
      else if (n < 36) w = p.r_expert[((size_t)layer * 1024 + k) * 32 + (n - 4)];
      w *= g;
      const float hi = bf_round(w);
      p.RWh[((size_t)layer * 48 + n) * 1024 + k] = f2bf(hi);
      p.RWl[((size_t)layer * 48 + n) * 1024 + k] = f2bf(w - hi);
    }
  }
  if (blockIdx.x == gridDim.x - 1) {
    const int tid = get_tid();
    if (tid < 64) p.gcnt[tid] = 0;
    p.gcntP[tid] = 0;
    const int kv = tid >> 7, n = tid & 127;
    const float* pe = kv ? p.cmp_pe_v : p.cmp_pe_k;
    const float* w1 = kv ? p.cmp_w1_v : p.cmp_w1_k;
    float a = 0.f;
    for (int i = 0; i < 2048; ++i) a += pe[i] * w1[(size_t)i * 128 + n];
    p.bias1[tid] = a;
  }
}


#define XB_TMO      128
#define XB_XCNT(j)  (256  + 64 * (j))
#define XB_XSUB(j)  (1280 + 64 * (j))
#define XB_XGEN(j)  (2304 + 64 * (j))
#define XB_TOP      3328
#define XB_TOPGEN   3392
#define XCD_BAR_WORDS 3456
#define XB_SPIN_CAP (1u << 20)
#define LAS __attribute__((address_space(3)))
DEVI unsigned xb_ld(unsigned* p) { return __hip_atomic_load(p, __ATOMIC_RELAXED, __HIP_MEMORY_SCOPE_AGENT); }
DEVI unsigned xb_add(unsigned* p, unsigned v) { return __hip_atomic_fetch_add(p, v, __ATOMIC_RELAXED, __HIP_MEMORY_SCOPE_AGENT); }
DEVI unsigned xb_xcc_id() { return (unsigned)__builtin_amdgcn_s_getreg((3 << 11) | 20) & 0xFu; }
#define XB_SPIN(cond, bar) do { unsigned _sp = 0; while (cond) { __builtin_amdgcn_s_sleep(1); \
    if ((++_sp & 255u) == 0u) { if (xb_ld(&(bar)[XB_TMO])) break; if (_sp > XB_SPIN_CAP) { atomicAdd(&(bar)[XB_TMO], 1u); break; } } } } while (0)
struct XcdBarrier { unsigned* bar; unsigned x; volatile LAS unsigned* st; };
DEVI XcdBarrier xcd_barrier_post(unsigned* bar, volatile LAS unsigned* st) {
  XcdBarrier b; b.bar = bar; b.x = xb_xcc_id(); b.st = st;
  if (threadIdx.x == 0) (void)xb_add(&bar[XB_XCNT(b.x)], 1u);
  return b;
}
DEVI void xcd_barrier_complete(unsigned* bar, unsigned x, unsigned& nloc, unsigned& nx) {
  const unsigned G = gridDim.x * gridDim.y * gridDim.z;
  unsigned sum, cnt, mine, sp = 0u;
  for (;;) {
    sum = 0u; cnt = 0u; mine = 0u;
#pragma unroll
    for (unsigned j = 0; j < 16; ++j) { const unsigned c = xb_ld(&bar[XB_XCNT(j)]); sum += c; cnt += (c > 0u) ? 1u : 0u; mine = (j == x) ? c : mine; }
    if (sum == G) break;
    __builtin_amdgcn_s_sleep(1);
    if ((++sp & 255u) == 0u) { if (xb_ld(&bar[XB_TMO])) break; if (sp > XB_SPIN_CAP) { atomicAdd(&bar[XB_TMO], 1u); break; } }
  }
  nloc = mine > 0u ? mine : 1u; nx = cnt > 0u ? cnt : 1u;
}
DEVI void xcd_barrier(const XcdBarrier& b) {
  asm volatile("s_waitcnt vmcnt(0)" ::: "memory");
  __syncthreads();
  if (threadIdx.x == 0) {
    unsigned* bar = b.bar;
    __builtin_amdgcn_s_waitcnt(0);
    unsigned nloc = b.st[0], nx = b.st[1];
    if (nloc == 0u) { xcd_barrier_complete(bar, b.x, nloc, nx); b.st[0] = nloc; b.st[1] = nx; }
    const unsigned old = xb_add(&bar[XB_XSUB(b.x)], 1u);
    const unsigned gen = old / nloc;
    if (old + 1u == (gen + 1u) * nloc) {
      __builtin_amdgcn_fence(__ATOMIC_RELEASE, "agent");
      asm volatile("s_waitcnt vmcnt(0)" ::: "memory");
      const unsigned og = xb_add(&bar[XB_TOP], 1u);
      const unsigned tg = og / nx;
      if (og + 1u == (tg + 1u) * nx) xb_add(&bar[XB_TOPGEN], 1u);
      else XB_SPIN(xb_ld(&bar[XB_TOPGEN]) == tg, bar);
      __builtin_amdgcn_fence(__ATOMIC_ACQUIRE, "agent");
      xb_add(&bar[XB_XGEN(b.x)], 1u);
      asm volatile("s_waitcnt vmcnt(0)" ::: "memory");
    } else {
      XB_SPIN(xb_ld(&bar[XB_XGEN(b.x)]) == gen, bar);
      __builtin_amdgcn_fence(__ATOMIC_ACQUIRE, "agent");
      asm volatile("s_waitcnt vmcnt(0)" ::: "memory");
    }
  }
  __syncthreads();
}

#ifndef PROBE_PHASE
#define PROBE_PHASE -1
#endif
#define GSYNC() do { if (use_cg) grid.sync(); else xcd_barrier(xb); } while (0)
__global__ void __launch_bounds__(256, 2) mega_kernel(Params p_unused) {
  extern __shared__ __attribute__((aligned(16))) char lds[];
  cg::grid_group grid = cg::this_grid();
  volatile LAS unsigned* xst = (volatile LAS unsigned*)(lds + LDS_BYTES - 16);
  if (threadIdx.x == 0) { xst[0] = 0u; xst[1] = 0u; }
  __syncthreads();
  unsigned* barw; int use_cg;
  { PR p = *get_params(); barw = p.bar; use_cg = p.use_cg; }
  const XcdBarrier xb = xcd_barrier_post(barw, xst);
  { PR p = *get_params(); conv_weights_phase(p, 0, p.njobsA, p.ntilesA, lds); }
  { PR p = *get_params(); rownorm_phase(p.x, nullptr, p.norm_mix, (float*)nullptr, p.hn); }
  { PR p = *get_params(); misc_init(p); }
  GSYNC();
#if PROBE_PHASE == 0
  { PR p = *get_params(); conv_weights_phase(p, 0, p.njobsA, p.ntilesA, lds); }
  { PR p = *get_params(); rownorm_phase(p.x, nullptr, p.norm_mix, (float*)nullptr, p.hn); }
  GSYNC();
#endif
  { PR p = *get_params(); gemm_bf16out_phase(p.hn, 1024, p.W1t, 1024, 12, p.proj0, 1440, 1440, lds); }
  { PR p = *get_params(); conv_weights_phase(p, p.njobsA, p.njobs0, p.ntiles0, lds); }
  GSYNC();
#if PROBE_PHASE == 1
  { PR p = *get_params(); gemm_bf16out_phase(p.hn, 1024, p.W1t, 1024, 12, p.proj0, 1440, 1440, lds); }
  GSYNC();
#endif
  { PR p = *get_params(); l0_phase2(p, lds); }
  GSYNC();
#if PROBE_PHASE == 2
  { PR p = *get_params(); l0_phase2(p, lds); }
  GSYNC();
#endif
  { PR p = *get_params(); mla_attn_phase(p, lds); }
  GSYNC();
#if PROBE_PHASE == 3
  { PR p = *get_params(); mla_attn_phase(p, lds); }
  GSYNC();
#endif
  { PR p = *get_params(); gemm_resid_phase(p.hn, p.Wo0t, p.x, p.xr, lds); }
  GSYNC();
#if PROBE_PHASE == 4
  { PR p = *get_params(); gemm_resid_phase(p.hn, p.Wo0t, p.x, p.xr, lds); }
  GSYNC();
#endif
#if PROBE_PHASE == 5
  { PR p = *get_params(); router_phase(p, 1, lds); }
  GSYNC();
  { PR p = *get_params(); if (blockIdx.x == 0 && threadIdx.x < 32) p.gcnt[32 + threadIdx.x] = 0; }
#endif
  { PR p = *get_params(); router_phase(p, 0, lds); }
  GSYNC();
  { PR p = *get_params(); moe_gateup_phase(p, 0, lds); }
  GSYNC();
#if PROBE_PHASE == 6
  { PR p = *get_params(); moe_gateup_phase(p, 0, lds); }
  GSYNC();
#endif
  { PR p = *get_params(); moe_down_phase(p, 0, lds); }
  GSYNC();
#if PROBE_PHASE == 7
  { PR p = *get_params(); moe_down_phase(p, 0, lds); }
  GSYNC();
#endif
  { PR p = *get_params(); rownorm_phase(p.xr, nullptr, p.norm_mix + 1024, (bf16_t*)nullptr, p.hn); }
  GSYNC();
  { PR p = *get_params(); nsa_proj_phase(p, lds); }
  GSYNC();
#if PROBE_PHASE == 9
  { PR p = *get_params(); nsa_proj_phase(p, lds); }
  GSYNC();
#endif
  { PR p = *get_params(); compress_phase(p, lds); }
  { PR p = *get_params(); conv_weights_phase(p, p.njobs1_begin, p.njobs1_begin + 3, p.ntiles1, lds); }
  GSYNC();
#if PROBE_PHASE == 10
  { PR p = *get_params(); compress_phase(p, lds); }
  GSYNC();
#endif
  { PR p = *get_params(); nsa_attn_phase(p, lds); }
  GSYNC();
#if PROBE_PHASE == 11
  { PR p = *get_params(); nsa_attn_phase(p, lds); }
  GSYNC();
#endif
  { PR p = *get_params(); gemm_resid_phase(p.hn, p.Wo1t, p.xr, p.xr, lds); }
  GSYNC();
  { PR p = *get_params(); router_phase(p, 1, lds); }
  GSYNC();
  { PR p = *get_params(); moe_gateup_phase(p, 1, lds); }
  GSYNC();
  { PR p = *get_params(); moe_down_phase(p, 1, lds); }
}

static inline size_t align_up(size_t v, size_t a) { return (v + a - 1) / a * a; }

extern "C" void kernel_launch(void* const* d_in, const int* in_sizes, int n_in, void* d_out, int out_size, void* d_ws, size_t ws_size,
                              hipStream_t stream) {
  (void)in_sizes; (void)n_in; (void)out_size;
  Params p;
  memset(&p, 0, sizeof(p));
  const float* const* in = (const float* const*)d_in;
  p.x = in[0]; p.pos = (const int*)d_in[1]; p.norm_mix = in[2]; p.norm_ffn = in[3];
  const float* mix0_w_in = in[4]; const float* mla_q_a_norm = in[5]; const float* mla_w_uq = in[6];
  const float* mla_kv_a_norm = in[7]; const float* mla_w_ukv = in[8];
  p.mla_q_norm = in[9]; p.mla_k_norm = in[10];
  p.conv_dw_w = in[11]; p.conv_dw_b = in[12]; p.conv_ln_g = in[13]; p.conv_ln_b = in[14];
  const float* mix0_w_out = in[15]; const float* nsa_w_in = in[16];
  p.nsa_q_norm = in[17]; p.nsa_k_norm_cmp = in[18]; p.nsa_k_norm_slc = in[19]; p.nsa_k_norm_win = in[20];
  p.cmp_pe_k = in[21]; p.cmp_w1_k = in[22]; const float* cmp_w2_k = in[23];
  p.cmp_pe_v = in[24]; p.cmp_w1_v = in[25]; const float* cmp_w2_v = in[26];
  const float* nsa_w_out = in[27];
  p.r_group = in[28]; p.r_group_b = in[29]; p.r_expert = in[30]; p.r_expert_b = in[31];
  const float* w_gate = in[32]; const float* w_up = in[33]; const float* w_down = in[34];
  p.out = (float*)d_out;

  char* ws = (char*)d_ws; size_t off = 0;
  auto take = [&](size_t bytes) { char* r = ws + off; off = align_up(off + bytes, 256); return r; };
  p.W1t = (bf16_t*)take((size_t)1536 * 1024 * 2);
  p.Wuqt = (bf16_t*)take((size_t)768 * 256 * 2);
  p.Wukvt = (bf16_t*)take((size_t)1024 * 128 * 2);
  p.Wo0t = (bf16_t*)take((size_t)1024 * 1024 * 2);
  p.W5t = (bf16_t*)take((size_t)1920 * 1024 * 2);
  p.Wc1kt = (bf16_t*)take((size_t)128 * 2048 * 2);
  p.Wc1vt = (bf16_t*)take((size_t)128 * 2048 * 2);
  p.Wc2kt = (bf16_t*)take((size_t)64 * 128 * 2);
  p.Wc2vt = (bf16_t*)take((size_t)64 * 128 * 2);
  p.Wo1t = (bf16_t*)take((size_t)1024 * 1024 * 2);
  p.Wgut = (bf16_t*)take((size_t)32 * 512 * 1024 * 2);
  p.Wdt = (bf16_t*)take((size_t)32 * 1024 * 256 * 2);
  p.xr = (bf16_t*)take((size_t)T_ * 1024 * 2);
  p.hn = (bf16_t*)take((size_t)T_ * 1024 * 2);
  p.RWh = (bf16_t*)take((size_t)2 * 48 * 1024 * 2);
  p.RWl = (bf16_t*)take((size_t)2 * 48 * 1024 * 2);
  p.rs = (float*)take((size_t)T_ * 4);
  p.row_aux = (float2*)take((size_t)32 * T_ * 8);
  p.row_tok = (int*)take((size_t)32 * T_ * 4);
  p.gcnt = (int*)take(256);
  p.gcntP = (int*)take(1024);
  p.pair_tok = (int*)take((size_t)112 * T_ * 4);
  p.pair_rk = (int2*)take((size_t)112 * T_ * 8);
  p.bias1 = (float*)take(1024);
  p.bar = (unsigned*)take((size_t)XCD_BAR_WORDS * 4);
  p.use_cg = 0;
  p.KCMP = (bf16_t*)take((size_t)32 * 128 * 64 * 2);
  p.VCMPt = (bf16_t*)take((size_t)32 * 64 * 128 * 2);
  char* scr = ws + off;
  {
    size_t o = 0;
    auto tk = [&](size_t bytes) { char* r = scr + o; o = align_up(o + bytes, 256); return r; };
    p.proj0 = (bf16_t*)tk((size_t)T_ * 1440 * 2);
    p.Q0 = (bf16_t*)tk((size_t)T_ * 768 * 2);
    p.K0 = (bf16_t*)tk((size_t)T_ * 768 * 2);
    p.V0t = (bf16_t*)tk((size_t)T_ * 512 * 2);
  }
  {
    size_t o = 0;
    auto tk = [&](size_t bytes) { char* r = scr + o; o = align_up(o + bytes, 256); return r; };
    p.hbuf = (bf16_t*)tk((size_t)(2 * T_ + 4096) * 256 * 2);
  }
  {
    size_t o = 0;
    auto tk = [&](size_t bytes) { char* r = scr + o; o = align_up(o + bytes, 256); return r; };
    p.Q1 = (bf16_t*)tk((size_t)T_ * 1024 * 2);
    p.KC = (bf16_t*)tk((size_t)T_ * 128 * 2);
    p.VC = (bf16_t*)tk((size_t)T_ * 128 * 2);
    p.KS = (bf16_t*)tk((size_t)T_ * 128 * 2);
    p.VSt = (bf16_t*)tk((size_t)T_ * 128 * 2);
    p.KW = (bf16_t*)tk((size_t)T_ * 128 * 2);
    p.VWt = (bf16_t*)tk((size_t)T_ * 128 * 2);
    p.GATES = (float*)tk((size_t)T_ * 48 * 4);
  }
  const size_t need = off + (size_t)T_ * (1440 + 768 + 768 + 512) * 2 + 4096;
  if (need > ws_size) { fprintf(stderr, "workspace too small: need %zu have %zu\n", need, ws_size); return; }
  for (int i = 0; i < 16; ++i) p.inv_freq[i] = (float)pow(10000.0, -(double)i / 16.0);

  int nj = 0, tiles = 0;
  auto add = [&](const float* src, bf16_t* dst, const float* gain, int K, int N, int Npad, int mode, int batch, long long ss, long long ds) {
    ConvJob& j = p.jobs[nj++];
    j.src = src; j.dst = dst; j.gain = gain; j.K = K; j.N = N; j.Npad = Npad; j.mode = mode; j.batch = batch; j.tile_start = tiles; j.pad0 = 0;
    j.sstride = ss; j.dstride = ds;
    tiles += batch * (K / 64) * (Npad / 64);
  };
  add(mix0_w_in, p.W1t, nullptr, 1024, 1440, 1536, 0, 1, 0, 0);
  add(mla_w_uq, p.Wuqt, mla_q_a_norm, 256, 768, 768, 0, 1, 0, 0);
  add(mla_w_ukv, p.Wukvt, mla_kv_a_norm, 128, 1024, 1024, 0, 1, 0, 0);
  add(mix0_w_out, p.Wo0t, nullptr, 1024, 1024, 1024, 0, 1, 0, 0);
  add(nsa_w_in, p.W5t, nullptr, 1024, 1840, 1920, 0, 1, 0, 0);
  add(p.cmp_w1_k, p.Wc1kt, nullptr, 2048, 128, 128, 0, 1, 0, 0);
  add(p.cmp_w1_v, p.Wc1vt, nullptr, 2048, 128, 128, 0, 1, 0, 0);
  add(cmp_w2_k, p.Wc2kt, nullptr, 128, 64, 64, 0, 1, 0, 0);
  add(cmp_w2_v, p.Wc2vt, nullptr, 128, 64, 64, 0, 1, 0, 0);
  add(nsa_w_out, p.Wo1t, nullptr, 1024, 1024, 1024, 0, 1, 0, 0);
  p.njobsA = nj; p.ntilesA = tiles;
  tiles = 0;
  add(w_gate, p.Wgut, p.norm_ffn, 1024, 256, 256, 1, 32, 1024LL * 256, 512LL * 1024);
  add(w_up, p.Wgut, p.norm_ffn, 1024, 256, 256, 2, 32, 1024LL * 256, 512LL * 1024);
  add(w_down, p.Wdt, nullptr, 256, 1024, 1024, 0, 32, 256LL * 1024, 1024LL * 256);
  p.njobs0 = nj; p.ntiles0 = tiles;
  p.njobs1_begin = nj;
  tiles = 0;
  const size_t l1 = (size_t)32 * 1024 * 256;
  add(w_gate + l1, p.Wgut, p.norm_ffn + 1024, 1024, 256, 256, 1, 32, 1024LL * 256, 512LL * 1024);
  add(w_up + l1, p.Wgut, p.norm_ffn + 1024, 1024, 256, 256, 2, 32, 1024LL * 256, 512LL * 1024);
  add(w_down + l1, p.Wdt, nullptr, 256, 1024, 1024, 0, 32, 256LL * 1024, 1024LL * 256);
  p.ntiles1 = tiles;

  static int grid_blocks = 0;
  if (!grid_blocks) {
    (void)hipFuncSetAttribute((const void*)mega_kernel, hipFuncAttributeMaxDynamicSharedMemorySize, LDS_BYTES);
    int dev = 0, cus = 0, per_cu = 0;
    (void)hipGetDevice(&dev);
    (void)hipDeviceGetAttribute(&cus, hipDeviceAttributeMultiprocessorCount, dev);
    (void)hipOccupancyMaxActiveBlocksPerMultiprocessor(&per_cu, mega_kernel, 256, LDS_BYTES);
    if (per_cu > 2) per_cu = 2;
    if (per_cu < 1) per_cu = 1;
    grid_blocks = cus * per_cu;
  }
  (void)hipMemsetAsync(p.bar, 0, (size_t)XCD_BAR_WORDS * 4, stream);
  void* args[] = {&p};
  hipError_t e = hipLaunchCooperativeKernel((const void*)mega_kernel, dim3(grid_blocks), dim3(256), args, LDS_BYTES, stream);
  if (e != hipSuccess) fprintf(stderr, "cooperative launch failed: %s (grid %d)\n", hipGetErrorString(e), grid_blocks);
}
```

```cpp
#include <hip/hip_runtime.h>
#include <hip/hip_cooperative_groups.h>
#include <stdint.h>
#include <math.h>
#include <stdio.h>
#include <string.h>
namespace cg = cooperative_groups;

typedef unsigned short bf16_t;
typedef short bf16x8 __attribute__((ext_vector_type(8)));
typedef float f32x4 __attribute__((ext_vector_type(4)));
typedef unsigned u32x4 __attribute__((ext_vector_type(4)));
typedef unsigned u32x2 __attribute__((ext_vector_type(2)));

#define DEVI __device__ __forceinline__
#define AS4 __attribute__((address_space(4)))

constexpr int T_ = 32768;
constexpr int S_ = 2048;
constexpr int LDS_BYTES = 73728;
constexpr float LOG2E = 1.4426950408889634f;
constexpr float NEGBIG = -1e30f;

struct ConvJob {
  const float* src; bf16_t* dst; const float* gain;
  int K, N, Npad, mode, batch, tile_start, pad0;
  long long sstride, dstride;
};
constexpr int MAXJOBS = 16;

struct Params {
  const float* x; const int* pos; const float* norm_mix; const float* norm_ffn;
  const float* mla_q_norm; const float* mla_k_norm;
  const float* conv_dw_w; const float* conv_dw_b; const float* conv_ln_g; const float* conv_ln_b;
  const float* nsa_q_norm; const float* nsa_k_norm_cmp; const float* nsa_k_norm_slc; const float* nsa_k_norm_win;
  const float* cmp_pe_k; const float* cmp_w1_k; const float* cmp_pe_v; const float* cmp_w1_v;
  const float* r_group; const float* r_group_b; const float* r_expert; const float* r_expert_b;
  float* out;
  bf16_t* W1t; bf16_t* Wuqt; bf16_t* Wukvt; bf16_t* Wo0t; bf16_t* W5t;
  bf16_t* Wc1kt; bf16_t* Wc1vt; bf16_t* Wc2kt; bf16_t* Wc2vt; bf16_t* Wo1t;
  bf16_t* Wgut; bf16_t* Wdt;
  bf16_t* xr;
  bf16_t* hn;
  bf16_t* proj0; bf16_t* Q0; bf16_t* K0; bf16_t* V0t;
  bf16_t* hbuf;
  bf16_t* Q1; bf16_t* KC; bf16_t* VC; bf16_t* KS; bf16_t* VSt; bf16_t* KW; bf16_t* VWt; float* GATES;
  bf16_t* KCMP; bf16_t* VCMPt;
  bf16_t* RWh; bf16_t* RWl; float* rs; float2* row_aux; int* row_tok; int* gcnt; float* bias1; unsigned* bar;
  bf16_t* xb; float* rs0;
  float* ssp;
  int* pair_tok; int2* pair_rk; int* gcntP;
  float inv_freq[16];
  ConvJob jobs[MAXJOBS];
  int njobs0, ntiles0, njobs1_begin, ntiles1, use_cg, njobsA, ntilesA, pad3;
};

typedef const AS4 Params& PR;
DEVI const AS4 Params* get_params() {
  const AS4 Params* kp = (const AS4 Params*)__builtin_amdgcn_kernarg_segment_ptr();
  asm volatile("" : "+s"(kp));
  return kp;
}

DEVI int get_tid() { int t = threadIdx.x; asm volatile("" : "+v"(t)); return t; }

typedef float f32x2_ __attribute__((ext_vector_type(2)));
typedef __bf16 bf16x2_ __attribute__((ext_vector_type(2)));
DEVI unsigned pack2(float lo, float hi) { const f32x2_ v = {lo, hi}; return __builtin_bit_cast(unsigned, __builtin_convertvector(v, bf16x2_)); }
DEVI float bflo(unsigned w) { return __uint_as_float(w << 16); }
DEVI float bfhi(unsigned w) { return __uint_as_float(w & 0xffff0000u); }
DEVI float bf2f(bf16_t h) { return __uint_as_float(((unsigned)h) << 16); }
DEVI bf16_t f2bf(float f) { return (bf16_t)(pack2(f, 0.f) & 0xffffu); }
DEVI float fast_exp2(float x) { return __builtin_amdgcn_exp2f(x); }
DEVI float fast_rcp(float x) { return __builtin_amdgcn_rcpf(x); }
DEVI float sigmoidf_(float x) { return fast_rcp(1.0f + fast_exp2(-x * LOG2E)); }
DEVI float wave_sum(float v) {
  v += __shfl_xor(v, 32); v += __shfl_xor(v, 16); v += __shfl_xor(v, 8);
  v += __shfl_xor(v, 4); v += __shfl_xor(v, 2); v += __shfl_xor(v, 1); return v;
}
DEVI void sincos_rev(float ang, float& s, float& c) {
  float rev = ang * 0.15915494309189535f;
  rev = rev - floorf(rev);
  s = __builtin_amdgcn_sinf(rev); c = __builtin_amdgcn_cosf(rev);
}

struct XcdIter {
  int xcd, lb, nlb;
  DEVI void init() { xcd = blockIdx.x & 7; lb = blockIdx.x >> 3; nlb = gridDim.x >> 3; }
};

DEVI int swz(int r, int c16) { return r * 128 + ((c16 ^ ((r >> 1) & 7)) << 4); }

template <int NT>
DEVI void mma_stage(const char* As, const char* Bs, f32x4 (&acc)[4][NT], int wr, int wc, int fr, int fq) {
  bf16x8 a[2][4], b[2][NT];
#pragma unroll
  for (int ks = 0; ks < 2; ++ks) {
#pragma unroll
    for (int m = 0; m < 4; ++m) a[ks][m] = *(const bf16x8*)(As + swz(wr * 64 + m * 16 + fr, ks * 4 + fq));
#pragma unroll
    for (int n = 0; n < NT; ++n) b[ks][n] = *(const bf16x8*)(Bs + swz(wc * (NT * 16) + n * 16 + fr, ks * 4 + fq));
  }
  __builtin_amdgcn_sched_barrier(0);
#pragma unroll
  for (int ks = 0; ks < 2; ++ks) {
#pragma unroll
    for (int m = 0; m < 4; ++m)
#pragma unroll
      for (int n = 0; n < NT; ++n) acc[m][n] = __builtin_amdgcn_mfma_f32_16x16x32_bf16(a[ks][m], b[ks][n], acc[m][n], 0, 0, 0);
    __builtin_amdgcn_sched_barrier(0);
  }
}

template <int NT, class ARow, class BRow>
DEVI void gemm_mainloop2(f32x4 (&acc)[4][NT], ARow arow, BRow brow, int K, char* lds);

template <int NT, class ARow>
DEVI void gemm_mainloop(f32x4 (&acc)[4][NT], ARow arow, const bf16_t* __restrict__ Bt, int ldb, int K, char* lds) {
  gemm_mainloop2<NT>(acc, arow, [&](int r) { return Bt + (size_t)r * ldb; }, K, lds);
}

template <int NT, class ARow, class BRow>
DEVI void gemm_mainloop2(f32x4 (&acc)[4][NT], ARow arow, BRow brow, int K, char* lds) {
  constexpr int NBR = NT;
  constexpr int STAGE = 16384 + NT * 32 * 128;
  const int tid = get_tid(), lane = tid & 63, wid = tid >> 6, wr = wid >> 1, wc = wid & 1, fr = lane & 15, fq = lane >> 4;
  const int lr = tid >> 3, lc = (tid & 7) ^ ((lr >> 1) & 7);
  const bf16_t* ap[4]; const bf16_t* bp[NBR];
#pragma unroll
  for (int i = 0; i < 4; ++i) ap[i] = arow(lr + 32 * i) + lc * 8;
#pragma unroll
  for (int i = 0; i < NBR; ++i) bp[i] = brow(lr + 32 * i) + lc * 8;
#pragma unroll
  for (int m = 0; m < 4; ++m)
#pragma unroll
    for (int n = 0; n < NT; ++n) acc[m][n] = (f32x4){0.f, 0.f, 0.f, 0.f};
  const int nk = K >> 6;
  auto issue = [&](int kt) {
    char* As = lds + (kt & 1) * STAGE + tid * 16; char* Bs = As + 16384;
#pragma unroll
    for (int i = 0; i < 4; ++i) __builtin_amdgcn_global_load_lds((const unsigned*)(ap[i] + kt * 64), (unsigned*)(As + i * 4096), 16, 0, 0);
#pragma unroll
    for (int i = 0; i < NBR; ++i) __builtin_amdgcn_global_load_lds((const unsigned*)(bp[i] + kt * 64), (unsigned*)(Bs + i * 4096), 16, 0, 0);
  };
  issue(0);
  for (int kt = 0; kt < nk; ++kt) {
    asm volatile("s_waitcnt vmcnt(0)" ::: "memory");
    __syncthreads();
    if (kt + 1 < nk) issue(kt + 1);
    const char* As = lds + (kt & 1) * STAGE; const char* Bs = As + 16384;
    mma_stage<NT>(As, Bs, acc, wr, wc, fr, fq);
  }
  __syncthreads();
}

template <class Rows2>
DEVI void gemm_mainloop_pair(f32x4 (&acc)[4][4], Rows2 rows2, const bf16_t* WA, const bf16_t* WB, char* lds) {
  constexpr int STAGE = 32768;
  const int tid = get_tid(), lane = tid & 63, wid = tid >> 6, wr = wid >> 1, wc = wid & 1, fr = lane & 15, fq = lane >> 4;
  const int lr = tid >> 3, lc = (tid & 7) ^ ((lr >> 1) & 7);
  const bf16_t* ap[4]; const bf16_t* ap2[4]; const bf16_t* bp[4]; const bf16_t* bp2[4];
#pragma unroll
  for (int i = 0; i < 4; ++i) {
    const bf16_t* pa; const bf16_t* pb;
    rows2(lr + 32 * i, pa, pb);
    ap[i] = pa + lc * 8; ap2[i] = pb + lc * 8 - 256;
    bp[i] = WA + (size_t)(lr + 32 * i) * 256 + lc * 8; bp2[i] = WB + (size_t)(lr + 32 * i) * 256 + lc * 8 - 256;
  }
#pragma unroll
  for (int m = 0; m < 4; ++m)
#pragma unroll
    for (int n = 0; n < 4; ++n) acc[m][n] = (f32x4){0.f, 0.f, 0.f, 0.f};
  auto issue = [&](int kt) {
    char* As = lds + (kt & 1) * STAGE + tid * 16; char* Bs = As + 16384;
    const bool second = kt >= 4;
#pragma unroll
    for (int i = 0; i < 4; ++i) __builtin_amdgcn_global_load_lds((const unsigned*)((second ? ap2[i] : ap[i]) + kt * 64), (unsigned*)(As + i * 4096), 16, 0, 0);
#pragma unroll
    for (int i = 0; i < 4; ++i) __builtin_amdgcn_global_load_lds((const unsigned*)((second ? bp2[i] : bp[i]) + kt * 64), (unsigned*)(Bs + i * 4096), 16, 0, 0);
  };
  issue(0);
  for (int kt = 0; kt < 8; ++kt) {
    asm volatile("s_waitcnt vmcnt(0)" ::: "memory");
    __syncthreads();
    if (kt + 1 < 8) issue(kt + 1);
    const char* As = lds + (kt & 1) * STAGE; const char* Bs = As + 16384;
    mma_stage<4>(As, Bs, acc, wr, wc, fr, fq);
  }
  __syncthreads();
}

template <int NT>
DEVI void acc_to_lds_scaled(const f32x4 (&acc)[4][NT], float* Cs, const float* rsA) {
  constexpr int LDC = NT * 32 + 4;
  const int lane = get_tid() & 63, wid = get_tid() >> 6, wr = wid >> 1, wc = wid & 1, fr = lane & 15, fq = lane >> 4;
#pragma unroll
  for (int m = 0; m < 4; ++m) {
    const f32x4 r4 = *(const f32x4*)(rsA + wr * 64 + m * 16 + fq * 4);
#pragma unroll
    for (int n = 0; n < NT; ++n)
#pragma unroll
      for (int j = 0; j < 4; ++j) Cs[(wr * 64 + m * 16 + fq * 4 + j) * LDC + wc * (NT * 16) + n * 16 + fr] = acc[m][n][j] * r4[j];
  }
  __syncthreads();
}

template <int NT>
DEVI void acc_to_lds(const f32x4 (&acc)[4][NT], float* Cs) {
  constexpr int LDC = NT * 32 + 4;
  const int lane = get_tid() & 63, wid = get_tid() >> 6, wr = wid >> 1, wc = wid & 1, fr = lane & 15, fq = lane >> 4;
#pragma unroll
  for (int m = 0; m < 4; ++m)
#pragma unroll
    for (int n = 0; n < NT; ++n)
#pragma unroll
      for (int j = 0; j < 4; ++j) Cs[(wr * 64 + m * 16 + fq * 4 + j) * LDC + wc * (NT * 16) + n * 16 + fr] = acc[m][n][j];
  __syncthreads();
}

DEVI void conv_weight_tile(const AS4 ConvJob& jb, int local, char* lds) {
  float* tile = (float*)lds;
  const int tid = get_tid();
  const int nkt = jb.K >> 6, nnt = jb.Npad >> 6;
  const int per = nkt * nnt;
  const int bi = local / per; const int rem = local - bi * per;
  const int ktile = rem / nnt, ntile = rem - ktile * nnt;
  const int k0 = ktile * 64, n0 = ntile * 64;
  const float* src = jb.src + (size_t)bi * jb.sstride;
  bf16_t* dst = jb.dst + (size_t)bi * jb.dstride;
  {
    const int c4 = (tid & 15) * 4; const int r0 = tid >> 4;
#pragma unroll
    for (int i = 0; i < 4; ++i) {
      const int k = r0 + 16 * i; const int n = n0 + c4;
      float4 v = make_float4(0.f, 0.f, 0.f, 0.f);
      if (n < jb.N) v = *(const float4*)(src + (size_t)(k0 + k) * jb.N + n);
      if (jb.gain) { const float g = jb.gain[k0 + k]; v.x *= g; v.y *= g; v.z *= g; v.w *= g; }
      tile[k * 65 + c4 + 0] = v.x; tile[k * 65 + c4 + 1] = v.y; tile[k * 65 + c4 + 2] = v.z; tile[k * 65 + c4 + 3] = v.w;
    }
  }
  __syncthreads();
  {
    const int n = tid >> 2, kseg = (tid & 3) * 16;
    unsigned w[8];
#pragma unroll
    for (int i = 0; i < 8; ++i) w[i] = pack2(tile[(kseg + 2 * i) * 65 + n], tile[(kseg + 2 * i + 1) * 65 + n]);
    const int ng = n0 + n;
    int row = ng;
    if (jb.mode == 1) row = (ng >> 6) * 128 + (ng & 63);
    else if (jb.mode == 2) row = (ng >> 6) * 128 + 64 + (ng & 63);
    bf16_t* d = dst + (size_t)row * jb.K + k0 + kseg;
    *(u32x4*)(d) = (u32x4){w[0], w[1], w[2], w[3]};
    *(u32x4*)(d + 8) = (u32x4){w[4], w[5], w[6], w[7]};
  }
  __syncthreads();
}

DEVI void conv_weights_phase(PR p, int jbegin, int jend, int ntiles, char* lds) {
  for (int t = blockIdx.x; t < ntiles; t += gridDim.x) {
    int j = jbegin;
    while (j + 1 < jend && p.jobs[j + 1].tile_start <= t) ++j;
    conv_weight_tile(p.jobs[j], t - p.jobs[j].tile_start, lds);
  }
}

DEVI float4 ld4(const float* q) { return *(const float4*)q; }
DEVI float4 ld4(const bf16_t* q) { const u32x2 w = *(const u32x2*)q; return make_float4(bflo(w.x), bfhi(w.x), bflo(w.y), bfhi(w.y)); }
DEVI void st4(float* q, float4 v) { *(float4*)q = v; }
DEVI void st4(bf16_t* q, float4 v) { u32x2 w; w.x = pack2(v.x, v.y); w.y = pack2(v.z, v.w); *(u32x2*)q = w; }

template <class SrcT, class DstT>
DEVI void rownorm_phase(const SrcT* __restrict__ src, const bf16_t* __restrict__ y, const float* __restrict__ gain,
                        DstT* dstx, bf16_t* dsth) {
  const int lane = get_tid() & 63;
  const int wave = blockIdx.x * 4 + (get_tid() >> 6), nw = gridDim.x * 4;
  for (int row = wave; row < T_; row += nw) {
    float4 v[4];
#pragma unroll
    for (int i = 0; i < 4; ++i) v[i] = ld4(src + (size_t)row * 1024 + i * 256 + lane * 4);
    if (y) {
#pragma unroll
      for (int s = 0; s < 2; ++s)
#pragma unroll
        for (int i = 0; i < 4; ++i) {
          u32x2 w = *(const u32x2*)(y + (size_t)(row * 2 + s) * 1024 + i * 256 + lane * 4);
          v[i].x += bflo(w.x); v[i].y += bfhi(w.x); v[i].z += bflo(w.y); v[i].w += bfhi(w.y);
        }
    }
    if (dstx) {
#pragma unroll
      for (int i = 0; i < 4; ++i) st4(dstx + (size_t)row * 1024 + i * 256 + lane * 4, v[i]);
    }
    if (dsth) {
      float ss = 0.f;
#pragma unroll
      for (int i = 0; i < 4; ++i) ss += v[i].x * v[i].x + v[i].y * v[i].y + v[i].z * v[i].z + v[i].w * v[i].w;
      ss = wave_sum(ss);
      const float r = 1.0f / sqrtf(ss * (1.0f / 1024.0f) + 1e-6f);
#pragma unroll
      for (int i = 0; i < 4; ++i) {
        const float4 g = *(const float4*)(gain + i * 256 + lane * 4);
        u32x2 w; w.x = pack2(v[i].x * r * g.x, v[i].y * r * g.y); w.y = pack2(v[i].z * r * g.z, v[i].w * r * g.w);
        *(u32x2*)(dsth + (size_t)row * 1024 + i * 256 + lane * 4) = w;
      }
    }
  }
}

DEVI void xcopy_phase(PR p) {
  const int lane = get_tid() & 63;
  const int wave = blockIdx.x * 4 + (get_tid() >> 6), nw = gridDim.x * 4;
  for (int row = wave; row < T_; row += nw) {
    float4 v[4];
#pragma unroll
    for (int i = 0; i < 4; ++i) v[i] = *(const float4*)(p.x + (size_t)row * 1024 + i * 256 + lane * 4);
    float ss = 0.f;
#pragma unroll
    for (int i = 0; i < 4; ++i) {
      ss += v[i].x * v[i].x + v[i].y * v[i].y + v[i].z * v[i].z + v[i].w * v[i].w;
      st4(p.xb + (size_t)row * 1024 + i * 256 + lane * 4, v[i]);
    }
    ss = wave_sum(ss);
    if (lane == 0) p.rs0[row] = 1.0f / sqrtf(ss * (1.0f / 1024.0f) + 1e-6f);
  }
}

DEVI void gemm_bf16out_phase(const bf16_t* A, int lda, const bf16_t* Bt, int K, int ncolt, bf16_t* out, int ldo, int nvalid, const float* rs, char* lds) {
  float* Cs = (float*)lds;
  float* rsA = (float*)(lds + 72704);
  XcdIter xi; xi.init();
  const int gsz = (ncolt > 8) ? 6 : ncolt, ngrp = ncolt / gsz;
  for (int n = xi.lb; n < 32 * ncolt; n += xi.nlb) {
    const int grp = n / (32 * gsz), rem = n - grp * (32 * gsz);
    const int rl = rem / gsz, jn = grp * gsz + (rem - rl * gsz);
    const int rt = xi.xcd * 32 + rl;
    f32x4 acc[4][4];
    const bf16_t* Ab = A + (size_t)rt * 128 * lda;
    if (get_tid() < 128) rsA[get_tid()] = rs[rt * 128 + get_tid()];
    gemm_mainloop<4>(acc, [&](int r) { return Ab + (size_t)r * lda; }, Bt + (size_t)jn * 128 * K, K, K, lds);
    acc_to_lds_scaled<4>(acc, Cs, rsA);
    const int c4 = get_tid() & 31, r0 = get_tid() >> 5;
    const int col = jn * 128 + c4 * 4;
    if (col < nvalid) {
#pragma unroll
      for (int i = 0; i < 16; ++i) {
        const int row = r0 + 8 * i;
        const f32x4 v = *(const f32x4*)(Cs + row * 132 + c4 * 4);
        u32x2 w; w.x = pack2(v[0], v[1]); w.y = pack2(v[2], v[3]);
        *(u32x2*)(out + (size_t)(rt * 128 + row) * ldo + col) = w;
      }
    }
    __syncthreads();
  }
}

template <class BaseT>
DEVI void gemm_resid_phase(const bf16_t* A, const bf16_t* Bt, const BaseT* base, bf16_t* xr, char* lds) {
  float* Cs = (float*)lds;
  XcdIter xi; xi.init();
  for (int n = xi.lb; n < 32 * 8; n += xi.nlb) {
    const int rt = xi.xcd * 32 + (n >> 3), jn = n & 7;
    f32x4 acc[4][4];
    const bf16_t* Ab = A + (size_t)rt * 128 * 1024;
    gemm_mainloop<4>(acc, [&](int r) { return Ab + (size_t)r * 1024; }, Bt + (size_t)jn * 128 * 1024, 1024, 1024, lds);
    const int c4 = get_tid() & 31, r0 = get_tid() >> 5;
    const int col = jn * 128 + c4 * 4;
    float4 bres[16];
#pragma unroll
    for (int i = 0; i < 16; ++i) bres[i] = ld4(base + (size_t)(rt * 128 + r0 + 8 * i) * 1024 + col);
    acc_to_lds<4>(acc, Cs);
#pragma unroll
    for (int i = 0; i < 16; ++i) {
      const int row = r0 + 8 * i;
      const f32x4 v = *(const f32x4*)(Cs + row * 132 + c4 * 4);
      const size_t o = (size_t)(rt * 128 + row) * 1024 + col;
      const float4 b = bres[i];
      st4(xr + o, make_float4(b.x + v[0], b.y + v[1], b.z + v[2], b.w + v[3]));
    }
    __syncthreads();
  }
}

template <int KW>
DEVI void row_rms_scale(const bf16_t* Ab, int lda, float* rsA) {
  const int row = get_tid() >> 1, half = get_tid() & 1;
  const bf16_t* q = Ab + (size_t)row * lda + half * (KW / 2);
  float ss = 0.f;
#pragma unroll
  for (int i = 0; i < KW / 16; ++i) {
    const u32x4 w = *(const u32x4*)(q + i * 8);
#pragma unroll
    for (int e = 0; e < 4; ++e) { const float a = bflo(w[e]), b = bfhi(w[e]); ss += a * a + b * b; }
  }
  ss += __shfl_xor(ss, 1);
  if (half == 0) rsA[row] = 1.0f / sqrtf(ss * (1.0f / KW) + 1e-6f);
}

DEVI void qup_tile(PR p, int rt, int h, char* lds) {
  float* Cs = (float*)lds;
  float* rsA = (float*)(lds + 72704);
  const bf16_t* Ab = p.proj0 + (size_t)rt * 128 * 1440;
  row_rms_scale<256>(Ab, 1440, rsA);
  f32x4 acc[4][3];
  gemm_mainloop<3>(acc, [&](int r) { return Ab + (size_t)r * 1440; }, p.Wuqt + (size_t)h * 96 * 256, 256, 256, lds);
  acc_to_lds<3>(acc, Cs);
  const int row = get_tid() >> 1, half = get_tid() & 1;
  const int t = rt * 128 + row, b = t >> 11, s = t & 2047;
  const float rq = rsA[row];
  float v[48];
#pragma unroll
  for (int i = 0; i < 12; ++i) {
    const f32x4 c = *(const f32x4*)(Cs + row * 100 + half * 48 + i * 4);
    v[4 * i] = c[0] * rq; v[4 * i + 1] = c[1] * rq; v[4 * i + 2] = c[2] * rq; v[4 * i + 3] = c[3] * rq;
  }
  float ss = 0.f;
#pragma unroll
  for (int i = 0; i < 48; ++i) ss += v[i] * v[i];
  ss += __shfl_xor(ss, 1);
  const float rn = 1.0f / sqrtf(ss * (1.0f / 96.0f) + 1e-6f);
  const float osc = 0.10206207261596575f * LOG2E;
#pragma unroll
  for (int i = 0; i < 48; ++i) v[i] = v[i] * rn * p.mla_q_norm[half * 48 + i];
  if (half == 1) {
    const float fpos = (float)p.pos[t];
#pragma unroll
    for (int i = 0; i < 16; ++i) {
      float sn, cs; sincos_rev(fpos * p.inv_freq[i], sn, cs);
      const float x1 = v[16 + i], x2 = v[32 + i];
      v[16 + i] = x1 * cs - x2 * sn; v[32 + i] = x1 * sn + x2 * cs;
    }
  }
  bf16_t* dst = p.Q0 + ((size_t)(b * 8 + h) * 2048 + s) * 96 + half * 48;
#pragma unroll
  for (int i = 0; i < 6; ++i) {
    u32x4 w;
    w[0] = pack2(v[8 * i] * osc, v[8 * i + 1] * osc); w[1] = pack2(v[8 * i + 2] * osc, v[8 * i + 3] * osc);
    w[2] = pack2(v[8 * i + 4] * osc, v[8 * i + 5] * osc); w[3] = pack2(v[8 * i + 6] * osc, v[8 * i + 7] * osc);
    *(u32x4*)(dst + i * 8) = w;
  }
  __syncthreads();
}

DEVI void kvup_tile(PR p, int rt, int h, char* lds) {
  float* Cs = (float*)lds;
  float* rsA = (float*)(lds + 72704);
  const bf16_t* Ab = p.proj0 + (size_t)rt * 128 * 1440 + 256;
  row_rms_scale<128>(Ab, 1440, rsA);
  f32x4 acc[4][4];
  gemm_mainloop<4>(acc, [&](int r) { return Ab + (size_t)r * 1440; }, p.Wukvt + (size_t)h * 128 * 128, 128, 128, lds);
  acc_to_lds<4>(acc, Cs);
  const int row = get_tid() >> 1, half = get_tid() & 1;
  const int t = rt * 128 + row, b = t >> 11, s = t & 2047;
  const float rkv = rsA[row];
  if (half == 0) {
    float kr[32];
    const bf16_t* rp = p.proj0 + (size_t)t * 1440 + 384;
#pragma unroll
    for (int i = 0; i < 4; ++i) {
      const u32x4 w = *(const u32x4*)(rp + i * 8);
#pragma unroll
      for (int e = 0; e < 4; ++e) { kr[8 * i + 2 * e] = bflo(w[e]); kr[8 * i + 2 * e + 1] = bfhi(w[e]); }
    }
    float ss = 0.f;
#pragma unroll
    for (int i = 0; i < 32; ++i) ss += kr[i] * kr[i];
#pragma unroll
    for (int i = 0; i < 16; ++i) {
      const f32x4 c = *(const f32x4*)(Cs + row * 132 + i * 4);
#pragma unroll
      for (int e = 0; e < 4; ++e) { const float a = c[e] * rkv; ss += a * a; }
    }
    const float rn = 1.0f / sqrtf(ss * (1.0f / 96.0f) + 1e-6f);
    bf16_t* dst = p.K0 + ((size_t)(b * 8 + h) * 2048 + s) * 96;
#pragma unroll
    for (int i = 0; i < 8; ++i) {
      const f32x4 c0 = *(const f32x4*)(Cs + row * 132 + i * 8);
      const f32x4 c1 = *(const f32x4*)(Cs + row * 132 + i * 8 + 4);
      const float4 g0 = *(const float4*)(p.mla_k_norm + i * 8);
      const float4 g1 = *(const float4*)(p.mla_k_norm + i * 8 + 4);
      const float f = rkv * rn;
      u32x4 w;
      w[0] = pack2(c0[0] * f * g0.x, c0[1] * f * g0.y); w[1] = pack2(c0[2] * f * g0.z, c0[3] * f * g0.w);
      w[2] = pack2(c1[0] * f * g1.x, c1[1] * f * g1.y); w[3] = pack2(c1[2] * f * g1.z, c1[3] * f * g1.w);
      *(u32x4*)(dst + i * 8) = w;
    }
#pragma unroll
    for (int i = 0; i < 32; ++i) kr[i] = kr[i] * rn * p.mla_k_norm[64 + i];
    const float fpos = (float)p.pos[t];
#pragma unroll
    for (int i = 0; i < 16; ++i) {
      float sn, cs; sincos_rev(fpos * p.inv_freq[i], sn, cs);
      const float x1 = kr[i], x2 = kr[16 + i];
      kr[i] = x1 * cs - x2 * sn; kr[16 + i] = x1 * sn + x2 * cs;
    }
#pragma unroll
    for (int i = 0; i < 4; ++i) {
      u32x4 w;
      w[0] = pack2(kr[8 * i], kr[8 * i + 1]); w[1] = pack2(kr[8 * i + 2], kr[8 * i + 3]);
      w[2] = pack2(kr[8 * i + 4], kr[8 * i + 5]); w[3] = pack2(kr[8 * i + 6], kr[8 * i + 7]);
      *(u32x4*)(dst + 64 + i * 8) = w;
    }
  } else {
    bf16_t* dst = p.V0t + ((size_t)(b * 8 + h) * 64) * 2048 + s;
#pragma unroll
    for (int i = 0; i < 16; ++i) {
      const f32x4 c = *(const f32x4*)(Cs + row * 132 + 64 + i * 4);
#pragma unroll
      for (int e = 0; e < 4; ++e) dst[(size_t)(i * 4 + e) * 2048] = f2bf(c[e] * rkv);
    }
  }
  __syncthreads();
}

DEVI void conv_tile(PR p, int tile, char* lds) {
  const int tid = get_tid(), lane = tid & 63, wid = tid >> 6;
  const int b = tile >> 6, t0 = (tile & 63) * 32;
  unsigned* glu = (unsigned*)lds;
#pragma unroll 1
  for (int i0 = 0; i0 < 62; i0 += 16) {
    unsigned av[16], gv[16];
#pragma unroll
    for (int k = 0; k < 16; ++k) {
      const int i = i0 + k; const int tt = max(t0 - 30 + i, 0);
      const bf16_t* rp = p.proj0 + (size_t)(b * 2048 + tt) * 1440;
      av[k] = (i < 62) ? *(const unsigned*)(rp + 416 + 2 * tid) : 0u;
      gv[k] = (i < 62) ? *(const unsigned*)(rp + 928 + 2 * tid) : 0u;
    }
#pragma unroll
    for (int k = 0; k < 16; ++k) {
      const int i = i0 + k;
      const unsigned a = av[k], g = gv[k];
      const unsigned w = (t0 - 30 + i >= 0) ? pack2(bflo(a) * sigmoidf_(bflo(g)), bfhi(a) * sigmoidf_(bfhi(g))) : 0u;
      if (i < 62) glu[i * 256 + tid] = w;
    }
  }
  __syncthreads();
  float y0[32], y1[32];
  {
    const float2 bb = *(const float2*)(p.conv_dw_b + 2 * tid);
#pragma unroll
    for (int t = 0; t < 32; ++t) { y0[t] = bb.x; y1[t] = bb.y; }
  }
  {
    float2 w[31];
#pragma unroll
    for (int j = 0; j < 31; ++j) w[j] = *(const float2*)(p.conv_dw_w + j * 512 + 2 * tid);
#pragma unroll
    for (int i = 0; i < 62; ++i) {
      const unsigned g2 = glu[i * 256 + tid];
      const float lo = bflo(g2), hi = bfhi(g2);
#pragma unroll
      for (int t = (i > 30 ? i - 30 : 0); t <= (i < 31 ? i : 31); ++t) { y0[t] += w[i - t].x * lo; y1[t] += w[i - t].y * hi; }
    }
  }
  __syncthreads();
  float* ys = (float*)lds;
#pragma unroll
  for (int t = 0; t < 32; ++t) *(float2*)(ys + t * 516 + 2 * tid) = make_float2(y0[t], y1[t]);
  __syncthreads();
  for (int k = 0; k < 8; ++k) {
    const int tl = wid * 8 + k;
    const f32x4 a0 = *(const f32x4*)(ys + tl * 516 + lane * 8);
    const f32x4 a1 = *(const f32x4*)(ys + tl * 516 + lane * 8 + 4);
    float v[8] = {a0[0], a0[1], a0[2], a0[3], a1[0], a1[1], a1[2], a1[3]};
    float sm = 0.f;
#pragma unroll
    for (int e = 0; e < 8; ++e) sm += v[e];
    const float mu = wave_sum(sm) * (1.0f / 512.0f);
    float sq = 0.f;
#pragma unroll
    for (int e = 0; e < 8; ++e) { v[e] -= mu; sq += v[e] * v[e]; }
    const float rstd = 1.0f / sqrtf(wave_sum(sq) * (1.0f / 512.0f) + 1e-5f);
    const float4 g0 = *(const float4*)(p.conv_ln_g + lane * 8), g1 = *(const float4*)(p.conv_ln_g + lane * 8 + 4);
    const float4 b0 = *(const float4*)(p.conv_ln_b + lane * 8), b1 = *(const float4*)(p.conv_ln_b + lane * 8 + 4);
    const float gg[8] = {g0.x, g0.y, g0.z, g0.w, g1.x, g1.y, g1.z, g1.w};
    const float bb[8] = {b0.x, b0.y, b0.z, b0.w, b1.x, b1.y, b1.z, b1.w};
    float o[8];
#pragma unroll
    for (int e = 0; e < 8; ++e) { const float z = v[e] * rstd * gg[e] + bb[e]; o[e] = z * sigmoidf_(z); }
    u32x4 w; w[0] = pack2(o[0], o[1]); w[1] = pack2(o[2], o[3]); w[2] = pack2(o[4], o[5]); w[3] = pack2(o[6], o[7]);
    *(u32x4*)(p.hn + (size_t)(b * 2048 + t0 + tl) * 1024 + 512 + lane * 8) = w;
  }
  __syncthreads();
}

DEVI void l0_phase2(PR p, char* lds) {
  XcdIter xi; xi.init();
  for (int n = xi.lb; n < 640; n += xi.nlb) {
    if (n < 256) qup_tile(p, xi.xcd * 32 + (n >> 3), n & 7, lds);
    else if (n < 512) kvup_tile(p, xi.xcd * 32 + ((n - 256) >> 3), (n - 256) & 7, lds);
    else conv_tile(p, xi.xcd * 128 + (n - 512), lds);
  }
}

template <int NKS, int KSTR>
DEVI void qk_tile(const char* Ks, const bf16x8 (&qf)[2][NKS], f32x4 (&s)[4][2], int fr, int fq) {
#pragma unroll
  for (int kt = 0; kt < 4; ++kt) {
    s[kt][0] = (f32x4){0.f, 0.f, 0.f, 0.f}; s[kt][1] = (f32x4){0.f, 0.f, 0.f, 0.f};
#pragma unroll
    for (int ks = 0; ks < NKS; ++ks) {
      const bf16x8 a = *(const bf16x8*)(Ks + (kt * 16 + fr) * KSTR + ks * 64 + fq * 16);
      s[kt][0] = __builtin_amdgcn_mfma_f32_16x16x32_bf16(a, qf[0][ks], s[kt][0], 0, 0, 0);
      s[kt][1] = __builtin_amdgcn_mfma_f32_16x16x32_bf16(a, qf[1][ks], s[kt][1], 0, 0, 0);
    }
  }
}
template <int VSTR>
DEVI void pv_tile(const char* Vs, const f32x4 (&pr)[4][2], f32x4 (&o)[4][2], int fr, int fq) {
#pragma unroll
  for (int u = 0; u < 2; ++u) {
    bf16x8 bfr[2];
#pragma unroll
    for (int qt = 0; qt < 2; ++qt) {
      u32x4 w;
      w[0] = pack2(pr[2 * u][qt][0], pr[2 * u][qt][1]); w[1] = pack2(pr[2 * u][qt][2], pr[2 * u][qt][3]);
      w[2] = pack2(pr[2 * u + 1][qt][0], pr[2 * u + 1][qt][1]); w[3] = pack2(pr[2 * u + 1][qt][2], pr[2 * u + 1][qt][3]);
      bfr[qt] = __builtin_bit_cast(bf16x8, w);
    }
#pragma unroll
    for (int dt = 0; dt < 4; ++dt) {
      const char* vp = Vs + (dt * 16 + fr) * VSTR + (32 * u + 4 * fq) * 2;
      const u32x2 lo = *(const u32x2*)(vp);
      const u32x2 hi = *(const u32x2*)(vp + 32);
      const u32x4 aw = (u32x4){lo[0], lo[1], hi[0], hi[1]};
      const bf16x8 a = __builtin_bit_cast(bf16x8, aw);
      o[dt][0] = __builtin_amdgcn_mfma_f32_16x16x32_bf16(a, bfr[0], o[dt][0], 0, 0, 0);
      o[dt][1] = __builtin_amdgcn_mfma_f32_16x16x32_bf16(a, bfr[1], o[dt][1], 0, 0, 0);
    }
  }
}
DEVI void softmax_update(f32x4 (&s)[4][2], float (&m)[2], float (&l)[2], f32x4 (&o)[4][2]) {
#pragma unroll
  for (int qt = 0; qt < 2; ++qt) {
    float mx = NEGBIG;
#pragma unroll
    for (int kt = 0; kt < 4; ++kt)
#pragma unroll
      for (int j = 0; j < 4; ++j) mx = fmaxf(mx, s[kt][qt][j]);
    mx = fmaxf(mx, __shfl_xor(mx, 16)); mx = fmaxf(mx, __shfl_xor(mx, 32));
    const float mn = fmaxf(m[qt], mx);
    const float alpha = fast_exp2(m[qt] - mn);
    m[qt] = mn;
    const float mnc = fmaxf(mn, -1e29f);
    float rsum = 0.f;
#pragma unroll
    for (int kt = 0; kt < 4; ++kt)
#pragma unroll
      for (int j = 0; j < 4; ++j) {
        const float pv = fast_exp2(s[kt][qt][j] - mnc);
        s[kt][qt][j] = pv; rsum += pv;
      }
    l[qt] = l[qt] * alpha + rsum;
#pragma unroll
    for (int dt = 0; dt < 4; ++dt) { o[dt][qt][0] *= alpha; o[dt][qt][1] *= alpha; o[dt][qt][2] *= alpha; o[dt][qt][3] *= alpha; }
  }
}

DEVI void exp_accum(f32x4 (&s)[4][2], float (&l)[2]) {
#pragma unroll
  for (int qt = 0; qt < 2; ++qt) {
    float rsum = 0.f;
#pragma unroll
    for (int kt = 0; kt < 4; ++kt)
#pragma unroll
      for (int j = 0; j < 4; ++j) { const float pv = fast_exp2(s[kt][qt][j]); s[kt][qt][j] = pv; rsum += pv; }
    l[qt] += rsum;
  }
}

DEVI unsigned bf_hi_bits(float v) { return pack2(v, 0.f) & 0xffffu; }
DEVI float bf_round(float v) { return __uint_as_float(bf_hi_bits(v) << 16); }
template <int NKS, int KSTR>
DEVI void qk_tile_aug(const char* Ks, const char* Kaug, const bf16x8 (&qf)[2][NKS], const bf16x8 (&qa)[2], f32x4 (&s)[4][2], int fr, int fq) {
#pragma unroll
  for (int kt = 0; kt < 4; ++kt) {
    s[kt][0] = (f32x4){0.f, 0.f, 0.f, 0.f}; s[kt][1] = (f32x4){0.f, 0.f, 0.f, 0.f};
#pragma unroll
    for (int ks = 0; ks < NKS; ++ks) {
      const bf16x8 a = *(const bf16x8*)(Ks + (kt * 16 + fr) * KSTR + ks * 64 + fq * 16);
      s[kt][0] = __builtin_amdgcn_mfma_f32_16x16x32_bf16(a, qf[0][ks], s[kt][0], 0, 0, 0);
      s[kt][1] = __builtin_amdgcn_mfma_f32_16x16x32_bf16(a, qf[1][ks], s[kt][1], 0, 0, 0);
    }
    u32x4 aw = *(const u32x4*)(Kaug + (kt * 16 + fr) * 16);
    if (fq != 0) aw = (u32x4){0u, 0u, 0u, 0u};
    const bf16x8 a = __builtin_bit_cast(bf16x8, aw);
    s[kt][0] = __builtin_amdgcn_mfma_f32_16x16x32_bf16(a, qa[0], s[kt][0], 0, 0, 0);
    s[kt][1] = __builtin_amdgcn_mfma_f32_16x16x32_bf16(a, qa[1], s[kt][1], 0, 0, 0);
  }
}
DEVI bf16x8 make_qaug(float slope2, float colc, int fq) {
  const float sh = bf_round(slope2), sl = slope2 - sh;
  const float c1 = bf_round(colc), r1 = colc - c1, c2 = bf_round(r1), c3 = r1 - c2;
  u32x4 w;
  w[0] = pack2(sh, sh); w[1] = pack2(sl, sl); w[2] = pack2(c1, c2); w[3] = pack2(c3, 0.f);
  if (fq != 0) w = (u32x4){0u, 0u, 0u, 0u};
  return __builtin_bit_cast(bf16x8, w);
}
DEVI u32x4 make_kaug(float v) {
  const float ph = bf_round(v), pl = v - ph;
  u32x4 w; w[0] = pack2(ph, pl); w[1] = pack2(ph, pl); w[2] = 0x3f803f80u; w[3] = 0x00003f80u;
  return w;
}
DEVI void exp_tile(f32x4 (&s)[4][2]) {
#pragma unroll
  for (int kt = 0; kt < 4; ++kt)
#pragma unroll
    for (int qt = 0; qt < 2; ++qt)
#pragma unroll
      for (int j = 0; j < 4; ++j) s[kt][qt][j] = fast_exp2(s[kt][qt][j]);
}
template <int VSTR>
DEVI void pv_tile_l(const char* Vs, const f32x4 (&pr)[4][2], f32x4 (&o)[4][2], f32x4 (&ol)[2], int fr, int fq) {
  const u32x4 onesw = (u32x4){0x3f803f80u, 0x3f803f80u, 0x3f803f80u, 0x3f803f80u};
  const bf16x8 ones = __builtin_bit_cast(bf16x8, onesw);
#pragma unroll
  for (int u = 0; u < 2; ++u) {
    bf16x8 bfr[2];
#pragma unroll
    for (int qt = 0; qt < 2; ++qt) {
      u32x4 w;
      w[0] = pack2(pr[2 * u][qt][0], pr[2 * u][qt][1]); w[1] = pack2(pr[2 * u][qt][2], pr[2 * u][qt][3]);
      w[2] = pack2(pr[2 * u + 1][qt][0], pr[2 * u + 1][qt][1]); w[3] = pack2(pr[2 * u + 1][qt][2], pr[2 * u + 1][qt][3]);
      bfr[qt] = __builtin_bit_cast(bf16x8, w);
    }
#pragma unroll
    for (int dt = 0; dt < 4; ++dt) {
      const char* vp = Vs + (dt * 16 + fr) * VSTR + (32 * u + 4 * fq) * 2;
      const u32x2 lo = *(const u32x2*)(vp);
      const u32x2 hi = *(const u32x2*)(vp + 32);
      const u32x4 aw = (u32x4){lo[0], lo[1], hi[0], hi[1]};
      const bf16x8 a = __builtin_bit_cast(bf16x8, aw);
      o[dt][0] = __builtin_amdgcn_mfma_f32_16x16x32_bf16(a, bfr[0], o[dt][0], 0, 0, 0);
      o[dt][1] = __builtin_amdgcn_mfma_f32_16x16x32_bf16(a, bfr[1], o[dt][1], 0, 0, 0);
    }
    ol[0] = __builtin_amdgcn_mfma_f32_16x16x32_bf16(ones, bfr[0], ol[0], 0, 0, 0);
    ol[1] = __builtin_amdgcn_mfma_f32_16x16x32_bf16(ones, bfr[1], ol[1], 0, 0, 0);
  }
}

DEVI float head8_sum(float v) {
  v += __builtin_bit_cast(float, __builtin_amdgcn_update_dpp(0, __builtin_bit_cast(int, v), 0xB1, 0xF, 0xF, true));
  v += __builtin_bit_cast(float, __builtin_amdgcn_update_dpp(0, __builtin_bit_cast(int, v), 0x4E, 0xF, 0xF, true));
  v += __builtin_bit_cast(float, __builtin_amdgcn_update_dpp(0, __builtin_bit_cast(int, v), 0x141, 0xF, 0xF, true));
  return v;
}

DEVI void rowsum_tile(const f32x4 (&pr)[4][2], f32x4 (&ol)[2]) {
  const u32x4 onesw = (u32x4){0x3f803f80u, 0x3f803f80u, 0x3f803f80u, 0x3f803f80u};
  const bf16x8 ones = __builtin_bit_cast(bf16x8, onesw);
#pragma unroll
  for (int u = 0; u < 2; ++u)
#pragma unroll
    for (int qt = 0; qt < 2; ++qt) {
      u32x4 w;
      w[0] = pack2(pr[2 * u][qt][0], pr[2 * u][qt][1]); w[1] = pack2(pr[2 * u][qt][2], pr[2 * u][qt][3]);
      w[2] = pack2(pr[2 * u + 1][qt][0], pr[2 * u + 1][qt][1]); w[3] = pack2(pr[2 * u + 1][qt][2], pr[2 * u + 1][qt][3]);
      ol[qt] = __builtin_amdgcn_mfma_f32_16x16x32_bf16(ones, __builtin_bit_cast(bf16x8, w), ol[qt], 0, 0, 0);
    }
}

DEVI void mla_attn_phase(PR p, char* lds) {
  constexpr int KSTR = 208, VSTR = 144;
  const int tid = get_tid(), lane = tid & 63, wid = tid >> 6, fr = lane & 15, fq = lane >> 4;
  XcdIter xi; xi.init();
  for (int n = xi.lb; n < 256; n += xi.nlb) {
    __syncthreads();
    const int r = n >> 6, li = n & 63, jq = li & 15;
    const int bh = xi.xcd * 16 + r * 4 + (li >> 4);
    const int j8 = (jq + 8) & 15;
    const int qt128 = (r == 0) ? jq : (r == 1) ? 15 - jq : (r == 2) ? j8 : 15 - j8;
    const int q0 = qt128 * 128 + wid * 32;
    const bf16_t* Qb = p.Q0 + (size_t)bh * 2048 * 96;
    const bf16_t* Kb = p.K0 + (size_t)bh * 2048 * 96;
    const bf16_t* Vb = p.V0t + (size_t)bh * 64 * 2048;
    bf16x8 qf[2][3];
#pragma unroll
    for (int qt = 0; qt < 2; ++qt)
#pragma unroll
      for (int ks = 0; ks < 3; ++ks) qf[qt][ks] = *(const bf16x8*)(Qb + (size_t)(q0 + 16 * qt + fr) * 96 + ks * 32 + fq * 8);
    f32x4 o[4][2]; f32x4 ol[2];
    ol[0] = (f32x4){0.f, 0.f, 0.f, 0.f}; ol[1] = (f32x4){0.f, 0.f, 0.f, 0.f};
#pragma unroll
    for (int dt = 0; dt < 4; ++dt) { o[dt][0] = (f32x4){0.f, 0.f, 0.f, 0.f}; o[dt][1] = (f32x4){0.f, 0.f, 0.f, 0.f}; }
    const int nkt = 2 * (qt128 + 1);
    u32x4 rk[3], rv[2];
    const int kr0 = tid / 12, kc0 = tid - kr0 * 12;
    const int kr1 = (tid + 256) / 12, kc1 = (tid + 256) - kr1 * 12;
    const int kr2 = (tid + 512) / 12, kc2 = (tid + 512) - kr2 * 12;
    const int vr0 = tid >> 3, vc0 = tid & 7;
    auto fetch = [&](int key0) {
      rk[0] = *(const u32x4*)(Kb + (size_t)(key0 + kr0) * 96 + kc0 * 8);
      rk[1] = *(const u32x4*)(Kb + (size_t)(key0 + kr1) * 96 + kc1 * 8);
      rk[2] = *(const u32x4*)(Kb + (size_t)(key0 + kr2) * 96 + kc2 * 8);
      rv[0] = *(const u32x4*)(Vb + (size_t)vr0 * 2048 + key0 + vc0 * 8);
      rv[1] = *(const u32x4*)(Vb + (size_t)(vr0 + 32) * 2048 + key0 + vc0 * 8);
    };
    fetch(0);
    for (int kt64 = 0; kt64 < nkt; ++kt64) {
      const int key0 = kt64 * 64;
      char* Kc = lds + (kt64 & 1) * 22528; char* Vc = Kc + 64 * KSTR;
      *(u32x4*)(Kc + kr0 * KSTR + kc0 * 16) = rk[0];
      *(u32x4*)(Kc + kr1 * KSTR + kc1 * 16) = rk[1];
      *(u32x4*)(Kc + kr2 * KSTR + kc2 * 16) = rk[2];
      *(u32x4*)(Vc + vr0 * VSTR + vc0 * 16) = rv[0];
      *(u32x4*)(Vc + (vr0 + 32) * VSTR + vc0 * 16) = rv[1];
      __syncthreads();
      if (kt64 + 1 < nkt) fetch(key0 + 64);
      if (key0 <= q0 + 31) {
        f32x4 s[4][2];
        qk_tile<3, KSTR>(Kc, qf, s, fr, fq);
        if (key0 + 63 > q0) {
#pragma unroll
          for (int kt = 0; kt < 4; ++kt)
#pragma unroll
            for (int qt = 0; qt < 2; ++qt)
#pragma unroll
              for (int j = 0; j < 4; ++j) {
                const int key = key0 + 16 * kt + 4 * fq + j, qq = q0 + 16 * qt + fr;
                if (key > qq) s[kt][qt][j] = NEGBIG;
              }
        }
        exp_tile(s);
        pv_tile_l<VSTR>(Vc, s, o, ol, fr, fq);
      }
    }
    const int b = bh >> 3, h = bh & 7;
#pragma unroll
    for (int qt = 0; qt < 2; ++qt) {
      const float inv = 1.0f / ol[qt][0];
      bf16_t* dst = p.hn + (size_t)(b * 2048 + q0 + 16 * qt + fr) * 1024 + h * 64 + 4 * fq;
#pragma unroll
      for (int dt = 0; dt < 4; ++dt) {
        u32x2 w; w[0] = pack2(o[dt][qt][0] * inv, o[dt][qt][1] * inv); w[1] = pack2(o[dt][qt][2] * inv, o[dt][qt][3] * inv);
        *(u32x2*)(dst + dt * 16) = w;
      }
    }
  }
  __syncthreads();
}

DEVI void router_phase(PR p, int layer, char* lds) {
  constexpr int WSTR = 528;
  char* Wh = lds;
  char* Wl = lds + 48 * WSTR;
  float* lg = (float*)(lds + 50688);
  float* ssL = (float*)(lds + 50688 + 12288);
  int* cntL = (int*)(lds + 50688 + 12288 + 256);
  int* baseL = cntL + 32;
  int* cntP = baseL + 32;
  int* baseP = cntP + 112;
  int* gcntP = p.gcntP + layer * 128;
  const int tid = get_tid(), lane = tid & 63, wid = tid >> 6, fr = lane & 15, fq = lane >> 4;
  const bf16_t* gWh = p.RWh + (size_t)layer * 48 * 1024;
  const bf16_t* gWl = p.RWl + (size_t)layer * 48 * 1024;
  int* gcnt = p.gcnt + layer * 32;
  for (int tile = blockIdx.x; tile < T_ / 64; tile += gridDim.x) {
    const int row = tile * 64 + wid * 16 + fr;
    const bf16_t* xrow = p.xr + (size_t)row * 1024;
    f32x4 acc[3]; acc[0] = acc[1] = acc[2] = (f32x4){0.f, 0.f, 0.f, 0.f};
    float ss = 0.f;
    if (tid < 32) cntL[tid] = 0;
    if (tid < 112) cntP[tid] = 0;
    for (int kc = 0; kc < 4; ++kc) {
      u32x4 xq[8];
#pragma unroll
      for (int i = 0; i < 8; ++i) xq[i] = *(const u32x4*)(xrow + kc * 256 + (i >> 1) * 64 + fq * 16 + (i & 1) * 8);
      u32x4 wq[12];
#pragma unroll
      for (int i = 0; i < 6; ++i) {
        const int q = tid + 256 * i; const int n = q >> 5, c = q & 31;
        wq[i] = *(const u32x4*)(gWh + (size_t)n * 1024 + kc * 256 + c * 8);
        wq[6 + i] = *(const u32x4*)(gWl + (size_t)n * 1024 + kc * 256 + c * 8);
      }
      __syncthreads();
#pragma unroll
      for (int i = 0; i < 6; ++i) {
        const int q = tid + 256 * i; const int n = q >> 5, c = q & 31;
        *(u32x4*)(Wh + n * WSTR + c * 16) = wq[i];
        *(u32x4*)(Wl + n * WSTR + c * 16) = wq[6 + i];
      }
      __syncthreads();
#pragma unroll
      for (int s4 = 0; s4 < 4; ++s4) {
#pragma unroll
        for (int m = 0; m < 2; ++m) {
          const u32x4 xw = xq[s4 * 2 + m];
#pragma unroll
          for (int i = 0; i < 4; ++i) { const float a = bflo(xw[i]), b = bfhi(xw[i]); ss += a * a + b * b; }
          const bf16x8 ah = __builtin_bit_cast(bf16x8, xw);
          const int koff = (s4 * 64 + fq * 16 + 8 * m) * 2;
#pragma unroll
          for (int nt = 0; nt < 3; ++nt) {
            const bf16x8 bh = *(const bf16x8*)(Wh + (nt * 16 + fr) * WSTR + koff);
            const bf16x8 bl = *(const bf16x8*)(Wl + (nt * 16 + fr) * WSTR + koff);
            acc[nt] = __builtin_amdgcn_mfma_f32_16x16x32_bf16(ah, bh, acc[nt], 0, 0, 0);
            acc[nt] = __builtin_amdgcn_mfma_f32_16x16x32_bf16(ah, bl, acc[nt], 0, 0, 0);
          }
        }
      }
    }
    ss += __shfl_xor(ss, 16); ss += __shfl_xor(ss, 32);
    if (fq == 0) ssL[wid * 16 + fr] = ss;
#pragma unroll
    for (int nt = 0; nt < 3; ++nt)
#pragma unroll
      for (int j = 0; j < 4; ++j) lg[(wid * 16 + 4 * fq + j) * 48 + nt * 16 + fr] = acc[nt][j];
    __syncthreads();
    int e0 = 0, e1 = 0, rk0 = 0, rk1 = 0; float w0 = 0.f, w1 = 0.f;
    int pidx = 0, rkp = 0; bool swapped = false;
    const int tok = tile * 64 + tid;
    if (tid < 64) {
      const float r = 1.0f / sqrtf(ssL[tid] * (1.0f / 1024.0f) + 1e-6f);
      p.rs[tok] = r;
      const float* L = lg + tid * 48;
      float gl[4];
#pragma unroll
      for (int i = 0; i < 4; ++i) gl[i] = L[i] * r + p.r_group_b[layer * 4 + i];
      int grp = 0; float gm = gl[0];
#pragma unroll
      for (int i = 1; i < 4; ++i) if (gl[i] > gm) { gm = gl[i]; grp = i; }
      float gs = 0.f;
#pragma unroll
      for (int i = 0; i < 4; ++i) gs += expf(gl[i] - gm);
      const float gw = 1.0f / gs;
      float el[8];
#pragma unroll
      for (int i = 0; i < 8; ++i) el[i] = L[4 + grp * 8 + i] * r + p.r_expert_b[layer * 32 + grp * 8 + i];
      int i0 = 0; float v0 = el[0];
#pragma unroll
      for (int i = 1; i < 8; ++i) if (el[i] > v0) { v0 = el[i]; i0 = i; }
      int i1 = (i0 == 0) ? 1 : 0; float v1 = -3e38f;
#pragma unroll
      for (int i = 0; i < 8; ++i) if (i != i0 && el[i] > v1) { v1 = el[i]; i1 = i; }
      const float ex = expf(v1 - v0);
      w0 = gw / (1.0f + ex); w1 = gw * ex / (1.0f + ex);
      e0 = grp * 8 + i0; e1 = grp * 8 + i1;
      rk0 = atomicAdd(&cntL[e0], 1);
      rk1 = atomicAdd(&cntL[e1], 1);
      swapped = i0 > i1;
      const int a = swapped ? i1 : i0, b = swapped ? i0 : i1;
      pidx = grp * 28 + a * 7 - ((a * (a - 1)) >> 1) + (b - a - 1);
      rkp = atomicAdd(&cntP[pidx], 1);
    }
    __syncthreads();
    if (tid < 32) { const int c = cntL[tid]; baseL[tid] = c ? atomicAdd(&gcnt[tid], c) : 0; }
    if (tid < 112) { const int c = cntP[tid]; baseP[tid] = c ? atomicAdd(&gcntP[tid], c) : 0; }
    __syncthreads();
    if (tid < 64) {
      const size_t s0 = (size_t)e0 * T_ + baseL[e0] + rk0, s1 = (size_t)e1 * T_ + baseL[e1] + rk1;
      p.row_tok[s0] = tok * 2;
      p.row_tok[s1] = tok * 2 + 1;
      const float rr = p.rs[tok];
      p.row_aux[s0] = make_float2(w0, rr);
      p.row_aux[s1] = make_float2(w1, rr);
      const int ra = baseL[e0] + rk0, rb = baseL[e1] + rk1;
      const size_t sp = (size_t)pidx * T_ + baseP[pidx] + rkp;
      p.pair_tok[sp] = tok;
      p.pair_rk[sp] = swapped ? make_int2(rb, ra) : make_int2(ra, rb);
    }
    __syncthreads();
  }
}

DEVI void moe_prefix(const int* gcnt, int* preL) {
  __syncthreads();
  if (get_tid() == 0) {
    int a = 0;
    for (int e = 0; e < 32; ++e) { preL[e] = a; a += (gcnt[e] + 127) >> 7; }
    preL[32] = a;
  }
  __syncthreads();
}
DEVI int find_expert(const int* preL, int rt) {
  int e = 0;
  for (int i = 1; i < 32; ++i) if (preL[i] <= rt) e = i;
  return e;
}

DEVI void moe_gateup_phase(PR p, int layer, char* lds) {
  int* preL = (int*)(lds + 72704 + 512);
  const int* gcnt = p.gcnt + layer * 32;
  moe_prefix(gcnt, preL);
  const int nrt = preL[32];
  float* Cs = (float*)lds;
  XcdIter xi; xi.init();
  const int rlo = (nrt * xi.xcd) >> 3, rhi = (nrt * (xi.xcd + 1)) >> 3;
  const int total = (rhi - rlo) * 4, G = xi.nlb;
  const int nfull_rounds = total / G, left = total - nfull_rounds * G;
  const bool split = (left > 0) && (2 * left <= G);
  const int nfull = split ? nfull_rounds * G : total;
  const int row = get_tid() >> 1, half = get_tid() & 1;
  for (int it = xi.lb; it < nfull + (split ? 2 * left : 0); it += G) {
    const bool ishalf = it >= nfull;
    const int item = ishalf ? nfull + ((it - nfull) >> 1) : it;
    const int ch = (it - nfull) & 1;
    const int rt = rlo + (item >> 2), j = item & 3;
    const int e = find_expert(preL, rt);
    const int blk = rt - preL[e];
    const int valid = min(128, gcnt[e] - blk * 128);
    const int* rtk = p.row_tok + (size_t)e * T_ + blk * 128;
    float2 aux = make_float2(0.f, 0.f);
    if (row < valid) aux = p.row_aux[(size_t)e * T_ + blk * 128 + row];
    const float rsc = aux.y, rsu = aux.y * aux.x;
    const bf16_t* Wb = p.Wgut + ((size_t)e * 512 + j * 128) * 1024;
    auto arow = [&](int r) { const int tok = (r < valid) ? (rtk[r] >> 1) : 0; return p.xr + (size_t)tok * 1024; };
    if (!ishalf) {
      f32x4 acc[4][4];
      gemm_mainloop<4>(acc, arow, Wb, 1024, 1024, lds);
      acc_to_lds<4>(acc, Cs);
      if (row < valid) {
        bf16_t* dst = p.hbuf + (size_t)(rt * 128 + row) * 256 + j * 64 + half * 32;
#pragma unroll
        for (int i = 0; i < 4; ++i) {
          float hv[8];
#pragma unroll
          for (int q = 0; q < 2; ++q) {
            const f32x4 g = *(const f32x4*)(Cs + row * 132 + half * 32 + i * 8 + q * 4);
            const f32x4 u = *(const f32x4*)(Cs + row * 132 + 64 + half * 32 + i * 8 + q * 4);
#pragma unroll
            for (int c = 0; c < 4; ++c) { const float gg = g[c] * rsc; hv[q * 4 + c] = gg * sigmoidf_(gg) * (u[c] * rsu); }
          }
          u32x4 w; w[0] = pack2(hv[0], hv[1]); w[1] = pack2(hv[2], hv[3]); w[2] = pack2(hv[4], hv[5]); w[3] = pack2(hv[6], hv[7]);
          *(u32x4*)(dst + i * 8) = w;
        }
      }
    } else {
      f32x4 acc[4][2];
      gemm_mainloop2<2>(acc, arow, [&](int r) { return Wb + (size_t)((r < 32) ? (32 * ch + r) : (64 + 32 * ch + (r - 32))) * 1024; }, 1024, lds);
      acc_to_lds<2>(acc, Cs);
      if (row < valid) {
        bf16_t* dst = p.hbuf + (size_t)(rt * 128 + row) * 256 + j * 64 + ch * 32 + half * 16;
#pragma unroll
        for (int i = 0; i < 2; ++i) {
          float hv[8];
#pragma unroll
          for (int q = 0; q < 2; ++q) {
            const f32x4 g = *(const f32x4*)(Cs + row * 68 + half * 16 + i * 8 + q * 4);
            const f32x4 u = *(const f32x4*)(Cs + row * 68 + 32 + half * 16 + i * 8 + q * 4);
#pragma unroll
            for (int c = 0; c < 4; ++c) { const float gg = g[c] * rsc; hv[q * 4 + c] = gg * sigmoidf_(gg) * (u[c] * rsu); }
          }
          u32x4 w; w[0] = pack2(hv[0], hv[1]); w[1] = pack2(hv[2], hv[3]); w[2] = pack2(hv[4], hv[5]); w[3] = pack2(hv[6], hv[7]);
          *(u32x4*)(dst + i * 8) = w;
        }
      }
    }
    __syncthreads();
  }
}

DEVI void moe_down_phase(PR p, int layer, char* lds) {
  int* preE = (int*)(lds + 72704 + 512);
  int* tabT = (int*)(lds + 67584);
  int* preP = (int*)(lds + 68608);
  unsigned char* tileB = (unsigned char*)(lds + 69120);
  int* cntS = (int*)(lds + 69632);
  const int* gcnt = p.gcnt + layer * 32;
  const int* gcntP = p.gcntP + layer * 128;
  const int tid = get_tid();
  moe_prefix(gcnt, preE);
  if (tid < 112) cntS[tid] = gcntP[tid];
  __syncthreads();
  if (tid == 0) {
    int a = 0;
    for (int b = 0; b < 112; ++b) {
      preP[b] = a;
      const int n = (cntS[b] + 127) >> 7;
      for (int i = 0; i < n; ++i) tileB[a + i] = (unsigned char)b;
      a += n;
    }
    preP[112] = a;
  }
  __syncthreads();
  const int nprt = preP[112];
  float* Cs = (float*)lds;
  XcdIter xi; xi.init();
  const int rlo = (nprt * xi.xcd) >> 3, rhi = (nprt * (xi.xcd + 1)) >> 3;
  for (int it = xi.lb; it < (rhi - rlo) * 8; it += xi.nlb) {
    const int prt = rlo + (it >> 3), j = it & 7;
    const int pb = tileB[prt];
    const int blk = prt - preP[pb];
    const int valid = min(128, cntS[pb] - blk * 128);
    const int g = pb / 28; int q = pb - g * 28, a = 0;
    while (q >= 7 - a) { q -= 7 - a; ++a; }
    const int eA = g * 8 + a, eB = eA + 1 + q;
    const size_t lb0 = (size_t)pb * T_ + blk * 128;
    int tok_r = 0;
    if (tid < valid) tok_r = p.pair_tok[lb0 + tid];
    const int baseA = preE[eA] * 128, baseB = preE[eB] * 128;
    f32x4 acc[4][4];
    gemm_mainloop_pair(acc, [&](int r, const bf16_t*& pa, const bf16_t*& pbp) {
      int2 rk = make_int2(0, 0); int ba = 0, bb = 0;
      if (r < valid) { rk = p.pair_rk[lb0 + r]; ba = baseA; bb = baseB; }
      pa = p.hbuf + (size_t)(ba + rk.x) * 256; pbp = p.hbuf + (size_t)(bb + rk.y) * 256;
    }, p.Wdt + ((size_t)eA * 1024 + j * 128) * 256, p.Wdt + ((size_t)eB * 1024 + j * 128) * 256, lds);
    if (tid < 128) tabT[tid] = tok_r;
    acc_to_lds<4>(acc, Cs);
    const int c4 = tid & 31, r0 = tid >> 5;
#pragma unroll
    for (int i = 0; i < 16; ++i) {
      const int row = r0 + 8 * i;
      float sq = 0.f;
      if (row < valid) {
        const size_t o = (size_t)tabT[row] * 1024 + j * 128 + c4 * 4;
        const f32x4 v = *(const f32x4*)(Cs + row * 132 + c4 * 4);
        const float4 b = ld4(p.xr + o);
        const float4 r = make_float4(b.x + v[0], b.y + v[1], b.z + v[2], b.w + v[3]);
        if (layer == 0) {
          u32x2 w; w.x = pack2(r.x, r.y); w.y = pack2(r.z, r.w);
          *(u32x2*)(p.xr + o) = w;
          const float q0 = bflo(w.x), q1 = bfhi(w.x), q2 = bflo(w.y), q3 = bfhi(w.y);
          sq = q0 * q0 + q1 * q1 + q2 * q2 + q3 * q3;
        } else st4(p.out + o, r);
      }
      if (layer == 0) {
        sq += __shfl_xor(sq, 1); sq += __shfl_xor(sq, 2); sq += __shfl_xor(sq, 4); sq += __shfl_xor(sq, 8); sq += __shfl_xor(sq, 16);
        if (c4 == 0 && row < valid) p.ssp[(size_t)tabT[row] * 8 + j] = sq;
      }
    }
    __syncthreads();
  }
}

DEVI void nsa_proj_phase(PR p, char* lds) {
  float* Cs = (float*)lds;
  XcdIter xi; xi.init();
  for (int n = xi.lb; n < 32 * 15; n += xi.nlb) {
    const int grp = n / 160, rem = n - grp * 160;
    const int rl = rem / 5, jn = grp * 5 + (rem - rl * 5);
    const int rt = xi.xcd * 32 + rl;
    f32x4 acc[4][4];
    float* rsA = (float*)(lds + 72704);
    if (get_tid() < 128) {
      const float4* sp = (const float4*)(p.ssp + (size_t)(rt * 128 + get_tid()) * 8);
      const float4 s0 = sp[0], s1 = sp[1];
      const float ss = ((s0.x + s0.y) + (s0.z + s0.w)) + ((s1.x + s1.y) + (s1.z + s1.w));
      rsA[get_tid()] = 1.0f / sqrtf(ss * (1.0f / 1024.0f) + 1e-6f);
    }
    const bf16_t* Ab = p.xr + (size_t)rt * 128 * 1024;
    gemm_mainloop<4>(acc, [&](int r) { return Ab + (size_t)r * 1024; }, p.W5t + (size_t)jn * 128 * 1024, 1024, 1024, lds);
    acc_to_lds_scaled<4>(acc, Cs, rsA);
    const int row = get_tid() >> 1, half = get_tid() & 1;
    const int t = rt * 128 + row, b = t >> 11, s = t & 2047;
    const float* cr = Cs + row * 132 + half * 64;
    if (jn == 14) {
      if (half == 0) {
#pragma unroll
        for (int i = 0; i < 12; ++i) {
          const f32x4 c = *(const f32x4*)(cr + i * 4);
          *(float4*)(p.GATES + (size_t)t * 48 + i * 4) = make_float4(sigmoidf_(c[0]), sigmoidf_(c[1]), sigmoidf_(c[2]), sigmoidf_(c[3]));
        }
      }
    } else if (jn == 11 || jn == 13) {
      bf16_t* dst = (jn == 11 ? p.VSt : p.VWt) + ((size_t)(b * 2 + half) * 64) * 2048 + s;
#pragma unroll
      for (int i = 0; i < 16; ++i) {
        const f32x4 c = *(const f32x4*)(cr + i * 4);
#pragma unroll
        for (int e = 0; e < 4; ++e) dst[(size_t)(i * 4 + e) * 2048] = f2bf(c[e]);
      }
    } else {
      const float* gn = nullptr; bf16_t* dst; float osc = 1.0f;
      if (jn < 8) { gn = p.nsa_q_norm; dst = p.Q1 + ((size_t)(b * 16 + jn * 2 + half) * 2048 + s) * 64; osc = 0.125f * LOG2E; }
      else {
        bf16_t* base = (jn == 8) ? p.KC : (jn == 9) ? p.VC : (jn == 10) ? p.KS : p.KW;
        if (jn == 10) gn = p.nsa_k_norm_slc; else if (jn == 12) gn = p.nsa_k_norm_win;
        dst = base + ((size_t)(b * 2 + half) * 2048 + s) * 64;
      }
      float rn = 1.0f;
      if (gn) {
        float ss = 0.f;
#pragma unroll
        for (int i = 0; i < 16; ++i) { const f32x4 c = *(const f32x4*)(cr + i * 4); ss += c[0] * c[0] + c[1] * c[1] + c[2] * c[2] + c[3] * c[3]; }
        rn = osc / sqrtf(ss * (1.0f / 64.0f) + 1e-6f);
      }
#pragma unroll
      for (int i = 0; i < 8; ++i) {
        const f32x4 c0 = *(const f32x4*)(cr + i * 8), c1 = *(const f32x4*)(cr + i * 8 + 4);
        float4 g0 = make_float4(1.f, 1.f, 1.f, 1.f), g1 = g0;
        if (gn) { g0 = *(const float4*)(gn + i * 8); g1 = *(const float4*)(gn + i * 8 + 4); }
        u32x4 w;
        w[0] = pack2(c0[0] * rn * g0.x, c0[1] * rn * g0.y); w[1] = pack2(c0[2] * rn * g0.z, c0[3] * rn * g0.w);
        w[2] = pack2(c1[0] * rn * g1.x, c1[1] * rn * g1.y); w[3] = pack2(c1[2] * rn * g1.z, c1[3] * rn * g1.w);
        *(u32x4*)(dst + i * 8) = w;
      }
    }
    __syncthreads();
  }
}

DEVI void compress_phase(PR p, char* lds) {
  const int tid = get_tid(), lane = tid & 63, wid = tid >> 6, wr = wid >> 1, wc = wid & 1, fr = lane & 15, fq = lane >> 4;
  for (int it = blockIdx.x; it < 64; it += gridDim.x) {
    const int kv = it >> 5, bg = it & 31;
    const bf16_t* base = (kv ? p.VC : p.KC) + (size_t)bg * 2048 * 64;
    const bf16_t* W1 = kv ? p.Wc1vt : p.Wc1kt;
    const bf16_t* W2 = kv ? p.Wc2vt : p.Wc2kt;
    const float* bias = p.bias1 + kv * 128;
    f32x4 acc[4][4];
    gemm_mainloop<4>(acc, [&](int r) { return base + (size_t)min(r, 126) * 1024; }, W1, 2048, 2048, lds);
#pragma unroll
    for (int m = 0; m < 4; ++m)
#pragma unroll
      for (int n = 0; n < 4; ++n)
#pragma unroll
        for (int j = 0; j < 4; ++j) {
          const int row = wr * 64 + m * 16 + fq * 4 + j, col = wc * 64 + n * 16 + fr;
          const float xv = acc[m][n][j] + bias[col];
          const float u2 = 1.5957691216057308f * (xv + 0.044715f * xv * xv * xv);
          const float hv = xv * sigmoidf_(u2);
          const int c = col & 63;
          *(bf16_t*)(lds + (col >> 6) * 16384 + swz(row, c >> 3) + (c & 7) * 2) = f2bf(hv);
        }
#pragma unroll
    for (int i = 0; i < 4; ++i) {
      const int q = tid + 256 * i; const int r = q >> 4, c16 = q & 15;
      *(u32x4*)(lds + 32768 + (c16 >> 3) * 8192 + swz(r, c16 & 7)) = *(const u32x4*)(W2 + (size_t)r * 128 + c16 * 8);
    }
    __syncthreads();
    f32x4 a2[4][2];
#pragma unroll
    for (int m = 0; m < 4; ++m) { a2[m][0] = (f32x4){0.f, 0.f, 0.f, 0.f}; a2[m][1] = (f32x4){0.f, 0.f, 0.f, 0.f}; }
#pragma unroll
    for (int ktile = 0; ktile < 2; ++ktile) mma_stage<2>(lds + ktile * 16384, lds + 32768 + ktile * 8192, a2, wr, wc, fr, fq);
    __syncthreads();
    float* C2 = (float*)lds;
#pragma unroll
    for (int m = 0; m < 4; ++m)
#pragma unroll
      for (int n = 0; n < 2; ++n)
#pragma unroll
        for (int j = 0; j < 4; ++j) C2[(wr * 64 + m * 16 + fq * 4 + j) * 68 + wc * 32 + n * 16 + fr] = a2[m][n][j];
    __syncthreads();
    const int row = tid >> 1, half = tid & 1;
    float v[32];
#pragma unroll
    for (int i = 0; i < 8; ++i) { const f32x4 c = *(const f32x4*)(C2 + row * 68 + half * 32 + i * 4); v[4 * i] = c[0]; v[4 * i + 1] = c[1]; v[4 * i + 2] = c[2]; v[4 * i + 3] = c[3]; }
    if (kv == 0) {
      float ss = 0.f;
#pragma unroll
      for (int i = 0; i < 32; ++i) ss += v[i] * v[i];
      ss += __shfl_xor(ss, 1);
      const float rn = (row < 127) ? 1.0f / sqrtf(ss * (1.0f / 64.0f) + 1e-6f) : 0.f;
      bf16_t* dst = p.KCMP + ((size_t)bg * 128 + row) * 64 + half * 32;
#pragma unroll
      for (int i = 0; i < 4; ++i) {
        u32x4 w;
#pragma unroll
        for (int e = 0; e < 4; ++e) { const int c = 8 * i + 2 * e; w[e] = pack2(v[c] * rn * p.nsa_k_norm_cmp[half * 32 + c], v[c + 1] * rn * p.nsa_k_norm_cmp[half * 32 + c + 1]); }
        *(u32x4*)(dst + i * 8) = w;
      }
    } else {
      const float z = (row < 127) ? 1.0f : 0.f;
      bf16_t* dst = p.VCMPt + ((size_t)bg * 64 + half * 32) * 128 + row;
#pragma unroll
      for (int i = 0; i < 32; ++i) dst[(size_t)i * 128] = f2bf(v[i] * z);
    }
    __syncthreads();
  }
}

DEVI void nsa_stage_tile(char* lds, int st, const bf16_t* Kg  , const bf16_t* Vg  , int vld) {
  const int tid = get_tid();
  char* Ks = lds + st * 18432; char* Vs = Ks + 9216;
#pragma unroll
  for (int i = 0; i < 2; ++i) {
    const int q = tid + 256 * i; const int r = q >> 3, c = q & 7;
    *(u32x4*)(Ks + r * 144 + c * 16) = *(const u32x4*)(Kg + (size_t)r * 64 + c * 8);
    *(u32x4*)(Vs + r * 144 + c * 16) = *(const u32x4*)(Vg + (size_t)r * vld + c * 8);
  }
}

DEVI void out_rmw2(bf16_t* const (&dst)[2], const f32x4 (&o)[4][2], float f0, float f1, bool accumulate) {
  u32x2 w[2][4];
  if (accumulate) {
#pragma unroll
    for (int qt = 0; qt < 2; ++qt)
#pragma unroll
      for (int dt = 0; dt < 4; ++dt) w[qt][dt] = *(const u32x2*)(dst[qt] + dt * 16);
  }
#pragma unroll
  for (int qt = 0; qt < 2; ++qt) {
    const float f = qt ? f1 : f0;
#pragma unroll
    for (int dt = 0; dt < 4; ++dt) {
      float a0 = o[dt][qt][0] * f, a1 = o[dt][qt][1] * f, a2 = o[dt][qt][2] * f, a3 = o[dt][qt][3] * f;
      if (accumulate) { a0 += bflo(w[qt][dt][0]); a1 += bfhi(w[qt][dt][0]); a2 += bflo(w[qt][dt][1]); a3 += bfhi(w[qt][dt][1]); }
      u32x2 r; r[0] = pack2(a0, a1); r[1] = pack2(a2, a3);
      w[qt][dt] = r;
    }
  }
#pragma unroll
  for (int qt = 0; qt < 2; ++qt)
#pragma unroll
    for (int dt = 0; dt < 4; ++dt) *(u32x2*)(dst[qt] + dt * 16) = w[qt][dt];
}

DEVI void nsa_attn_phase(PR p, char* lds) {
  constexpr int STR = 144, STG = 19456;
  constexpr int OSTR = 136;
  const int tid = get_tid(), lane = tid & 63, wid = tid >> 6, fr = lane & 15, fq = lane >> 4;
  float* Ptok = (float*)(lds + 2 * STG);
  unsigned* maskL = (unsigned*)(lds + 2 * STG + 8192);
  char* Ot = lds + 2 * STG + 8192 + 64;
  float cbound;
  {
    float gq = fabsf(p.nsa_q_norm[lane]);
    float gk = fmaxf(fabsf(p.nsa_k_norm_cmp[lane]), fmaxf(fabsf(p.nsa_k_norm_slc[lane]), fabsf(p.nsa_k_norm_win[lane])));
#pragma unroll
    for (int m = 32; m >= 1; m >>= 1) { gq = fmaxf(gq, __shfl_xor(gq, m)); gk = fmaxf(gk, __shfl_xor(gk, m)); }
    cbound = 8.0f * LOG2E * gq * gk * 1.01f;
  }
  XcdIter xi; xi.init();
  for (int n = xi.lb; n < 512; n += xi.nlb) {
    const int bg = xi.xcd * 4 + (n >> 7), b = bg >> 1, g = bg & 1;
    const int tl128 = n & 127;
    const int t0 = (((n >> 6) & 1) ? (127 - (tl128 & 63)) : (tl128 & 63)) * 16;
    const int head = fr & 7;
    const int hg = g * 8 + head;
    const int pbase = p.pos[b * 2048 + t0];
    int tq[2]; float colc[2]; bf16x8 qf[2][2]; bf16x8 qa[2]; float gate[3][2];
    const float slope2 = exp2f(-0.5f * (float)(hg + 1)) * LOG2E;
#pragma unroll
    for (int qt = 0; qt < 2; ++qt) {
      tq[qt] = t0 + 4 * wid + 2 * qt + (fr >> 3);
      colc[qt] = -slope2 * (float)(p.pos[b * 2048 + tq[qt]] - pbase) - cbound;
      qa[qt] = make_qaug(slope2, colc[qt], fq);
      const bf16_t* qp = p.Q1 + ((size_t)(b * 16 + hg) * 2048 + tq[qt]) * 64;
      qf[qt][0] = *(const bf16x8*)(qp + fq * 8);
      qf[qt][1] = *(const bf16x8*)(qp + 32 + fq * 8);
      const float* gp = p.GATES + (size_t)(b * 2048 + tq[qt]) * 48 + hg;
      gate[0][qt] = gp[0]; gate[1][qt] = gp[16]; gate[2][qt] = gp[32];
    }
    char* orow[2];
#pragma unroll
    for (int qt = 0; qt < 2; ++qt) orow[qt] = Ot + (32 * wid + 16 * qt + fr) * OSTR + 8 * fq;
    auto out_acc = [&](const f32x4 (&o)[4][2], float f0, float f1, bool first) {
#pragma unroll
      for (int qt = 0; qt < 2; ++qt) {
        const float f = qt ? f1 : f0;
#pragma unroll
        for (int dt = 0; dt < 4; ++dt) {
          float a0 = o[dt][qt][0] * f, a1 = o[dt][qt][1] * f, a2 = o[dt][qt][2] * f, a3 = o[dt][qt][3] * f;
          if (!first) {
            const u32x2 w = *(const u32x2*)(orow[qt] + dt * 32);
            a0 += bflo(w[0]); a1 += bfhi(w[0]); a2 += bflo(w[1]); a3 += bfhi(w[1]);
          }
          u32x2 r; r[0] = pack2(a0, a1); r[1] = pack2(a2, a3);
          *(u32x2*)(orow[qt] + dt * 32) = r;
        }
      }
    };

    u32x4 rk[2], rv[2]; int rpos = 0;
    const int sr = tid >> 3, sc = tid & 7;
    auto fetch = [&](const bf16_t* Kg, const bf16_t* Vg, int vstride, const int* posg, int pstride, int pmax) {
      rk[0] = *(const u32x4*)(Kg + (size_t)sr * 64 + sc * 8);
      rk[1] = *(const u32x4*)(Kg + (size_t)(sr + 32) * 64 + sc * 8);
      rv[0] = *(const u32x4*)(Vg + (size_t)sr * vstride + sc * 8);
      rv[1] = *(const u32x4*)(Vg + (size_t)(sr + 32) * vstride + sc * 8);
      if (tid < 64) rpos = posg[min(tid * pstride, pmax)];
    };
    auto commit = [&](int st) {
      char* Ks = lds + st * STG; char* Vs = Ks + 9216;
      *(u32x4*)(Ks + sr * 144 + sc * 16) = rk[0];
      *(u32x4*)(Ks + (sr + 32) * 144 + sc * 16) = rk[1];
      *(u32x4*)(Vs + sr * 144 + sc * 16) = rv[0];
      *(u32x4*)(Vs + (sr + 32) * 144 + sc * 16) = rv[1];
      if (tid < 64) *(u32x4*)(Ks + 18432 + tid * 16) = make_kaug((float)(rpos - pbase));
    };
    auto fetch_win = [&](int key0) { PR q = *get_params(); fetch(q.KW + ((size_t)bg * 2048 + key0) * 64, q.VWt + (size_t)bg * 64 * 2048 + key0, 2048, q.pos + b * 2048 + key0, 1, 63); };
    auto fetch_slc = [&](int key0) { PR q = *get_params(); fetch(q.KS + ((size_t)bg * 2048 + key0) * 64, q.VSt + (size_t)bg * 64 * 2048 + key0, 2048, q.pos + b * 2048 + key0, 1, 63); };
    auto fetch_cmp = [&](int tile) { PR q = *get_params(); fetch(q.KCMP + ((size_t)bg * 128 + tile * 64) * 64, q.VCMPt + (size_t)bg * 64 * 128 + tile * 64, 128,
                                                                    q.pos + b * 2048 + 1024 * tile + 31, 16, 2047 - 1024 * tile - 31); };

    int stw;
    {
      __syncthreads();
      f32x4 o[4][2], ol[2];
      ol[0] = (f32x4){0.f, 0.f, 0.f, 0.f}; ol[1] = (f32x4){0.f, 0.f, 0.f, 0.f};
#pragma unroll
      for (int dt = 0; dt < 4; ++dt) { o[dt][0] = (f32x4){0.f, 0.f, 0.f, 0.f}; o[dt][1] = (f32x4){0.f, 0.f, 0.f, 0.f}; }
      const int kfirst = max(0, t0 - 255) >> 6, klast = t0 >> 6;
      stw = (klast - kfirst) & 1;
      fetch_win(kfirst * 64);
      for (int k64 = kfirst; k64 <= klast; ++k64) {
        const int key0 = k64 * 64;
        const int st = (k64 - kfirst) & 1;
        commit(st);
        __syncthreads();
        if (k64 < klast) fetch_win(key0 + 64); else fetch_cmp(0);
        const char* Kc = lds + st * STG;
        f32x4 s[4][2];
        qk_tile_aug<2, STR>(Kc, Kc + 18432, qf, qa, s, fr, fq);
        if (key0 < t0 + 15 - 255 || key0 + 63 > t0) {
#pragma unroll
          for (int kt = 0; kt < 4; ++kt)
#pragma unroll
            for (int j = 0; j < 4; ++j) {
              const int key = key0 + 16 * kt + 4 * fq + j;
#pragma unroll
              for (int qt = 0; qt < 2; ++qt) {
                const unsigned rel = (unsigned)(tq[qt] - key);
                s[kt][qt][j] = (rel < 256u) ? s[kt][qt][j] : NEGBIG;
              }
            }
        }
        exp_tile(s);
        pv_tile_l<STR>(Kc + 9216, s, o, ol, fr, fq);
      }
      {
        const float l0 = ol[0][0], l1 = ol[1][0];
        out_acc(o, (l0 > 0.f) ? gate[2][0] / l0 : 0.f, (l1 > 0.f) ? gate[2][1] / l1 : 0.f, true);
      }
    }

    {
      const int clim[2] = {(tq[0] - 31) >> 4, (tq[1] - 31) >> 4};
      const int sA = stw ^ 1, sB = stw;
      f32x4 ol[2];
      ol[0] = (f32x4){0.f, 0.f, 0.f, 0.f}; ol[1] = (f32x4){0.f, 0.f, 0.f, 0.f};
#pragma unroll
      for (int tl2 = 0; tl2 < 2; ++tl2) {
        const int st = tl2 ? sB : sA;
        commit(st);
        __syncthreads();
        if (tl2 == 0) fetch_cmp(1); else fetch_slc(0);
        f32x4 s[4][2];
        qk_tile_aug<2, STR>(lds + st * STG, lds + st * STG + 18432, qf, qa, s, fr, fq);
#pragma unroll
        for (int kt = 0; kt < 4; ++kt)
#pragma unroll
          for (int j = 0; j < 4; ++j) {
            const int c0 = tl2 * 64 + 16 * kt + 4 * fq + j;
#pragma unroll
            for (int qt = 0; qt < 2; ++qt) s[kt][qt][j] = fast_exp2((c0 <= clim[qt]) ? s[kt][qt][j] : NEGBIG);
          }
        rowsum_tile(s, ol);
      }
      float linv[2];
#pragma unroll
      for (int qt = 0; qt < 2; ++qt) { const float r = ol[qt][0]; linv[qt] = (r > 0.f) ? 1.0f / r : 0.f; }
      f32x4 o[4][2];
#pragma unroll
      for (int dt = 0; dt < 4; ++dt) { o[dt][0] = (f32x4){0.f, 0.f, 0.f, 0.f}; o[dt][1] = (f32x4){0.f, 0.f, 0.f, 0.f}; }
#pragma unroll
      for (int tl2 = 0; tl2 < 2; ++tl2) {
        const int st = tl2 ? sB : sA;
        f32x4 s[4][2];
        qk_tile_aug<2, STR>(lds + st * STG, lds + st * STG + 18432, qf, qa, s, fr, fq);
#pragma unroll
        for (int kt = 0; kt < 4; ++kt)
#pragma unroll
          for (int j = 0; j < 4; ++j) {
            const int c0 = tl2 * 64 + 16 * kt + 4 * fq + j;
#pragma unroll
            for (int qt = 0; qt < 2; ++qt) s[kt][qt][j] = fast_exp2((c0 <= clim[qt]) ? s[kt][qt][j] : NEGBIG);
          }
        pv_tile<STR>(lds + st * STG + 9216, s, o, fr, fq);
#pragma unroll
        for (int qt = 0; qt < 2; ++qt) {
          const int tl = 4 * wid + 2 * qt + (fr >> 3);
#pragma unroll
          for (int kt = 0; kt < 4; ++kt) {
            f32x4 hs;
#pragma unroll
            for (int j = 0; j < 4; ++j) hs[j] = head8_sum(s[kt][qt][j] * linv[qt]);
            if (head == 0) *(f32x4*)(Ptok + tl * 128 + tl2 * 64 + 16 * kt + 4 * fq) = hs;
          }
        }
      }
      out_acc(o, gate[0][0] * linv[0], gate[0][1] * linv[1], false);
      __syncthreads();
      const int cur = t0 >> 6;
      const int j = tid & 31;
#pragma unroll
      for (int i = 0; i < 2; ++i) {
        const int tl = (tid >> 5) + 8 * i;
        float im = 0.f;
        for (int c = max(4 * j - 1, 0); c <= 4 * j + 3; ++c) im += Ptok[tl * 128 + c];
        const bool forced = (j == 0) || (j == cur) || (j == cur - 1);
        const float v = forced ? 1e4f : ((j <= cur) ? im : -1.0f);
        unsigned key = ((v < 0.f) ? 0u : (__float_as_uint(v) | 0x80000000u));
        key = (key & ~31u) | (unsigned)(31 - j);
        bool sel = false;
#pragma unroll
        for (int rnd = 0; rnd < 8; ++rnd) {
          unsigned m = key;
          m = max(m, (unsigned)__builtin_amdgcn_update_dpp(0, (int)m, 0xB1, 0xF, 0xF, true));
          m = max(m, (unsigned)__builtin_amdgcn_update_dpp(0, (int)m, 0x4E, 0xF, 0xF, true));
          m = max(m, (unsigned)__builtin_amdgcn_update_dpp(0, (int)m, 0x141, 0xF, 0xF, true));
          m = max(m, (unsigned)__builtin_amdgcn_update_dpp(0, (int)m, 0x140, 0xF, 0xF, true));
          m = max(m, (unsigned)__shfl_xor((int)m, 16));
          const bool win = (key == m);
          sel = sel || win;
          key = win ? 0u : key;
        }
        const unsigned long long bal = __ballot(sel);
        if (j == 0) maskL[tl] = (unsigned)(bal >> (lane & 32));
      }
      __syncthreads();
    }

    {
      const int cur = t0 >> 6;
      const unsigned curmask = (cur >= 31) ? 0xffffffffu : ((2u << cur) - 1u);
      unsigned um = 0u;
#pragma unroll
      for (int i = 0; i < 16; ++i) um |= maskL[i];
      um &= curmask;
      unsigned mq[2];
#pragma unroll
      for (int qt = 0; qt < 2; ++qt) mq[qt] = maskL[4 * wid + 2 * qt + (fr >> 3)];
      const unsigned wm = (maskL[4 * wid] | maskL[4 * wid + 1] | maskL[4 * wid + 2] | maskL[4 * wid + 3]) & curmask;
      f32x4 o[4][2], ol[2];
      ol[0] = (f32x4){0.f, 0.f, 0.f, 0.f}; ol[1] = (f32x4){0.f, 0.f, 0.f, 0.f};
#pragma unroll
      for (int dt = 0; dt < 4; ++dt) { o[dt][0] = (f32x4){0.f, 0.f, 0.f, 0.f}; o[dt][1] = (f32x4){0.f, 0.f, 0.f, 0.f}; }
      unsigned rem = um;
      for (int step = 0; rem != 0u; ++step) {
        const int jb = __builtin_ctz(rem); rem &= rem - 1u;
        const int key0 = jb * 64;
        const int st = step & 1;
        commit(st);
        __syncthreads();
        if (rem != 0u) fetch_slc(__builtin_ctz(rem) * 64);
        if ((wm >> jb) & 1u) {
          const char* Kc = lds + st * STG;
          f32x4 s[4][2];
          bf16x8 qs[2];
          qs[0] = make_qaug(slope2, ((mq[0] >> jb) & 1u) ? colc[0] : NEGBIG, fq);
          qs[1] = make_qaug(slope2, ((mq[1] >> jb) & 1u) ? colc[1] : NEGBIG, fq);
          qk_tile_aug<2, STR>(Kc, Kc + 18432, qf, qs, s, fr, fq);
          {
#pragma unroll
            for (int kt = 0; kt < 4; ++kt)
#pragma unroll
              for (int j = 0; j < 4; ++j) {
                const int key = key0 + 16 * kt + 4 * fq + j;
#pragma unroll
                for (int qt = 0; qt < 2; ++qt) s[kt][qt][j] = (key <= tq[qt]) ? s[kt][qt][j] : NEGBIG;
              }
          }
          exp_tile(s);
          pv_tile_l<STR>(Kc + 9216, s, o, ol, fr, fq);
        }
      }
      {
        const float l0 = ol[0][0], l1 = ol[1][0];
        out_acc(o, (l0 > 0.f) ? gate[1][0] / l0 : 0.f, (l1 > 0.f) ? gate[1][1] / l1 : 0.f, false);
      }
    }
    {
      const int c16 = lane & 7;
#pragma unroll
      for (int i = 0; i < 4; ++i) {
        const int r = (lane >> 3) + 8 * i;
        const int tok = t0 + 4 * wid + 2 * (r >> 4) + ((r & 15) >> 3), hh = g * 8 + (r & 7);
        const char* src = Ot + (32 * wid + r) * OSTR + c16 * 16;
        const u32x2 lo = *(const u32x2*)(src), hi = *(const u32x2*)(src + 8);
        *(u32x4*)(p.hn + (size_t)(b * 2048 + tok) * 1024 + hh * 64 + c16 * 8) = (u32x4){lo[0], lo[1], hi[0], hi[1]};
      }
    }
    __syncthreads();
  }
}

DEVI void misc_init(PR p) {
  if (blockIdx.x >= gridDim.x - 9 && blockIdx.x < gridDim.x - 1) {
    const int part = blockIdx.x - (gridDim.x - 9);
    const int layer = part >> 2, k = (part & 3) * 256 + get_tid();
    const float g = p.norm_ffn[layer * 1024 + k];
    for (int n = 0; n < 48; ++n) {
      float w = 0.f;
      if (n < 4) w = p.r_group[((size_t)layer * 1024 + k) * 4 + n];
      else if (n < 36) w = p.r_expert[((size_t)layer * 1024 + k) * 32 + (n - 4)];
      w *= g;
      const float hi = bf_round(w);
      p.RWh[((size_t)layer * 48 + n) * 1024 + k] = f2bf(hi);
      p.RWl[((size_t)layer * 48 + n) * 1024 + k] = f2bf(w - hi);
    }
  }
  if (blockIdx.x == gridDim.x - 1) {
    const int tid = get_tid();
    if (tid < 64) p.gcnt[tid] = 0;
    p.gcntP[tid] = 0;
    const int kv = tid >> 7, n = tid & 127;
    const float* pe = kv ? p.cmp_pe_v : p.cmp_pe_k;
    const float* w1 = kv ? p.cmp_w1_v : p.cmp_w1_k;
    float a = 0.f;
    for (int i = 0; i < 2048; ++i) a += pe[i] * w1[(size_t)i * 128 + n];
    p.bias1[tid] = a;
  }
}


#define XB_TMO      128
#define XB_XCNT(j)  (256  + 64 * (j))
#define XB_XSUB(j)  (1280 + 64 * (j))
#define XB_XGEN(j)  (2304 + 64 * (j))
#define XB_TOP      3328
#define XB_TOPGEN   3392
#define XCD_BAR_WORDS 3456
#define XB_SPIN_CAP (1u << 20)
#define LAS __attribute__((address_space(3)))
DEVI unsigned xb_ld(unsigned* p) { return __hip_atomic_load(p, __ATOMIC_RELAXED, __HIP_MEMORY_SCOPE_AGENT); }
DEVI unsigned xb_add(unsigned* p, unsigned v) { return __hip_atomic_fetch_add(p, v, __ATOMIC_RELAXED, __HIP_MEMORY_SCOPE_AGENT); }
DEVI unsigned xb_xcc_id() { return (unsigned)__builtin_amdgcn_s_getreg((3 << 11) | 20) & 0xFu; }
#define XB_SPIN(cond, bar) do { unsigned _sp = 0; while (cond) { __builtin_amdgcn_s_sleep(1); \
    if ((++_sp & 255u) == 0u) { if (xb_ld(&(bar)[XB_TMO])) break; if (_sp > XB_SPIN_CAP) { atomicAdd(&(bar)[XB_TMO], 1u); break; } } } } while (0)
struct XcdBarrier { unsigned* bar; unsigned x; volatile LAS unsigned* st; };
DEVI XcdBarrier xcd_barrier_post(unsigned* bar, volatile LAS unsigned* st) {
  XcdBarrier b; b.bar = bar; b.x = xb_xcc_id(); b.st = st;
  if (threadIdx.x == 0) (void)xb_add(&bar[XB_XCNT(b.x)], 1u);
  return b;
}
DEVI void xcd_barrier_complete(unsigned* bar, unsigned x, unsigned& nloc, unsigned& nx) {
  const unsigned G = gridDim.x * gridDim.y * gridDim.z;
  unsigned sum, cnt, mine, sp = 0u;
  for (;;) {
    sum = 0u; cnt = 0u; mine = 0u;
#pragma unroll
    for (unsigned j = 0; j < 16; ++j) { const unsigned c = xb_ld(&bar[XB_XCNT(j)]); sum += c; cnt += (c > 0u) ? 1u : 0u; mine = (j == x) ? c : mine; }
    if (sum == G) break;
    __builtin_amdgcn_s_sleep(1);
    if ((++sp & 255u) == 0u) { if (xb_ld(&bar[XB_TMO])) break; if (sp > XB_SPIN_CAP) { atomicAdd(&bar[XB_TMO], 1u); break; } }
  }
  nloc = mine > 0u ? mine : 1u; nx = cnt > 0u ? cnt : 1u;
}
DEVI void xcd_barrier(const XcdBarrier& b) {
  asm volatile("s_waitcnt vmcnt(0)" ::: "memory");
  __syncthreads();
  if (threadIdx.x == 0) {
    unsigned* bar = b.bar;
    __builtin_amdgcn_s_waitcnt(0);
    unsigned nloc = b.st[0], nx = b.st[1];
    if (nloc == 0u) { xcd_barrier_complete(bar, b.x, nloc, nx); b.st[0] = nloc; b.st[1] = nx; }
    const unsigned old = xb_add(&bar[XB_XSUB(b.x)], 1u);
    const unsigned gen = old / nloc;
    if (old + 1u == (gen + 1u) * nloc) {
      __builtin_amdgcn_fence(__ATOMIC_RELEASE, "agent");
      asm volatile("s_waitcnt vmcnt(0)" ::: "memory");
      const unsigned og = xb_add(&bar[XB_TOP], 1u);
      const unsigned tg = og / nx;
      if (og + 1u == (tg + 1u) * nx) xb_add(&bar[XB_TOPGEN], 1u);
      else XB_SPIN(xb_ld(&bar[XB_TOPGEN]) == tg, bar);
      __builtin_amdgcn_fence(__ATOMIC_ACQUIRE, "agent");
      xb_add(&bar[XB_XGEN(b.x)], 1u);
      asm volatile("s_waitcnt vmcnt(0)" ::: "memory");
    } else {
      XB_SPIN(xb_ld(&bar[XB_XGEN(b.x)]) == gen, bar);
      __builtin_amdgcn_fence(__ATOMIC_ACQUIRE, "agent");
      asm volatile("s_waitcnt vmcnt(0)" ::: "memory");
    }
  }
  __syncthreads();
}

#ifndef PROBE_PHASE
#define PROBE_PHASE -1
#endif
#define GSYNC() do { if (use_cg) grid.sync(); else xcd_barrier(xb); } while (0)
__global__ void __launch_bounds__(256, 2) mega_kernel(Params p_unused) {
  extern __shared__ __attribute__((aligned(16))) char lds[];
  cg::grid_group grid = cg::this_grid();
  volatile LAS unsigned* xst = (volatile LAS unsigned*)(lds + LDS_BYTES - 16);
  if (threadIdx.x == 0) { xst[0] = 0u; xst[1] = 0u; }
  __syncthreads();
  unsigned* barw; int use_cg;
  { PR p = *get_params(); barw = p.bar; use_cg = p.use_cg; }
  const XcdBarrier xb = xcd_barrier_post(barw, xst);
  { PR p = *get_params(); conv_weights_phase(p, 0, p.njobsA, p.ntilesA, lds); }
  { PR p = *get_params(); xcopy_phase(p); }
  { PR p = *get_params(); misc_init(p); }
  GSYNC();
#if PROBE_PHASE == 0
  { PR p = *get_params(); conv_weights_phase(p, 0, p.njobsA, p.ntilesA, lds); }
  { PR p = *get_params(); xcopy_phase(p); }
  GSYNC();
#endif
  { PR p = *get_params(); gemm_bf16out_phase(p.xb, 1024, p.W1t, 1024, 12, p.proj0, 1440, 1440, p.rs0, lds); }
  { PR p = *get_params(); conv_weights_phase(p, p.njobsA, p.njobs0, p.ntiles0, lds); }
  GSYNC();
#if PROBE_PHASE == 1
  { PR p = *get_params(); gemm_bf16out_phase(p.xb, 1024, p.W1t, 1024, 12, p.proj0, 1440, 1440, p.rs0, lds); }
  GSYNC();
#endif
  { PR p = *get_params(); l0_phase2(p, lds); }
  GSYNC();
#if PROBE_PHASE == 2
  { PR p = *get_params(); l0_phase2(p, lds); }
  GSYNC();
#endif
  { PR p = *get_params(); mla_attn_phase(p, lds); }
  GSYNC();
#if PROBE_PHASE == 3
  { PR p = *get_params(); mla_attn_phase(p, lds); }
  GSYNC();
#endif
  { PR p = *get_params(); gemm_resid_phase(p.hn, p.Wo0t, p.xb, p.xr, lds); }
  GSYNC();
#if PROBE_PHASE == 4
  { PR p = *get_params(); gemm_resid_phase(p.hn, p.Wo0t, p.xb, p.xr, lds); }
  GSYNC();
#endif
#if PROBE_PHASE == 5
  { PR p = *get_params(); router_phase(p, 1, lds); }
  GSYNC();
  { PR p = *get_params(); if (blockIdx.x == 0 && threadIdx.x < 32) p.gcnt[32 + threadIdx.x] = 0; }
#endif
  { PR p = *get_params(); router_phase(p, 0, lds); }
  GSYNC();
  { PR p = *get_params(); moe_gateup_phase(p, 0, lds); }
  GSYNC();
#if PROBE_PHASE == 6
  { PR p = *get_params(); moe_gateup_phase(p, 0, lds); }
  GSYNC();
#endif
  { PR p = *get_params(); moe_down_phase(p, 0, lds); }
  GSYNC();
#if PROBE_PHASE == 7
  { PR p = *get_params(); moe_down_phase(p, 0, lds); }
  GSYNC();
#endif
  { PR p = *get_params(); nsa_proj_phase(p, lds); }
  GSYNC();
#if PROBE_PHASE == 9
  { PR p = *get_params(); nsa_proj_phase(p, lds); }
  GSYNC();
#endif
  { PR p = *get_params(); compress_phase(p, lds); }
  { PR p = *get_params(); conv_weights_phase(p, p.njobs1_begin, p.njobs1_begin + 3, p.ntiles1, lds); }
  GSYNC();
#if PROBE_PHASE == 10
  { PR p = *get_params(); compress_phase(p, lds); }
  GSYNC();
#endif
  { PR p = *get_params(); nsa_attn_phase(p, lds); }
  GSYNC();
#if PROBE_PHASE == 11
  { PR p = *get_params(); nsa_attn_phase(p, lds); }
  GSYNC();
#endif
  { PR p = *get_params(); gemm_resid_phase(p.hn, p.Wo1t, p.xr, p.xr, lds); }
  GSYNC();
  { PR p = *get_params(); router_phase(p, 1, lds); }
  GSYNC();
  { PR p = *get_params(); moe_gateup_phase(p, 1, lds); }
  GSYNC();
  { PR p = *get_params(); moe_down_phase(p, 1, lds); }
}

static inline size_t align_up(size_t v, size_t a) { return (v + a - 1) / a * a; }

extern "C" void kernel_launch(void* const* d_in, const int* in_sizes, int n_in, void* d_out, int out_size, void* d_ws, size_t ws_size,
                              hipStream_t stream) {
  (void)in_sizes; (void)n_in; (void)out_size;
  Params p;
  memset(&p, 0, sizeof(p));
  const float* const* in = (const float* const*)d_in;
  p.x = in[0]; p.pos = (const int*)d_in[1]; p.norm_mix = in[2]; p.norm_ffn = in[3];
  const float* mix0_w_in = in[4]; const float* mla_q_a_norm = in[5]; const float* mla_w_uq = in[6];
  const float* mla_kv_a_norm = in[7]; const float* mla_w_ukv = in[8];
  p.mla_q_norm = in[9]; p.mla_k_norm = in[10];
  p.conv_dw_w = in[11]; p.conv_dw_b = in[12]; p.conv_ln_g = in[13]; p.conv_ln_b = in[14];
  const float* mix0_w_out = in[15]; const float* nsa_w_in = in[16];
  p.nsa_q_norm = in[17]; p.nsa_k_norm_cmp = in[18]; p.nsa_k_norm_slc = in[19]; p.nsa_k_norm_win = in[20];
  p.cmp_pe_k = in[21]; p.cmp_w1_k = in[22]; const float* cmp_w2_k = in[23];
  p.cmp_pe_v = in[24]; p.cmp_w1_v = in[25]; const float* cmp_w2_v = in[26];
  const float* nsa_w_out = in[27];
  p.r_group = in[28]; p.r_group_b = in[29]; p.r_expert = in[30]; p.r_expert_b = in[31];
  const float* w_gate = in[32]; const float* w_up = in[33]; const float* w_down = in[34];
  p.out = (float*)d_out;

  char* ws = (char*)d_ws; size_t off = 0;
  auto take = [&](size_t bytes) { char* r = ws + off; off = align_up(off + bytes, 256); return r; };
  p.W1t = (bf16_t*)take((size_t)1536 * 1024 * 2);
  p.Wuqt = (bf16_t*)take((size_t)768 * 256 * 2);
  p.Wukvt = (bf16_t*)take((size_t)1024 * 128 * 2);
  p.Wo0t = (bf16_t*)take((size_t)1024 * 1024 * 2);
  p.W5t = (bf16_t*)take((size_t)1920 * 1024 * 2);
  p.Wc1kt = (bf16_t*)take((size_t)128 * 2048 * 2);
  p.Wc1vt = (bf16_t*)take((size_t)128 * 2048 * 2);
  p.Wc2kt = (bf16_t*)take((size_t)64 * 128 * 2);
  p.Wc2vt = (bf16_t*)take((size_t)64 * 128 * 2);
  p.Wo1t = (bf16_t*)take((size_t)1024 * 1024 * 2);
  p.Wgut = (bf16_t*)take((size_t)32 * 512 * 1024 * 2);
  p.Wdt = (bf16_t*)take((size_t)32 * 1024 * 256 * 2);
  p.xr = (bf16_t*)take((size_t)T_ * 1024 * 2);
  p.hn = (bf16_t*)take((size_t)T_ * 1024 * 2);
  p.RWh = (bf16_t*)take((size_t)2 * 48 * 1024 * 2);
  p.RWl = (bf16_t*)take((size_t)2 * 48 * 1024 * 2);
  p.rs = (float*)take((size_t)T_ * 4);
  p.rs0 = (float*)take((size_t)T_ * 4);
  {
    char* u = (char*)take((size_t)T_ * 1024 * 2);
    p.xb = (bf16_t*)u;
    size_t o = 0;
    auto tk = [&](size_t bytes) { char* r = u + o; o = align_up(o + bytes, 256); return r; };
    p.row_aux = (float2*)tk((size_t)32 * T_ * 8);
    p.row_tok = (int*)tk((size_t)32 * T_ * 4);
    p.pair_tok = (int*)tk((size_t)112 * T_ * 4);
    p.pair_rk = (int2*)tk((size_t)112 * T_ * 8);
  }
  p.gcnt = (int*)take(256);
  p.gcntP = (int*)take(1024);
  p.ssp = (float*)take((size_t)T_ * 8 * 4);
  p.bias1 = (float*)take(1024);
  p.bar = (unsigned*)take((size_t)XCD_BAR_WORDS * 4);
  p.use_cg = 0;
  p.KCMP = (bf16_t*)take((size_t)32 * 128 * 64 * 2);
  p.VCMPt = (bf16_t*)take((size_t)32 * 64 * 128 * 2);
  char* scr = ws + off;
  {
    size_t o = 0;
    auto tk = [&](size_t bytes) { char* r = scr + o; o = align_up(o + bytes, 256); return r; };
    p.proj0 = (bf16_t*)tk((size_t)T_ * 1440 * 2);
    p.Q0 = (bf16_t*)tk((size_t)T_ * 768 * 2);
    p.K0 = (bf16_t*)tk((size_t)T_ * 768 * 2);
    p.V0t = (bf16_t*)tk((size_t)T_ * 512 * 2);
  }
  {
    size_t o = 0;
    auto tk = [&](size_t bytes) { char* r = scr + o; o = align_up(o + bytes, 256); return r; };
    p.hbuf = (bf16_t*)tk((size_t)(2 * T_ + 4096) * 256 * 2);
  }
  {
    size_t o = 0;
    auto tk = [&](size_t bytes) { char* r = scr + o; o = align_up(o + bytes, 256); return r; };
    p.Q1 = (bf16_t*)tk((size_t)T_ * 1024 * 2);
    p.KC = (bf16_t*)tk((size_t)T_ * 128 * 2);
    p.VC = (bf16_t*)tk((size_t)T_ * 128 * 2);
    p.KS = (bf16_t*)tk((size_t)T_ * 128 * 2);
    p.VSt = (bf16_t*)tk((size_t)T_ * 128 * 2);
    p.KW = (bf16_t*)tk((size_t)T_ * 128 * 2);
    p.VWt = (bf16_t*)tk((size_t)T_ * 128 * 2);
    p.GATES = (float*)tk((size_t)T_ * 48 * 4);
  }
  const size_t need = off + (size_t)T_ * (1440 + 768 + 768 + 512) * 2 + 4096;
  if (need > ws_size) { fprintf(stderr, "workspace too small: need %zu have %zu\n", need, ws_size); return; }
  for (int i = 0; i < 16; ++i) p.inv_freq[i] = (float)pow(10000.0, -(double)i / 16.0);

  int nj = 0, tiles = 0;
  auto add = [&](const float* src, bf16_t* dst, const float* gain, int K, int N, int Npad, int mode, int batch, long long ss, long long ds) {
    ConvJob& j = p.jobs[nj++];
    j.src = src; j.dst = dst; j.gain = gain; j.K = K; j.N = N; j.Npad = Npad; j.mode = mode; j.batch = batch; j.tile_start = tiles; j.pad0 = 0;
    j.sstride = ss; j.dstride = ds;
    tiles += batch * (K / 64) * (Npad / 64);
  };
  add(mix0_w_in, p.W1t, p.norm_mix, 1024, 1440, 1536, 0, 1, 0, 0);
  add(mla_w_uq, p.Wuqt, mla_q_a_norm, 256, 768, 768, 0, 1, 0, 0);
  add(mla_w_ukv, p.Wukvt, mla_kv_a_norm, 128, 1024, 1024, 0, 1, 0, 0);
  add(mix0_w_out, p.Wo0t, nullptr, 1024, 1024, 1024, 0, 1, 0, 0);
  add(nsa_w_in, p.W5t, p.norm_mix + 1024, 1024, 1840, 1920, 0, 1, 0, 0);
  add(p.cmp_w1_k, p.Wc1kt, nullptr, 2048, 128, 128, 0, 1, 0, 0);
  add(p.cmp_w1_v, p.Wc1vt, nullptr, 2048, 128, 128, 0, 1, 0, 0);
  add(cmp_w2_k, p.Wc2kt, nullptr, 128, 64, 64, 0, 1, 0, 0);
  add(cmp_w2_v, p.Wc2vt, nullptr, 128, 64, 64, 0, 1, 0, 0);
  add(nsa_w_out, p.Wo1t, nullptr, 1024, 1024, 1024, 0, 1, 0, 0);
  p.njobsA = nj; p.ntilesA = tiles;
  tiles = 0;
  add(w_gate, p.Wgut, p.norm_ffn, 1024, 256, 256, 1, 32, 1024LL * 256, 512LL * 1024);
  add(w_up, p.Wgut, p.norm_ffn, 1024, 256, 256, 2, 32, 1024LL * 256, 512LL * 1024);
  add(w_down, p.Wdt, nullptr, 256, 1024, 1024, 0, 32, 256LL * 1024, 1024LL * 256);
  p.njobs0 = nj; p.ntiles0 = tiles;
  p.njobs1_begin = nj;
  tiles = 0;
  const size_t l1 = (size_t)32 * 1024 * 256;
  add(w_gate + l1, p.Wgut, p.norm_ffn + 1024, 1024, 256, 256, 1, 32, 1024LL * 256, 512LL * 1024);
  add(w_up + l1, p.Wgut, p.norm_ffn + 1024, 1024, 256, 256, 2, 32, 1024LL * 256, 512LL * 1024);
  add(w_down + l1, p.Wdt, nullptr, 256, 1024, 1024, 0, 32, 256LL * 1024, 1024LL * 256);
  p.ntiles1 = tiles;

  static int grid_blocks = 0;
  if (!grid_blocks) {
    (void)hipFuncSetAttribute((const void*)mega_kernel, hipFuncAttributeMaxDynamicSharedMemorySize, LDS_BYTES);
    int dev = 0, cus = 0, per_cu = 0;
    (void)hipGetDevice(&dev);
    (void)hipDeviceGetAttribute(&cus, hipDeviceAttributeMultiprocessorCount, dev);
    (void)hipOccupancyMaxActiveBlocksPerMultiprocessor(&per_cu, mega_kernel, 256, LDS_BYTES);
    if (per_cu > 2) per_cu = 2;
    if (per_cu < 1) per_cu = 1;
    grid_blocks = cus * per_cu;
  }
  (void)hipMemsetAsync(p.bar, 0, (size_t)XCD_BAR_WORDS * 4, stream);
  void* args[] = {&p};
  hipError_t e = hipLaunchCooperativeKernel((const void*)mega_kernel, dim3(grid_blocks), dim3(256), args, LDS_BYTES, stream);
  if (e != hipSuccess) fprintf(stderr, "cooperative launch failed: %s (grid %d)\n", hipGetErrorString(e), grid_blocks);
}
```

```cpp
#include <hip/hip_runtime.h>
#include <hip/hip_cooperative_groups.h>
#include <stdint.h>
#include <math.h>
#include <stdio.h>
#include <string.h>
namespace cg = cooperative_groups;

typedef unsigned short bf16_t;
typedef short bf16x8 __attribute__((ext_vector_type(8)));
typedef float f32x4 __attribute__((ext_vector_type(4)));
typedef unsigned u32x4 __attribute__((ext_vector_type(4)));
typedef unsigned u32x2 __attribute__((ext_vector_type(2)));

#define DEVI __device__ __forceinline__
#define AS4 __attribute__((address_space(4)))

constexpr int T_ = 32768;
constexpr int S_ = 2048;
constexpr int LDS_BYTES = 73728;
constexpr int PROJ_LD = 512;
constexpr float LOG2E = 1.4426950408889634f;
constexpr float NEGBIG = -1e30f;

struct ConvJob {
  const float* src; bf16_t* dst; const float* gain;
  int K, N, Npad, mode, batch, tile_start, pad0;
  long long sstride, dstride;
};
constexpr int MAXJOBS = 16;

struct Params {
  const float* x; const int* pos; const float* norm_mix; const float* norm_ffn;
  const float* mla_q_norm; const float* mla_k_norm;
  const float* conv_dw_w; const float* conv_dw_b; const float* conv_ln_g; const float* conv_ln_b;
  const float* nsa_q_norm; const float* nsa_k_norm_cmp; const float* nsa_k_norm_slc; const float* nsa_k_norm_win;
  const float* cmp_pe_k; const float* cmp_w1_k; const float* cmp_pe_v; const float* cmp_w1_v;
  const float* r_group; const float* r_group_b; const float* r_expert; const float* r_expert_b;
  float* out;
  bf16_t* W1t; bf16_t* Wuqt; bf16_t* Wukvt; bf16_t* Wo0t; bf16_t* W5t;
  bf16_t* Wc1kt; bf16_t* Wc1vt; bf16_t* Wc2kt; bf16_t* Wc2vt; bf16_t* Wo1t;
  bf16_t* Wgut; bf16_t* Wdt;
  bf16_t* xr;
  bf16_t* hn;
  bf16_t* proj0; bf16_t* Q0; bf16_t* K0; bf16_t* V0t;
  bf16_t* hbuf;
  bf16_t* Q1; bf16_t* KC; bf16_t* VC; bf16_t* KS; bf16_t* VSt; bf16_t* KW; bf16_t* VWt; float* GATES;
  bf16_t* KCMP; bf16_t* VCMPt;
  bf16_t* RWh; bf16_t* RWl; float* rs; float2* row_aux; int* row_tok; int* gcnt; float* bias1; unsigned* bar;
  bf16_t* gluB;
  bf16_t* xb; float* rs0;
  int* cflag;
  float* ssq;
  float* ssp;
  int* pair_tok; int2* pair_rk; int* gcntP;
  float inv_freq[16];
  ConvJob jobs[MAXJOBS];
  int njobs0, ntiles0, njobs1_begin, ntiles1, use_cg, njobsA, ntilesA, pad3;
};

typedef const AS4 Params& PR;
DEVI const AS4 Params* get_params() {
  const AS4 Params* kp = (const AS4 Params*)__builtin_amdgcn_kernarg_segment_ptr();
  asm volatile("" : "+s"(kp));
  return kp;
}

DEVI int get_tid() { int t = threadIdx.x; asm volatile("" : "+v"(t)); return t; }

typedef float f32x2_ __attribute__((ext_vector_type(2)));
typedef __bf16 bf16x2_ __attribute__((ext_vector_type(2)));
DEVI unsigned pack2(float lo, float hi) { const f32x2_ v = {lo, hi}; return __builtin_bit_cast(unsigned, __builtin_convertvector(v, bf16x2_)); }
DEVI float bflo(unsigned w) { return __uint_as_float(w << 16); }
DEVI float bfhi(unsigned w) { return __uint_as_float(w & 0xffff0000u); }
DEVI float bf2f(bf16_t h) { return __uint_as_float(((unsigned)h) << 16); }
DEVI bf16_t f2bf(float f) { return (bf16_t)(pack2(f, 0.f) & 0xffffu); }
DEVI float fast_exp2(float x) { return __builtin_amdgcn_exp2f(x); }
DEVI float fast_rcp(float x) { return __builtin_amdgcn_rcpf(x); }
DEVI float sigmoidf_(float x) { return fast_rcp(1.0f + fast_exp2(-x * LOG2E)); }
DEVI float wave_sum(float v) {
  v += __shfl_xor(v, 32); v += __shfl_xor(v, 16); v += __shfl_xor(v, 8);
  v += __shfl_xor(v, 4); v += __shfl_xor(v, 2); v += __shfl_xor(v, 1); return v;
}
DEVI void sincos_rev(float ang, float& s, float& c) {
  float rev = ang * 0.15915494309189535f;
  rev = rev - floorf(rev);
  s = __builtin_amdgcn_sinf(rev); c = __builtin_amdgcn_cosf(rev);
}

struct XcdIter {
  int xcd, lb, nlb;
  DEVI void init() { xcd = blockIdx.x & 7; lb = blockIdx.x >> 3; nlb = gridDim.x >> 3; }
};

DEVI int swz(int r, int c16) { return r * 128 + ((c16 ^ ((r >> 1) & 7)) << 4); }

template <int NT>
DEVI void mma_stage(const char* As, const char* Bs, f32x4 (&acc)[4][NT], int wr, int wc, int fr, int fq) {
  bf16x8 a[2][4], b[2][NT];
#pragma unroll
  for (int ks = 0; ks < 2; ++ks) {
#pragma unroll
    for (int m = 0; m < 4; ++m) a[ks][m] = *(const bf16x8*)(As + swz(wr * 64 + m * 16 + fr, ks * 4 + fq));
#pragma unroll
    for (int n = 0; n < NT; ++n) b[ks][n] = *(const bf16x8*)(Bs + swz(wc * (NT * 16) + n * 16 + fr, ks * 4 + fq));
  }
  __builtin_amdgcn_sched_barrier(0);
#pragma unroll
  for (int ks = 0; ks < 2; ++ks) {
#pragma unroll
    for (int m = 0; m < 4; ++m)
#pragma unroll
      for (int n = 0; n < NT; ++n) acc[m][n] = __builtin_amdgcn_mfma_f32_16x16x32_bf16(a[ks][m], b[ks][n], acc[m][n], 0, 0, 0);
    __builtin_amdgcn_sched_barrier(0);
  }
}

template <int NT, class ARow, class BRow>
DEVI void gemm_mainloop2(f32x4 (&acc)[4][NT], ARow arow, BRow brow, int K, char* lds);

template <int NT, class ARow>
DEVI void gemm_mainloop(f32x4 (&acc)[4][NT], ARow arow, const bf16_t* __restrict__ Bt, int ldb, int K, char* lds) {
  gemm_mainloop2<NT>(acc, arow, [&](int r) { return Bt + (size_t)r * ldb; }, K, lds);
}

template <int NT, class ARow, class BRow>
DEVI void gemm_mainloop2(f32x4 (&acc)[4][NT], ARow arow, BRow brow, int K, char* lds) {
  constexpr int NBR = NT;
  constexpr int STAGE = 16384 + NT * 32 * 128;
  const int tid = get_tid(), lane = tid & 63, wid = tid >> 6, wr = wid >> 1, wc = wid & 1, fr = lane & 15, fq = lane >> 4;
  const int lr = tid >> 3, lc = (tid & 7) ^ ((lr >> 1) & 7);
  const bf16_t* ap[4]; const bf16_t* bp[NBR];
#pragma unroll
  for (int i = 0; i < 4; ++i) ap[i] = arow(lr + 32 * i) + lc * 8;
#pragma unroll
  for (int i = 0; i < NBR; ++i) bp[i] = brow(lr + 32 * i) + lc * 8;
#pragma unroll
  for (int m = 0; m < 4; ++m)
#pragma unroll
    for (int n = 0; n < NT; ++n) acc[m][n] = (f32x4){0.f, 0.f, 0.f, 0.f};
  const int nk = K >> 6;
  auto issue = [&](int kt) {
    char* As = lds + (kt & 1) * STAGE + tid * 16; char* Bs = As + 16384;
#pragma unroll
    for (int i = 0; i < 4; ++i) __builtin_amdgcn_global_load_lds((const unsigned*)(ap[i] + kt * 64), (unsigned*)(As + i * 4096), 16, 0, 0);
#pragma unroll
    for (int i = 0; i < NBR; ++i) __builtin_amdgcn_global_load_lds((const unsigned*)(bp[i] + kt * 64), (unsigned*)(Bs + i * 4096), 16, 0, 0);
  };
  constexpr int NDMA = 4 + NBR;
  auto piece = [&](int kt, int i) {
    char* As = lds + (kt & 1) * STAGE + tid * 16; char* Bs = As + 16384;
    if (i < 4) __builtin_amdgcn_global_load_lds((const unsigned*)(ap[i] + kt * 64), (unsigned*)(As + i * 4096), 16, 0, 0);
    else __builtin_amdgcn_global_load_lds((const unsigned*)(bp[i - 4] + kt * 64), (unsigned*)(Bs + (i - 4) * 4096), 16, 0, 0);
  };
  issue(0); issue(1);
  for (int kt = 0; kt < nk; ++kt) {
    if (kt + 1 < nk) asm volatile("s_waitcnt vmcnt(%0)" :: "n"(NDMA) : "memory");
    else asm volatile("s_waitcnt vmcnt(0)" ::: "memory");
    __builtin_amdgcn_s_barrier();
    asm volatile("" ::: "memory");
    const char* As = lds + (kt & 1) * STAGE; const char* Bs = As + 16384;
    bf16x8 a[2][4], b[2][NT];
#pragma unroll
    for (int ks = 0; ks < 2; ++ks) {
#pragma unroll
      for (int m = 0; m < 4; ++m) a[ks][m] = *(const bf16x8*)(As + swz(wr * 64 + m * 16 + fr, ks * 4 + fq));
#pragma unroll
      for (int n = 0; n < NT; ++n) b[ks][n] = *(const bf16x8*)(Bs + swz(wc * (NT * 16) + n * 16 + fr, ks * 4 + fq));
    }
    asm volatile("s_waitcnt lgkmcnt(0)" ::: "memory");
    __builtin_amdgcn_s_barrier();
    asm volatile("" ::: "memory");
    __builtin_amdgcn_sched_barrier(0);
    const bool pf = kt + 2 < nk;
#pragma unroll
    for (int ks = 0; ks < 2; ++ks)
#pragma unroll
      for (int m = 0; m < 4; ++m) {
#pragma unroll
        for (int n = 0; n < NT; ++n) acc[m][n] = __builtin_amdgcn_mfma_f32_16x16x32_bf16(a[ks][m], b[ks][n], acc[m][n], 0, 0, 0);
        if (ks * 4 + m < NDMA) { if (pf) piece(kt + 2, ks * 4 + m); }
        __builtin_amdgcn_sched_barrier(0);
      }
  }
  __syncthreads();
}

template <class Rows2>
DEVI void gemm_mainloop_pair(f32x4 (&acc)[4][4], Rows2 rows2, const bf16_t* WA, const bf16_t* WB, char* lds) {
  constexpr int STAGE = 32768;
  const int tid = get_tid(), lane = tid & 63, wid = tid >> 6, wr = wid >> 1, wc = wid & 1, fr = lane & 15, fq = lane >> 4;
  const int lr = tid >> 3, lc = (tid & 7) ^ ((lr >> 1) & 7);
  const bf16_t* ap[4]; const bf16_t* ap2[4]; const bf16_t* bp[4]; const bf16_t* bp2[4];
#pragma unroll
  for (int i = 0; i < 4; ++i) {
    const bf16_t* pa; const bf16_t* pb;
    rows2(i, pa, pb);
    ap[i] = pa + lc * 8; ap2[i] = pb + lc * 8 - 256;
    bp[i] = WA + (size_t)(lr + 32 * i) * 256 + lc * 8; bp2[i] = WB + (size_t)(lr + 32 * i) * 256 + lc * 8 - 256;
  }
#pragma unroll
  for (int m = 0; m < 4; ++m)
#pragma unroll
    for (int n = 0; n < 4; ++n) acc[m][n] = (f32x4){0.f, 0.f, 0.f, 0.f};
  auto issue = [&](int kt) {
    char* As = lds + (kt & 1) * STAGE + tid * 16; char* Bs = As + 16384;
    const bool second = kt >= 4;
#pragma unroll
    for (int i = 0; i < 4; ++i) __builtin_amdgcn_global_load_lds((const unsigned*)((second ? ap2[i] : ap[i]) + kt * 64), (unsigned*)(As + i * 4096), 16, 0, 0);
#pragma unroll
    for (int i = 0; i < 4; ++i) __builtin_amdgcn_global_load_lds((const unsigned*)((second ? bp2[i] : bp[i]) + kt * 64), (unsigned*)(Bs + i * 4096), 16, 0, 0);
  };
  issue(0);
#pragma unroll 1
  for (int kt = 0; kt < 8; ++kt) {
    asm volatile("s_waitcnt vmcnt(0)" ::: "memory");
    __syncthreads();
    if (kt + 1 < 8) issue(kt + 1);
    const char* As = lds + (kt & 1) * STAGE; const char* Bs = As + 16384;
    mma_stage<4>(As, Bs, acc, wr, wc, fr, fq);
  }
  __syncthreads();
}

template <int NT>
DEVI void acc_to_lds_scaled(const f32x4 (&acc)[4][NT], float* Cs, const float* rsA) {
  constexpr int LDC = NT * 32 + 4;
  const int lane = get_tid() & 63, wid = get_tid() >> 6, wr = wid >> 1, wc = wid & 1, fr = lane & 15, fq = lane >> 4;
#pragma unroll
  for (int m = 0; m < 4; ++m) {
    const f32x4 r4 = *(const f32x4*)(rsA + wr * 64 + m * 16 + fq * 4);
#pragma unroll
    for (int n = 0; n < NT; ++n)
#pragma unroll
      for (int j = 0; j < 4; ++j) Cs[(wr * 64 + m * 16 + fq * 4 + j) * LDC + wc * (NT * 16) + n * 16 + fr] = acc[m][n][j] * r4[j];
  }
  __syncthreads();
}

template <int NT>
DEVI void acc_to_lds(const f32x4 (&acc)[4][NT], float* Cs) {
  constexpr int LDC = NT * 32 + 4;
  const int lane = get_tid() & 63, wid = get_tid() >> 6, wr = wid >> 1, wc = wid & 1, fr = lane & 15, fq = lane >> 4;
#pragma unroll
  for (int m = 0; m < 4; ++m)
#pragma unroll
    for (int n = 0; n < NT; ++n)
#pragma unroll
      for (int j = 0; j < 4; ++j) Cs[(wr * 64 + m * 16 + fq * 4 + j) * LDC + wc * (NT * 16) + n * 16 + fr] = acc[m][n][j];
  __syncthreads();
}

DEVI void conv_weight_tile(const AS4 ConvJob& jb, int local, char* lds) {
  float* tile = (float*)lds;
  const int tid = get_tid();
  const int nkt = jb.K >> 6, nnt = jb.Npad >> 6;
  const int per = nkt * nnt;
  const int bi = local / per; const int rem = local - bi * per;
  const int ktile = rem / nnt, ntile = rem - ktile * nnt;
  const int k0 = ktile * 64, n0 = ntile * 64;
  const float* src = jb.src + (size_t)bi * jb.sstride;
  bf16_t* dst = jb.dst + (size_t)bi * jb.dstride;
  {
    const int c4 = (tid & 15) * 4; const int r0 = tid >> 4;
#pragma unroll
    for (int i = 0; i < 4; ++i) {
      const int k = r0 + 16 * i; const int n = n0 + c4;
      float4 v = make_float4(0.f, 0.f, 0.f, 0.f);
      if (n < jb.N) v = *(const float4*)(src + (size_t)(k0 + k) * jb.N + n);
      if (jb.gain) { const float g = jb.gain[k0 + k]; v.x *= g; v.y *= g; v.z *= g; v.w *= g; }
      tile[k * 65 + c4 + 0] = v.x; tile[k * 65 + c4 + 1] = v.y; tile[k * 65 + c4 + 2] = v.z; tile[k * 65 + c4 + 3] = v.w;
    }
  }
  __syncthreads();
  {
    const int n = tid >> 2, kseg = (tid & 3) * 16;
    unsigned w[8];
#pragma unroll
    for (int i = 0; i < 8; ++i) w[i] = pack2(tile[(kseg + 2 * i) * 65 + n], tile[(kseg + 2 * i + 1) * 65 + n]);
    const int ng = n0 + n;
    int row = ng;
    if (jb.mode == 1) row = (ng >> 6) * 128 + (ng & 63);
    else if (jb.mode == 2) row = (ng >> 6) * 128 + 64 + (ng & 63);
    else if (jb.mode == 3) {
      if (ng >= 928) { const int c = ng - 928; row = 512 + (c >> 6) * 128 + 64 + (c & 63); }
      else if (ng >= 416) { const int c = ng - 416; row = 512 + (c >> 6) * 128 + (c & 63); }
    }
    if (jb.mode != 3 || ng < jb.N) {
      bf16_t* d = dst + (size_t)row * jb.K + k0 + kseg;
      *(u32x4*)(d) = (u32x4){w[0], w[1], w[2], w[3]};
      *(u32x4*)(d + 8) = (u32x4){w[4], w[5], w[6], w[7]};
    }
  }
  __syncthreads();
}

DEVI void conv_weights_phase(PR p, int jbegin, int jend, int ntiles, char* lds) {
  for (int t = blockIdx.x; t < ntiles; t += gridDim.x) {
    int j = jbegin;
    while (j + 1 < jend && p.jobs[j + 1].tile_start <= t) ++j;
    conv_weight_tile(p.jobs[j], t - p.jobs[j].tile_start, lds);
  }
}

DEVI float4 ld4(const float* q) { return *(const float4*)q; }
DEVI float4 ld4(const bf16_t* q) { const u32x2 w = *(const u32x2*)q; return make_float4(bflo(w.x), bfhi(w.x), bflo(w.y), bfhi(w.y)); }
DEVI void st4(float* q, float4 v) { *(float4*)q = v; }
DEVI void st4(bf16_t* q, float4 v) { u32x2 w; w.x = pack2(v.x, v.y); w.y = pack2(v.z, v.w); *(u32x2*)q = w; }

struct f32x8_t { float v[8]; };
DEVI f32x8_t ld8(const float* q) { f32x8_t r; const float4 a = *(const float4*)q, b = *(const float4*)(q + 4); r.v[0] = a.x; r.v[1] = a.y; r.v[2] = a.z; r.v[3] = a.w; r.v[4] = b.x; r.v[5] = b.y; r.v[6] = b.z; r.v[7] = b.w; return r; }
DEVI f32x8_t ld8(const bf16_t* q) { f32x8_t r; const u32x4 w = *(const u32x4*)q;
#pragma unroll
  for (int i = 0; i < 4; ++i) { r.v[2 * i] = bflo(w[i]); r.v[2 * i + 1] = bfhi(w[i]); } return r; }
DEVI u32x4 pack8(const f32x8_t& r) { u32x4 w; w[0] = pack2(r.v[0], r.v[1]); w[1] = pack2(r.v[2], r.v[3]); w[2] = pack2(r.v[4], r.v[5]); w[3] = pack2(r.v[6], r.v[7]); return w; }

template <class SrcT, class DstT>
DEVI void rownorm_phase(const SrcT* __restrict__ src, const bf16_t* __restrict__ y, const float* __restrict__ gain,
                        DstT* dstx, bf16_t* dsth) {
  const int lane = get_tid() & 63;
  const int wave = blockIdx.x * 4 + (get_tid() >> 6), nw = gridDim.x * 4;
  for (int row = wave; row < T_; row += nw) {
    float4 v[4];
#pragma unroll
    for (int i = 0; i < 4; ++i) v[i] = ld4(src + (size_t)row * 1024 + i * 256 + lane * 4);
    if (y) {
#pragma unroll
      for (int s = 0; s < 2; ++s)
#pragma unroll
        for (int i = 0; i < 4; ++i) {
          u32x2 w = *(const u32x2*)(y + (size_t)(row * 2 + s) * 1024 + i * 256 + lane * 4);
          v[i].x += bflo(w.x); v[i].y += bfhi(w.x); v[i].z += bflo(w.y); v[i].w += bfhi(w.y);
        }
    }
    if (dstx) {
#pragma unroll
      for (int i = 0; i < 4; ++i) st4(dstx + (size_t)row * 1024 + i * 256 + lane * 4, v[i]);
    }
    if (dsth) {
      float ss = 0.f;
#pragma unroll
      for (int i = 0; i < 4; ++i) ss += v[i].x * v[i].x + v[i].y * v[i].y + v[i].z * v[i].z + v[i].w * v[i].w;
      ss = wave_sum(ss);
      const float r = 1.0f / sqrtf(ss * (1.0f / 1024.0f) + 1e-6f);
#pragma unroll
      for (int i = 0; i < 4; ++i) {
        const float4 g = *(const float4*)(gain + i * 256 + lane * 4);
        u32x2 w; w.x = pack2(v[i].x * r * g.x, v[i].y * r * g.y); w.y = pack2(v[i].z * r * g.z, v[i].w * r * g.w);
        *(u32x2*)(dsth + (size_t)row * 1024 + i * 256 + lane * 4) = w;
      }
    }
  }
}

DEVI void xcopy_phase(PR p) {
  const int lane = get_tid() & 63;
  const int wave = blockIdx.x * 4 + (get_tid() >> 6), nw = gridDim.x * 4;
  for (int row = wave; row < T_; row += nw) {
    f32x8_t v[2];
#pragma unroll
    for (int i = 0; i < 2; ++i) v[i] = ld8(p.x + (size_t)row * 1024 + i * 512 + lane * 8);
    float ss = 0.f;
#pragma unroll
    for (int i = 0; i < 2; ++i) {
#pragma unroll
      for (int c = 0; c < 8; ++c) ss += v[i].v[c] * v[i].v[c];
      *(u32x4*)(p.xb + (size_t)row * 1024 + i * 512 + lane * 8) = pack8(v[i]);
    }
    ss = wave_sum(ss);
    if (lane == 0) p.rs0[row] = 1.0f / sqrtf(ss * (1.0f / 1024.0f) + 1e-6f);
  }
}

DEVI void gemm_bf16out_phase(const bf16_t* A, int lda, const bf16_t* Bt, int K, int ncolt, bf16_t* out, int ldo, int nvalid, const float* rs, float* ssq, bf16_t* glu, char* lds) {
  float* Cs = (float*)lds;
  float* rsA = (float*)(lds + 72704);
  XcdIter xi; xi.init();
  const int gsz = (ncolt > 8) ? 6 : ncolt, ngrp = ncolt / gsz;
  for (int n = xi.lb; n < 32 * ncolt; n += xi.nlb) {
    const int grp = n / (32 * gsz), rem = n - grp * (32 * gsz);
    const int rl = rem / gsz, jn = grp * gsz + (rem - rl * gsz);
    const int rt = xi.xcd * 32 + rl;
    f32x4 acc[4][4];
    const bf16_t* Ab = A + (size_t)rt * 128 * lda;
    if (get_tid() < 128) rsA[get_tid()] = rs[rt * 128 + get_tid()];
    gemm_mainloop<4>(acc, [&](int r) { return Ab + (size_t)r * lda; }, Bt + (size_t)jn * 128 * K, K, K, lds);
    acc_to_lds_scaled<4>(acc, Cs, rsA);
    const int c8 = get_tid() & 15, r0 = get_tid() >> 4;
    const int col = jn * 128 + c8 * 8;
    if (jn >= 4) {
      const int g8 = get_tid() & 7, rq = get_tid() >> 3;
#pragma unroll
      for (int i = 0; i < 4; ++i) {
        const int row = rq + 32 * i;
        const float* cp = Cs + row * 132 + g8 * 8;
        const f32x4 a0 = *(const f32x4*)cp, a1 = *(const f32x4*)(cp + 4), g0 = *(const f32x4*)(cp + 64), g1 = *(const f32x4*)(cp + 68);
        u32x4 w;
        w[0] = pack2(a0[0] * sigmoidf_(g0[0]), a0[1] * sigmoidf_(g0[1])); w[1] = pack2(a0[2] * sigmoidf_(g0[2]), a0[3] * sigmoidf_(g0[3]));
        w[2] = pack2(a1[0] * sigmoidf_(g1[0]), a1[1] * sigmoidf_(g1[1])); w[3] = pack2(a1[2] * sigmoidf_(g1[2]), a1[3] * sigmoidf_(g1[3]));
        __builtin_nontemporal_store(w, (u32x4*)(glu + (size_t)(rt * 128 + row) * 512 + (jn - 4) * 64 + g8 * 8));
      }
    } else if (col < nvalid) {
#pragma unroll
      for (int i = 0; i < 8; ++i) {
        const int row = r0 + 16 * i;
        const f32x4 v0 = *(const f32x4*)(Cs + row * 132 + c8 * 8), v1 = *(const f32x4*)(Cs + row * 132 + c8 * 8 + 4);
        u32x4 w; w[0] = pack2(v0[0], v0[1]); w[1] = pack2(v0[2], v0[3]); w[2] = pack2(v1[0], v1[1]); w[3] = pack2(v1[2], v1[3]);
        __builtin_nontemporal_store(w, (u32x4*)(out + (size_t)(rt * 128 + row) * ldo + col));
        if (jn < 3) {
          float sq = 0.f;
#pragma unroll
          for (int c = 0; c < 4; ++c) { const float q0 = bflo(w[c]), q1 = bfhi(w[c]); sq += q0 * q0 + q1 * q1; }
          sq += __shfl_xor(sq, 1); sq += __shfl_xor(sq, 2); sq += __shfl_xor(sq, 4); sq += __shfl_xor(sq, 8);
          if (c8 == 0) ssq[(size_t)(rt * 128 + row) * 4 + jn] = sq;
        }
      }
    }
    __syncthreads();
  }
}

template <class BaseT>
DEVI void gemm_resid_phase(const bf16_t* A, const bf16_t* Bt, const BaseT* base, bf16_t* xr, char* lds) {
  float* Cs = (float*)lds;
  XcdIter xi; xi.init();
  for (int n = xi.lb; n < 32 * 8; n += xi.nlb) {
    const int rt = xi.xcd * 32 + (n >> 3), jn = n & 7;
    f32x4 acc[4][4];
    const bf16_t* Ab = A + (size_t)rt * 128 * 1024;
    gemm_mainloop<4>(acc, [&](int r) { return Ab + (size_t)r * 1024; }, Bt + (size_t)jn * 128 * 1024, 1024, 1024, lds);
    const int c8 = get_tid() & 15, r0 = get_tid() >> 4;
    const int col = jn * 128 + c8 * 8;
    f32x8_t bres[8];
#pragma unroll
    for (int i = 0; i < 8; ++i) bres[i] = ld8(base + (size_t)(rt * 128 + r0 + 16 * i) * 1024 + col);
    acc_to_lds<4>(acc, Cs);
#pragma unroll
    for (int i = 0; i < 8; ++i) {
      const int row = r0 + 16 * i;
      const f32x4 v0 = *(const f32x4*)(Cs + row * 132 + c8 * 8), v1 = *(const f32x4*)(Cs + row * 132 + c8 * 8 + 4);
      f32x8_t r = bres[i];
#pragma unroll
      for (int c = 0; c < 4; ++c) { r.v[c] += v0[c]; r.v[4 + c] += v1[c]; }
      __builtin_nontemporal_store(pack8(r), (u32x4*)(xr + (size_t)(rt * 128 + row) * 1024 + col));
    }
    __syncthreads();
  }
}

template <int KW>
DEVI void row_rms_scale(const bf16_t* Ab, int lda, float* rsA) {
  const int row = get_tid() >> 1, half = get_tid() & 1;
  const bf16_t* q = Ab + (size_t)row * lda + half * (KW / 2);
  float ss = 0.f;
#pragma unroll
  for (int i = 0; i < KW / 16; ++i) {
    const u32x4 w = *(const u32x4*)(q + i * 8);
#pragma unroll
    for (int e = 0; e < 4; ++e) { const float a = bflo(w[e]), b = bfhi(w[e]); ss += a * a + b * b; }
  }
  ss += __shfl_xor(ss, 1);
  if (half == 0) rsA[row] = 1.0f / sqrtf(ss * (1.0f / KW) + 1e-6f);
}

DEVI void qup_tile(PR p, int rt, int h, char* lds) {
  float* Cs = (float*)lds;
  float* rsA = (float*)(lds + 72704);
  const bf16_t* Ab = p.proj0 + (size_t)rt * 128 * PROJ_LD;
  if (get_tid() < 128) { const float* q = p.ssq + (size_t)(rt * 128 + get_tid()) * 4; rsA[get_tid()] = 1.0f / sqrtf((q[0] + q[1]) * (1.0f / 256.0f) + 1e-6f); }
  const int row = get_tid() >> 1, half = get_tid() & 1;
  const int t = rt * 128 + row, b = t >> 11, s = t & 2047;
  const int pos_t = p.pos[t];
  f32x4 acc[4][3];
  gemm_mainloop<3>(acc, [&](int r) { return Ab + (size_t)r * PROJ_LD; }, p.Wuqt + (size_t)h * 96 * 256, 256, 256, lds);
  acc_to_lds<3>(acc, Cs);
  const float rq = rsA[row];
  float v[48];
#pragma unroll
  for (int i = 0; i < 12; ++i) {
    const f32x4 c = *(const f32x4*)(Cs + row * 100 + half * 48 + i * 4);
    v[4 * i] = c[0] * rq; v[4 * i + 1] = c[1] * rq; v[4 * i + 2] = c[2] * rq; v[4 * i + 3] = c[3] * rq;
  }
  float ss = 0.f;
#pragma unroll
  for (int i = 0; i < 48; ++i) ss += v[i] * v[i];
  ss += __shfl_xor(ss, 1);
  const float rn = 1.0f / sqrtf(ss * (1.0f / 96.0f) + 1e-6f);
  const float osc = 0.10206207261596575f * LOG2E;
#pragma unroll
  for (int i = 0; i < 48; ++i) v[i] = v[i] * rn * p.mla_q_norm[half * 48 + i];
  if (half == 1) {
    const float fpos = (float)pos_t;
#pragma unroll
    for (int i = 0; i < 16; ++i) {
      float sn, cs; sincos_rev(fpos * p.inv_freq[i], sn, cs);
      const float x1 = v[16 + i], x2 = v[32 + i];
      v[16 + i] = x1 * cs - x2 * sn; v[32 + i] = x1 * sn + x2 * cs;
    }
  }
  __syncthreads();
  char* Qs = lds;
#pragma unroll
  for (int i = 0; i < 6; ++i) {
    u32x4 w;
    w[0] = pack2(v[8 * i] * osc, v[8 * i + 1] * osc); w[1] = pack2(v[8 * i + 2] * osc, v[8 * i + 3] * osc);
    w[2] = pack2(v[8 * i + 4] * osc, v[8 * i + 5] * osc); w[3] = pack2(v[8 * i + 6] * osc, v[8 * i + 7] * osc);
    *(u32x4*)(Qs + row * 192 + half * 96 + i * 16) = w;
  }
  __syncthreads();
  {
    char* dstb = (char*)(p.Q0 + ((size_t)(((rt * 128) >> 11) * 8 + h) * 2048 + ((rt * 128) & 2047)) * 96);
#pragma unroll
    for (int i = 0; i < 6; ++i) { const int q = get_tid() + 256 * i; *(u32x4*)(dstb + q * 16) = *(const u32x4*)(Qs + q * 16); }
  }
  __syncthreads();
}

DEVI void kvup_tile(PR p, int rt, int h, char* lds) {
  float* Cs = (float*)lds;
  float* rsA = (float*)(lds + 72704);
  const bf16_t* Ab = p.proj0 + (size_t)rt * 128 * PROJ_LD + 256;
  if (get_tid() < 128) rsA[get_tid()] = 1.0f / sqrtf(p.ssq[(size_t)(rt * 128 + get_tid()) * 4 + 2] * (1.0f / 128.0f) + 1e-6f);
  const int row = get_tid() >> 1, half = get_tid() & 1;
  const int t = rt * 128 + row, b = t >> 11, s = t & 2047;
  const int pos_t = p.pos[t];
  u32x4 krw[2];
  {
    const bf16_t* rp = p.proj0 + (size_t)t * PROJ_LD + 384;
    krw[0] = *(const u32x4*)(rp + 8 * half); krw[1] = *(const u32x4*)(rp + 16 + 8 * half);
  }
  f32x4 acc[4][4];
  gemm_mainloop<4>(acc, [&](int r) { return Ab + (size_t)r * PROJ_LD; }, p.Wukvt + (size_t)h * 128 * 128, 128, 128, lds);
  acc_to_lds<4>(acc, Cs);
  const float rkv = rsA[row];
  u32x4 wk[6];
  {
    float x1[8], x2[8];
#pragma unroll
    for (int e = 0; e < 4; ++e) {
      x1[2 * e] = bflo(krw[0][e]); x1[2 * e + 1] = bfhi(krw[0][e]);
      x2[2 * e] = bflo(krw[1][e]); x2[2 * e + 1] = bfhi(krw[1][e]);
    }
    float ss = 0.f;
#pragma unroll
    for (int i = 0; i < 8; ++i) ss += x1[i] * x1[i] + x2[i] * x2[i];
    const float* crow = Cs + row * 132 + half * 32;
#pragma unroll
    for (int i = 0; i < 8; ++i) {
      const f32x4 c = *(const f32x4*)(crow + i * 4);
#pragma unroll
      for (int e = 0; e < 4; ++e) { const float a = c[e] * rkv; ss += a * a; }
    }
    ss += __shfl_xor(ss, 1);
    const float rn = 1.0f / sqrtf(ss * (1.0f / 96.0f) + 1e-6f);
    const float f = rkv * rn;
#pragma unroll
    for (int i = 0; i < 4; ++i) {
      const f32x4 c0 = *(const f32x4*)(crow + i * 8);
      const f32x4 c1 = *(const f32x4*)(crow + i * 8 + 4);
      const float4 g0 = *(const float4*)(p.mla_k_norm + half * 32 + i * 8);
      const float4 g1 = *(const float4*)(p.mla_k_norm + half * 32 + i * 8 + 4);
      u32x4 w;
      w[0] = pack2(c0[0] * f * g0.x, c0[1] * f * g0.y); w[1] = pack2(c0[2] * f * g0.z, c0[3] * f * g0.w);
      w[2] = pack2(c1[0] * f * g1.x, c1[1] * f * g1.y); w[3] = pack2(c1[2] * f * g1.z, c1[3] * f * g1.w);
      wk[i] = w;
    }
    const float fpos = (float)pos_t;
#pragma unroll
    for (int i = 0; i < 8; ++i) {
      const float fr_ = half ? p.inv_freq[8 + i] : p.inv_freq[i];
      float sn, cs; sincos_rev(fpos * fr_, sn, cs);
      const float a1 = x1[i] * rn * p.mla_k_norm[64 + 8 * half + i], a2 = x2[i] * rn * p.mla_k_norm[80 + 8 * half + i];
      x1[i] = a1 * cs - a2 * sn; x2[i] = a1 * sn + a2 * cs;
    }
    wk[4] = (u32x4){pack2(x1[0], x1[1]), pack2(x1[2], x1[3]), pack2(x1[4], x1[5]), pack2(x1[6], x1[7])};
    wk[5] = (u32x4){pack2(x2[0], x2[1]), pack2(x2[2], x2[3]), pack2(x2[4], x2[5]), pack2(x2[6], x2[7])};
  }
  {
    const int tc = get_tid() & 15, dq = get_tid() >> 4;
    const int b0 = (rt * 128) >> 11, s0 = (rt * 128) & 2047;
    float rv8[8];
#pragma unroll
    for (int e = 0; e < 8; ++e) rv8[e] = rsA[tc * 8 + e];
#pragma unroll
    for (int i = 0; i < 4; ++i) {
      const int dv = dq + 16 * i;
      float vv[8];
#pragma unroll
      for (int e = 0; e < 8; ++e) vv[e] = Cs[(tc * 8 + e) * 132 + 64 + dv] * rv8[e];
      u32x4 w; w[0] = pack2(vv[0], vv[1]); w[1] = pack2(vv[2], vv[3]); w[2] = pack2(vv[4], vv[5]); w[3] = pack2(vv[6], vv[7]);
      *(u32x4*)(p.V0t + ((size_t)(b0 * 8 + h) * 64 + dv) * 2048 + s0 + tc * 8) = w;
    }
  }
  __syncthreads();
  char* Ksg = lds;
#pragma unroll
  for (int i = 0; i < 4; ++i) *(u32x4*)(Ksg + row * 192 + (4 * half + i) * 16) = wk[i];
  *(u32x4*)(Ksg + row * 192 + (8 + half) * 16) = wk[4];
  *(u32x4*)(Ksg + row * 192 + (10 + half) * 16) = wk[5];
  __syncthreads();
  {
    char* dstb = (char*)(p.K0 + ((size_t)(((rt * 128) >> 11) * 8 + h) * 2048 + ((rt * 128) & 2047)) * 96);
#pragma unroll
    for (int i = 0; i < 6; ++i) { const int q = get_tid() + 256 * i; *(u32x4*)(dstb + q * 16) = *(const u32x4*)(Ksg + q * 16); }
  }
  __syncthreads();
}

DEVI void conv_tile(PR p, int tile, char* lds) {
  const int tid = get_tid(), lane = tid & 63, wid = tid >> 6;
  const int b = tile >> 6, t0 = (tile & 63) * 32;
  unsigned* glu = (unsigned*)lds;
#pragma unroll
  for (int k = 0; k < 16; ++k) {
    const int i = wid + 4 * k;
    if (i < 62) {
      const int tt = t0 - 30 + i;
      char* dstl = lds + i * 1024 + lane * 16;
      if (tt >= 0) __builtin_amdgcn_global_load_lds((const unsigned*)(p.gluB + (size_t)(b * 2048 + tt) * 512 + lane * 8), (unsigned*)dstl, 16, 0, 0);
      else *(u32x4*)dstl = (u32x4){0u, 0u, 0u, 0u};
    }
  }
  asm volatile("s_waitcnt vmcnt(0)" ::: "memory");
  __syncthreads();
  float y0[32], y1[32];
  {
    const float2 bb = *(const float2*)(p.conv_dw_b + 2 * tid);
#pragma unroll
    for (int t = 0; t < 32; ++t) { y0[t] = bb.x; y1[t] = bb.y; }
  }
  {
    float2 w[31];
#pragma unroll
    for (int j = 0; j < 31; ++j) w[j] = *(const float2*)(p.conv_dw_w + j * 512 + 2 * tid);
#pragma unroll
    for (int i = 0; i < 62; ++i) {
      const unsigned g2 = glu[i * 256 + tid];
      const float lo = bflo(g2), hi = bfhi(g2);
#pragma unroll
      for (int t = (i > 30 ? i - 30 : 0); t <= (i < 31 ? i : 31); ++t) { y0[t] += w[i - t].x * lo; y1[t] += w[i - t].y * hi; }
    }
  }
  __syncthreads();
  float* ys = (float*)lds;
#pragma unroll
  for (int t = 0; t < 32; ++t) *(float2*)(ys + t * 516 + 2 * tid) = make_float2(y0[t], y1[t]);
  __syncthreads();
  const float4 g0 = *(const float4*)(p.conv_ln_g + lane * 8), g1 = *(const float4*)(p.conv_ln_g + lane * 8 + 4);
  const float4 b0 = *(const float4*)(p.conv_ln_b + lane * 8), b1 = *(const float4*)(p.conv_ln_b + lane * 8 + 4);
  const float gg[8] = {g0.x, g0.y, g0.z, g0.w, g1.x, g1.y, g1.z, g1.w};
  const float bb[8] = {b0.x, b0.y, b0.z, b0.w, b1.x, b1.y, b1.z, b1.w};
  asm volatile("s_waitcnt vmcnt(0)" ::: "memory");
  for (int k = 0; k < 8; ++k) {
    const int tl = wid * 8 + k;
    const f32x4 a0 = *(const f32x4*)(ys + tl * 516 + lane * 8);
    const f32x4 a1 = *(const f32x4*)(ys + tl * 516 + lane * 8 + 4);
    float v[8] = {a0[0], a0[1], a0[2], a0[3], a1[0], a1[1], a1[2], a1[3]};
    float sm = 0.f;
#pragma unroll
    for (int e = 0; e < 8; ++e) sm += v[e];
    const float mu = wave_sum(sm) * (1.0f / 512.0f);
    float sq = 0.f;
#pragma unroll
    for (int e = 0; e < 8; ++e) { v[e] -= mu; sq += v[e] * v[e]; }
    const float rstd = 1.0f / sqrtf(wave_sum(sq) * (1.0f / 512.0f) + 1e-5f);
    float o[8];
#pragma unroll
    for (int e = 0; e < 8; ++e) { const float z = v[e] * rstd * gg[e] + bb[e]; o[e] = z * sigmoidf_(z); }
    u32x4 w; w[0] = pack2(o[0], o[1]); w[1] = pack2(o[2], o[3]); w[2] = pack2(o[4], o[5]); w[3] = pack2(o[6], o[7]);
    *(u32x4*)(p.hn + (size_t)(b * 2048 + t0 + tl) * 1024 + 512 + lane * 8) = w;
  }
  __syncthreads();
}

DEVI void l0_phase2(PR p, char* lds) {
  XcdIter xi; xi.init();
  for (int n = xi.lb; n < 640; n += xi.nlb) {
    if (n < 256) qup_tile(p, xi.xcd * 32 + (n >> 3), n & 7, lds);
    else if (n < 512) kvup_tile(p, xi.xcd * 32 + ((n - 256) >> 3), (n - 256) & 7, lds);
    else conv_tile(p, xi.xcd * 128 + (n - 512), lds);
  }
}

template <int NKS, int KSTR>
DEVI void qk_tile(const char* Ks, const bf16x8 (&qf)[2][NKS], f32x4 (&s)[4][2], int fr, int fq) {
#pragma unroll
  for (int kt = 0; kt < 4; ++kt) {
    s[kt][0] = (f32x4){0.f, 0.f, 0.f, 0.f}; s[kt][1] = (f32x4){0.f, 0.f, 0.f, 0.f};
#pragma unroll
    for (int ks = 0; ks < NKS; ++ks) {
      const bf16x8 a = *(const bf16x8*)(Ks + (kt * 16 + fr) * KSTR + ks * 64 + fq * 16);
      s[kt][0] = __builtin_amdgcn_mfma_f32_16x16x32_bf16(a, qf[0][ks], s[kt][0], 0, 0, 0);
      s[kt][1] = __builtin_amdgcn_mfma_f32_16x16x32_bf16(a, qf[1][ks], s[kt][1], 0, 0, 0);
    }
  }
}
template <int VSTR>
DEVI void pv_tile(const char* Vs, const f32x4 (&pr)[4][2], f32x4 (&o)[4][2], int fr, int fq) {
#pragma unroll
  for (int u = 0; u < 2; ++u) {
    bf16x8 bfr[2];
#pragma unroll
    for (int qt = 0; qt < 2; ++qt) {
      u32x4 w;
      w[0] = pack2(pr[2 * u][qt][0], pr[2 * u][qt][1]); w[1] = pack2(pr[2 * u][qt][2], pr[2 * u][qt][3]);
      w[2] = pack2(pr[2 * u + 1][qt][0], pr[2 * u + 1][qt][1]); w[3] = pack2(pr[2 * u + 1][qt][2], pr[2 * u + 1][qt][3]);
      bfr[qt] = __builtin_bit_cast(bf16x8, w);
    }
#pragma unroll
    for (int dt = 0; dt < 4; ++dt) {
      const char* vp = Vs + (dt * 16 + fr) * VSTR + (32 * u + 4 * fq) * 2;
      const u32x2 lo = *(const u32x2*)(vp);
      const u32x2 hi = *(const u32x2*)(vp + 32);
      const u32x4 aw = (u32x4){lo[0], lo[1], hi[0], hi[1]};
      const bf16x8 a = __builtin_bit_cast(bf16x8, aw);
      o[dt][0] = __builtin_amdgcn_mfma_f32_16x16x32_bf16(a, bfr[0], o[dt][0], 0, 0, 0);
      o[dt][1] = __builtin_amdgcn_mfma_f32_16x16x32_bf16(a, bfr[1], o[dt][1], 0, 0, 0);
    }
  }
}
DEVI void softmax_update(f32x4 (&s)[4][2], float (&m)[2], float (&l)[2], f32x4 (&o)[4][2]) {
#pragma unroll
  for (int qt = 0; qt < 2; ++qt) {
    float mx = NEGBIG;
#pragma unroll
    for (int kt = 0; kt < 4; ++kt)
#pragma unroll
      for (int j = 0; j < 4; ++j) mx = fmaxf(mx, s[kt][qt][j]);
    mx = fmaxf(mx, __shfl_xor(mx, 16)); mx = fmaxf(mx, __shfl_xor(mx, 32));
    const float mn = fmaxf(m[qt], mx);
    const float alpha = fast_exp2(m[qt] - mn);
    m[qt] = mn;
    const float mnc = fmaxf(mn, -1e29f);
    float rsum = 0.f;
#pragma unroll
    for (int kt = 0; kt < 4; ++kt)
#pragma unroll
      for (int j = 0; j < 4; ++j) {
        const float pv = fast_exp2(s[kt][qt][j] - mnc);
        s[kt][qt][j] = pv; rsum += pv;
      }
    l[qt] = l[qt] * alpha + rsum;
#pragma unroll
    for (int dt = 0; dt < 4; ++dt) { o[dt][qt][0] *= alpha; o[dt][qt][1] *= alpha; o[dt][qt][2] *= alpha; o[dt][qt][3] *= alpha; }
  }
}

DEVI void exp_accum(f32x4 (&s)[4][2], float (&l)[2]) {
#pragma unroll
  for (int qt = 0; qt < 2; ++qt) {
    float rsum = 0.f;
#pragma unroll
    for (int kt = 0; kt < 4; ++kt)
#pragma unroll
      for (int j = 0; j < 4; ++j) { const float pv = fast_exp2(s[kt][qt][j]); s[kt][qt][j] = pv; rsum += pv; }
    l[qt] += rsum;
  }
}

DEVI unsigned bf_hi_bits(float v) { return pack2(v, 0.f) & 0xffffu; }
DEVI float bf_round(float v) { return __uint_as_float(bf_hi_bits(v) << 16); }
template <int NKS, int KSTR>
DEVI void qk_tile_aug(const char* Ks, const char* Kaug, const bf16x8 (&qf)[2][NKS], const bf16x8 (&qa)[2], f32x4 (&s)[4][2], int fr, int fq) {
#pragma unroll
  for (int kt = 0; kt < 4; ++kt) {
    s[kt][0] = (f32x4){0.f, 0.f, 0.f, 0.f}; s[kt][1] = (f32x4){0.f, 0.f, 0.f, 0.f};
#pragma unroll
    for (int ks = 0; ks < NKS; ++ks) {
      const bf16x8 a = *(const bf16x8*)(Ks + (kt * 16 + fr) * KSTR + ks * 64 + fq * 16);
      s[kt][0] = __builtin_amdgcn_mfma_f32_16x16x32_bf16(a, qf[0][ks], s[kt][0], 0, 0, 0);
      s[kt][1] = __builtin_amdgcn_mfma_f32_16x16x32_bf16(a, qf[1][ks], s[kt][1], 0, 0, 0);
    }
    const u32x4 aw = *(const u32x4*)(Kaug + (kt * 16 + fr) * 64 + fq * 16);
    const bf16x8 a = __builtin_bit_cast(bf16x8, aw);
    s[kt][0] = __builtin_amdgcn_mfma_f32_16x16x32_bf16(a, qa[0], s[kt][0], 0, 0, 0);
    s[kt][1] = __builtin_amdgcn_mfma_f32_16x16x32_bf16(a, qa[1], s[kt][1], 0, 0, 0);
  }
}
DEVI bf16x8 make_qaug(float slope2, float colc, int fq) {
  const float sh = bf_round(slope2), sl = slope2 - sh;
  const float c1 = bf_round(colc), r1 = colc - c1, c2 = bf_round(r1), c3 = r1 - c2;
  u32x4 w;
  w[0] = pack2(sh, sh); w[1] = pack2(sl, sl); w[2] = pack2(c1, c2); w[3] = pack2(c3, 0.f);
  if (fq != 0) w = (u32x4){0u, 0u, 0u, 0u};
  return __builtin_bit_cast(bf16x8, w);
}
DEVI u32x4 make_kaug(float v) {
  const float ph = bf_round(v), pl = v - ph;
  u32x4 w; w[0] = pack2(ph, pl); w[1] = pack2(ph, pl); w[2] = 0x3f803f80u; w[3] = 0x00003f80u;
  return w;
}
DEVI void exp_tile(f32x4 (&s)[4][2]) {
#pragma unroll
  for (int kt = 0; kt < 4; ++kt)
#pragma unroll
    for (int qt = 0; qt < 2; ++qt)
#pragma unroll
      for (int j = 0; j < 4; ++j) s[kt][qt][j] = fast_exp2(s[kt][qt][j]);
}
template <int VSTR>
DEVI void pv_tile_l(const char* Vs, const f32x4 (&pr)[4][2], f32x4 (&o)[4][2], f32x4 (&ol)[2], int fr, int fq) {
  const u32x4 onesw = (u32x4){0x3f803f80u, 0x3f803f80u, 0x3f803f80u, 0x3f803f80u};
  const bf16x8 ones = __builtin_bit_cast(bf16x8, onesw);
#pragma unroll
  for (int u = 0; u < 2; ++u) {
    bf16x8 bfr[2];
#pragma unroll
    for (int qt = 0; qt < 2; ++qt) {
      u32x4 w;
      w[0] = pack2(pr[2 * u][qt][0], pr[2 * u][qt][1]); w[1] = pack2(pr[2 * u][qt][2], pr[2 * u][qt][3]);
      w[2] = pack2(pr[2 * u + 1][qt][0], pr[2 * u + 1][qt][1]); w[3] = pack2(pr[2 * u + 1][qt][2], pr[2 * u + 1][qt][3]);
      bfr[qt] = __builtin_bit_cast(bf16x8, w);
    }
#pragma unroll
    for (int dt = 0; dt < 4; ++dt) {
      const char* vp = Vs + (dt * 16 + fr) * VSTR + (32 * u + 4 * fq) * 2;
      const u32x2 lo = *(const u32x2*)(vp);
      const u32x2 hi = *(const u32x2*)(vp + 32);
      const u32x4 aw = (u32x4){lo[0], lo[1], hi[0], hi[1]};
      const bf16x8 a = __builtin_bit_cast(bf16x8, aw);
      o[dt][0] = __builtin_amdgcn_mfma_f32_16x16x32_bf16(a, bfr[0], o[dt][0], 0, 0, 0);
      o[dt][1] = __builtin_amdgcn_mfma_f32_16x16x32_bf16(a, bfr[1], o[dt][1], 0, 0, 0);
    }
    ol[0] = __builtin_amdgcn_mfma_f32_16x16x32_bf16(ones, bfr[0], ol[0], 0, 0, 0);
    ol[1] = __builtin_amdgcn_mfma_f32_16x16x32_bf16(ones, bfr[1], ol[1], 0, 0, 0);
  }
}

DEVI float head8_sum(float v) {
  v += __builtin_bit_cast(float, __builtin_amdgcn_update_dpp(0, __builtin_bit_cast(int, v), 0xB1, 0xF, 0xF, true));
  v += __builtin_bit_cast(float, __builtin_amdgcn_update_dpp(0, __builtin_bit_cast(int, v), 0x4E, 0xF, 0xF, true));
  v += __builtin_bit_cast(float, __builtin_amdgcn_update_dpp(0, __builtin_bit_cast(int, v), 0x141, 0xF, 0xF, true));
  return v;
}

DEVI void rowsum_tile(const f32x4 (&pr)[4][2], f32x4 (&ol)[2]) {
  const u32x4 onesw = (u32x4){0x3f803f80u, 0x3f803f80u, 0x3f803f80u, 0x3f803f80u};
  const bf16x8 ones = __builtin_bit_cast(bf16x8, onesw);
#pragma unroll
  for (int u = 0; u < 2; ++u)
#pragma unroll
    for (int qt = 0; qt < 2; ++qt) {
      u32x4 w;
      w[0] = pack2(pr[2 * u][qt][0], pr[2 * u][qt][1]); w[1] = pack2(pr[2 * u][qt][2], pr[2 * u][qt][3]);
      w[2] = pack2(pr[2 * u + 1][qt][0], pr[2 * u + 1][qt][1]); w[3] = pack2(pr[2 * u + 1][qt][2], pr[2 * u + 1][qt][3]);
      ol[qt] = __builtin_amdgcn_mfma_f32_16x16x32_bf16(ones, __builtin_bit_cast(bf16x8, w), ol[qt], 0, 0, 0);
    }
}

DEVI void mla_attn_phase(PR p, char* lds) {
  constexpr int KSTR = 208, VSTR = 144;
  const int tid = get_tid(), lane = tid & 63, wid = tid >> 6, fr = lane & 15, fq = lane >> 4;
  XcdIter xi; xi.init();
  for (int n = xi.lb; n < 256; n += xi.nlb) {
    __syncthreads();
    const int r = n >> 6, li = n & 63, jq = li & 15;
    const int bh = xi.xcd * 16 + r * 4 + (li >> 4);
    const int j8 = (jq + 8) & 15;
    const int qt128 = (r == 0) ? jq : (r == 1) ? 15 - jq : (r == 2) ? j8 : 15 - j8;
    const int q0 = qt128 * 128 + wid * 32;
    const bf16_t* Qb = p.Q0 + (size_t)bh * 2048 * 96;
    const bf16_t* Kb = p.K0 + (size_t)bh * 2048 * 96;
    const bf16_t* Vb = p.V0t + (size_t)bh * 64 * 2048;
    bf16x8 qf[2][3];
#pragma unroll
    for (int qt = 0; qt < 2; ++qt)
#pragma unroll
      for (int ks = 0; ks < 3; ++ks) qf[qt][ks] = *(const bf16x8*)(Qb + (size_t)(q0 + 16 * qt + fr) * 96 + ks * 32 + fq * 8);
    f32x4 o[4][2]; f32x4 ol[2];
    ol[0] = (f32x4){0.f, 0.f, 0.f, 0.f}; ol[1] = (f32x4){0.f, 0.f, 0.f, 0.f};
#pragma unroll
    for (int dt = 0; dt < 4; ++dt) { o[dt][0] = (f32x4){0.f, 0.f, 0.f, 0.f}; o[dt][1] = (f32x4){0.f, 0.f, 0.f, 0.f}; }
    const int nkt = 2 * (qt128 + 1);
    u32x4 rk[3], rv[2];
    const int kr0 = tid / 12, kc0 = tid - kr0 * 12;
    const int kr1 = (tid + 256) / 12, kc1 = (tid + 256) - kr1 * 12;
    const int kr2 = (tid + 512) / 12, kc2 = (tid + 512) - kr2 * 12;
    const int vr0 = tid >> 3, vc0 = tid & 7;
    auto fetch = [&](int key0) {
      rk[0] = *(const u32x4*)(Kb + (size_t)(key0 + kr0) * 96 + kc0 * 8);
      rk[1] = *(const u32x4*)(Kb + (size_t)(key0 + kr1) * 96 + kc1 * 8);
      rk[2] = *(const u32x4*)(Kb + (size_t)(key0 + kr2) * 96 + kc2 * 8);
      rv[0] = *(const u32x4*)(Vb + (size_t)vr0 * 2048 + key0 + vc0 * 8);
      rv[1] = *(const u32x4*)(Vb + (size_t)(vr0 + 32) * 2048 + key0 + vc0 * 8);
    };
    fetch(0);
    for (int kt64 = 0; kt64 < nkt; ++kt64) {
      const int key0 = kt64 * 64;
      char* Kc = lds + (kt64 & 1) * 22528; char* Vc = Kc + 64 * KSTR;
      *(u32x4*)(Kc + kr0 * KSTR + kc0 * 16) = rk[0];
      *(u32x4*)(Kc + kr1 * KSTR + kc1 * 16) = rk[1];
      *(u32x4*)(Kc + kr2 * KSTR + kc2 * 16) = rk[2];
      *(u32x4*)(Vc + vr0 * VSTR + vc0 * 16) = rv[0];
      *(u32x4*)(Vc + (vr0 + 32) * VSTR + vc0 * 16) = rv[1];
      __syncthreads();
      if (kt64 + 1 < nkt) fetch(key0 + 64);
      if (key0 <= q0 + 31) {
        f32x4 s[4][2];
        qk_tile<3, KSTR>(Kc, qf, s, fr, fq);
        if (key0 + 63 > q0) {
#pragma unroll
          for (int kt = 0; kt < 4; ++kt)
#pragma unroll
            for (int qt = 0; qt < 2; ++qt)
#pragma unroll
              for (int j = 0; j < 4; ++j) {
                const int key = key0 + 16 * kt + 4 * fq + j, qq = q0 + 16 * qt + fr;
                if (key > qq) s[kt][qt][j] = NEGBIG;
              }
        }
        exp_tile(s);
        pv_tile_l<VSTR>(Vc, s, o, ol, fr, fq);
      }
    }
    const int b = bh >> 3, h = bh & 7;
#pragma unroll
    for (int qt = 0; qt < 2; ++qt) {
      const float inv = 1.0f / ol[qt][0];
      bf16_t* dst = p.hn + (size_t)(b * 2048 + q0 + 16 * qt + fr) * 1024 + h * 64 + 4 * fq;
#pragma unroll
      for (int dt = 0; dt < 4; ++dt) {
        u32x2 w; w[0] = pack2(o[dt][qt][0] * inv, o[dt][qt][1] * inv); w[1] = pack2(o[dt][qt][2] * inv, o[dt][qt][3] * inv);
        *(u32x2*)(dst + dt * 16) = w;
      }
    }
  }
  __syncthreads();
}

DEVI void router_phase(PR p, int layer, char* lds) {
  constexpr int WSTR = 528;
  char* Wh = lds;
  char* Wl = lds + 48 * WSTR;
  float* lg = (float*)(lds + 50688);
  float* ssL = (float*)(lds + 50688 + 12288);
  int* cntL = (int*)(lds + 50688 + 12288 + 256);
  int* baseL = cntL + 32;
  int* cntP = baseL + 32;
  int* baseP = cntP + 112;
  int* gcntP = p.gcntP + layer * 128;
  const int tid = get_tid(), lane = tid & 63, wid = tid >> 6, fr = lane & 15, fq = lane >> 4;
  const bf16_t* gWh = p.RWh + (size_t)layer * 48 * 1024;
  const bf16_t* gWl = p.RWl + (size_t)layer * 48 * 1024;
  int* gcnt = p.gcnt + layer * 32;
  for (int tile = blockIdx.x; tile < T_ / 64; tile += gridDim.x) {
    const int row = tile * 64 + wid * 16 + fr;
    const bf16_t* xrow = p.xr + (size_t)row * 1024;
    f32x4 acc[3]; acc[0] = acc[1] = acc[2] = (f32x4){0.f, 0.f, 0.f, 0.f};
    float ss = 0.f;
    if (tid < 32) cntL[tid] = 0;
    if (tid < 112) cntP[tid] = 0;
    for (int kc = 0; kc < 4; ++kc) {
      u32x4 xq[8];
#pragma unroll
      for (int i = 0; i < 8; ++i) xq[i] = *(const u32x4*)(xrow + kc * 256 + (i >> 1) * 64 + fq * 16 + (i & 1) * 8);
      u32x4 wq[12];
#pragma unroll
      for (int i = 0; i < 6; ++i) {
        const int q = tid + 256 * i; const int n = q >> 5, c = q & 31;
        wq[i] = *(const u32x4*)(gWh + (size_t)n * 1024 + kc * 256 + c * 8);
        wq[6 + i] = *(const u32x4*)(gWl + (size_t)n * 1024 + kc * 256 + c * 8);
      }
      __syncthreads();
#pragma unroll
      for (int i = 0; i < 6; ++i) {
        const int q = tid + 256 * i; const int n = q >> 5, c = q & 31;
        *(u32x4*)(Wh + n * WSTR + c * 16) = wq[i];
        *(u32x4*)(Wl + n * WSTR + c * 16) = wq[6 + i];
      }
      __syncthreads();
#pragma unroll
      for (int s4 = 0; s4 < 4; ++s4) {
#pragma unroll
        for (int m = 0; m < 2; ++m) {
          const u32x4 xw = xq[s4 * 2 + m];
#pragma unroll
          for (int i = 0; i < 4; ++i) { const float a = bflo(xw[i]), b = bfhi(xw[i]); ss += a * a + b * b; }
          const bf16x8 ah = __builtin_bit_cast(bf16x8, xw);
          const int koff = (s4 * 64 + fq * 16 + 8 * m) * 2;
#pragma unroll
          for (int nt = 0; nt < 3; ++nt) {
            const bf16x8 bh = *(const bf16x8*)(Wh + (nt * 16 + fr) * WSTR + koff);
            const bf16x8 bl = *(const bf16x8*)(Wl + (nt * 16 + fr) * WSTR + koff);
            acc[nt] = __builtin_amdgcn_mfma_f32_16x16x32_bf16(ah, bh, acc[nt], 0, 0, 0);
            acc[nt] = __builtin_amdgcn_mfma_f32_16x16x32_bf16(ah, bl, acc[nt], 0, 0, 0);
          }
        }
      }
    }
    ss += __shfl_xor(ss, 16); ss += __shfl_xor(ss, 32);
    if (fq == 0) ssL[wid * 16 + fr] = ss;
#pragma unroll
    for (int nt = 0; nt < 3; ++nt)
#pragma unroll
      for (int j = 0; j < 4; ++j) lg[(wid * 16 + 4 * fq + j) * 48 + nt * 16 + fr] = acc[nt][j];
    __syncthreads();
    int e0 = 0, e1 = 0, rk0 = 0, rk1 = 0; float w0 = 0.f, w1 = 0.f;
    int pidx = 0, rkp = 0; bool swapped = false;
    const int tok = tile * 64 + tid;
    if (tid < 64) {
      const float r = 1.0f / sqrtf(ssL[tid] * (1.0f / 1024.0f) + 1e-6f);
      p.rs[tok] = r;
      const float* L = lg + tid * 48;
      float gl[4];
#pragma unroll
      for (int i = 0; i < 4; ++i) gl[i] = L[i] * r + p.r_group_b[layer * 4 + i];
      int grp = 0; float gm = gl[0];
#pragma unroll
      for (int i = 1; i < 4; ++i) if (gl[i] > gm) { gm = gl[i]; grp = i; }
      float gs = 0.f;
#pragma unroll
      for (int i = 0; i < 4; ++i) gs += expf(gl[i] - gm);
      const float gw = 1.0f / gs;
      float el[8];
#pragma unroll
      for (int i = 0; i < 8; ++i) el[i] = L[4 + grp * 8 + i] * r + p.r_expert_b[layer * 32 + grp * 8 + i];
      int i0 = 0; float v0 = el[0];
#pragma unroll
      for (int i = 1; i < 8; ++i) if (el[i] > v0) { v0 = el[i]; i0 = i; }
      int i1 = (i0 == 0) ? 1 : 0; float v1 = -3e38f;
#pragma unroll
      for (int i = 0; i < 8; ++i) if (i != i0 && el[i] > v1) { v1 = el[i]; i1 = i; }
      const float ex = expf(v1 - v0);
      w0 = gw / (1.0f + ex); w1 = gw * ex / (1.0f + ex);
      e0 = grp * 8 + i0; e1 = grp * 8 + i1;
      rk0 = atomicAdd(&cntL[e0], 1);
      rk1 = atomicAdd(&cntL[e1], 1);
      swapped = i0 > i1;
      const int a = swapped ? i1 : i0, b = swapped ? i0 : i1;
      pidx = grp * 28 + a * 7 - ((a * (a - 1)) >> 1) + (b - a - 1);
      rkp = atomicAdd(&cntP[pidx], 1);
    }
    __syncthreads();
    if (tid < 32) { const int c = cntL[tid]; baseL[tid] = c ? atomicAdd(&gcnt[tid], c) : 0; }
    if (tid < 112) { const int c = cntP[tid]; baseP[tid] = c ? atomicAdd(&gcntP[tid], c) : 0; }
    __syncthreads();
    if (tid < 64) {
      const size_t s0 = (size_t)e0 * T_ + baseL[e0] + rk0, s1 = (size_t)e1 * T_ + baseL[e1] + rk1;
      p.row_tok[s0] = tok * 2;
      p.row_tok[s1] = tok * 2 + 1;
      const float rr = p.rs[tok];
      p.row_aux[s0] = make_float2(w0, rr);
      p.row_aux[s1] = make_float2(w1, rr);
      const int ra = baseL[e0] + rk0, rb = baseL[e1] + rk1;
      const size_t sp = (size_t)pidx * T_ + baseP[pidx] + rkp;
      p.pair_tok[sp] = tok;
      p.pair_rk[sp] = swapped ? make_int2(rb, ra) : make_int2(ra, rb);
    }
    __syncthreads();
  }
}

DEVI void moe_prefix(const int* gcnt, int* preL) {
  __syncthreads();
  if (get_tid() == 0) {
    int a = 0;
    for (int e = 0; e < 32; ++e) { preL[e] = a; a += (gcnt[e] + 127) >> 7; }
    preL[32] = a;
  }
  __syncthreads();
}
DEVI int find_expert(const int* preL, int rt) {
  int e = 0;
  for (int i = 1; i < 32; ++i) if (preL[i] <= rt) e = i;
  return e;
}

DEVI void moe_gateup_phase(PR p, int layer, char* lds) {
  int* preL = (int*)(lds + 72704 + 512);
  const int* gcnt = p.gcnt + layer * 32;
  moe_prefix(gcnt, preL);
  const int nrt = preL[32];
  float* Cs = (float*)lds;
  XcdIter xi; xi.init();
  const int rlo = (nrt * xi.xcd) >> 3, rhi = (nrt * (xi.xcd + 1)) >> 3;
  const int total = (rhi - rlo) * 4, G = xi.nlb;
  const int nfull_rounds = total / G, left = total - nfull_rounds * G;
  const bool split = (left > 0) && (2 * left <= G);
  const int nfull = split ? nfull_rounds * G : total;
  const int row = get_tid() >> 1, half = get_tid() & 1;
  for (int it = xi.lb; it < nfull + (split ? 2 * left : 0); it += G) {
    const bool ishalf = it >= nfull;
    const int item = ishalf ? nfull + ((it - nfull) >> 1) : it;
    const int ch = (it - nfull) & 1;
    const int rt = rlo + (item >> 2), j = item & 3;
    const int e = find_expert(preL, rt);
    const int blk = rt - preL[e];
    const int valid = min(128, gcnt[e] - blk * 128);
    const int* rtk = p.row_tok + (size_t)e * T_ + blk * 128;
    float2 aux = make_float2(0.f, 0.f);
    if (row < valid) aux = p.row_aux[(size_t)e * T_ + blk * 128 + row];
    const float rsc = aux.y, rsu = aux.y * aux.x;
    const bf16_t* Wb = p.Wgut + ((size_t)e * 512 + j * 128) * 1024;
    auto arow = [&](int r) { const int tok = (r < valid) ? (rtk[r] >> 1) : 0; return p.xr + (size_t)tok * 1024; };
    if (!ishalf) {
      f32x4 acc[4][4];
      gemm_mainloop<4>(acc, arow, Wb, 1024, 1024, lds);
      acc_to_lds<4>(acc, Cs);
      if (row < valid) {
        bf16_t* dst = p.hbuf + (size_t)(rt * 128 + row) * 256 + j * 64 + half * 32;
#pragma unroll
        for (int i = 0; i < 4; ++i) {
          float hv[8];
#pragma unroll
          for (int q = 0; q < 2; ++q) {
            const f32x4 g = *(const f32x4*)(Cs + row * 132 + half * 32 + i * 8 + q * 4);
            const f32x4 u = *(const f32x4*)(Cs + row * 132 + 64 + half * 32 + i * 8 + q * 4);
#pragma unroll
            for (int c = 0; c < 4; ++c) { const float gg = g[c] * rsc; hv[q * 4 + c] = gg * sigmoidf_(gg) * (u[c] * rsu); }
          }
          u32x4 w; w[0] = pack2(hv[0], hv[1]); w[1] = pack2(hv[2], hv[3]); w[2] = pack2(hv[4], hv[5]); w[3] = pack2(hv[6], hv[7]);
          *(u32x4*)(dst + i * 8) = w;
        }
      }
    } else {
      f32x4 acc[4][2];
      gemm_mainloop2<2>(acc, arow, [&](int r) { return Wb + (size_t)((r < 32) ? (32 * ch + r) : (64 + 32 * ch + (r - 32))) * 1024; }, 1024, lds);
      acc_to_lds<2>(acc, Cs);
      if (row < valid) {
        bf16_t* dst = p.hbuf + (size_t)(rt * 128 + row) * 256 + j * 64 + ch * 32 + half * 16;
#pragma unroll
        for (int i = 0; i < 2; ++i) {
          float hv[8];
#pragma unroll
          for (int q = 0; q < 2; ++q) {
            const f32x4 g = *(const f32x4*)(Cs + row * 68 + half * 16 + i * 8 + q * 4);
            const f32x4 u = *(const f32x4*)(Cs + row * 68 + 32 + half * 16 + i * 8 + q * 4);
#pragma unroll
            for (int c = 0; c < 4; ++c) { const float gg = g[c] * rsc; hv[q * 4 + c] = gg * sigmoidf_(gg) * (u[c] * rsu); }
          }
          u32x4 w; w[0] = pack2(hv[0], hv[1]); w[1] = pack2(hv[2], hv[3]); w[2] = pack2(hv[4], hv[5]); w[3] = pack2(hv[6], hv[7]);
          *(u32x4*)(dst + i * 8) = w;
        }
      }
    }
    __syncthreads();
  }
}

DEVI void moe_down_phase(PR p, int layer, char* lds) {
  int* preE = (int*)(lds + 72704 + 512);
  int* tabT = (int*)(lds + 67584);
  int* preP = (int*)(lds + 68608);
  unsigned char* tileB = (unsigned char*)(lds + 69120);
  int* cntS = (int*)(lds + 69632);
  int* cntE = (int*)(lds + 70144);
  const int* gcnt = p.gcnt + layer * 32;
  const int* gcntP = p.gcntP + layer * 128;
  const int tid = get_tid();
  __syncthreads();
  if (tid < 112) cntS[tid] = gcntP[tid];
  if (tid < 32) cntE[tid] = gcnt[tid];
  __syncthreads();
  if (tid == 0) {
    int a = 0;
    for (int b = 0; b < 112; ++b) {
      preP[b] = a;
      const int n = (cntS[b] + 127) >> 7;
      for (int i = 0; i < n; ++i) tileB[a + i] = (unsigned char)b;
      a += n;
    }
    preP[112] = a;
  }
  if (tid == 64) {
    int a = 0;
    for (int e = 0; e < 32; ++e) { preE[e] = a; a += (cntE[e] + 127) >> 7; }
    preE[32] = a;
  }
  __syncthreads();
  const int nprt = preP[112];
  float* Cs = (float*)lds;
  XcdIter xi; xi.init();
  const int rlo = (nprt * xi.xcd) >> 3, rhi = (nprt * (xi.xcd + 1)) >> 3;
  const int nit = (rhi - rlo) * 8;
  const int lr = tid >> 3;
#define DOWN_FETCH(IT, R0, R1, R2, R3, TOK) do { \
    const int prt_ = rlo + ((IT) >> 3); const int pb_ = tileB[prt_]; const int blk_ = prt_ - preP[pb_]; \
    const int valid_ = min(128, cntS[pb_] - blk_ * 128); const size_t lb_ = (size_t)pb_ * T_ + blk_ * 128; \
    R0 = R1 = R2 = R3 = make_int2(0, 0); TOK = 0; \
    if (lr < valid_) R0 = p.pair_rk[lb_ + lr]; if (lr + 32 < valid_) R1 = p.pair_rk[lb_ + lr + 32]; \
    if (lr + 64 < valid_) R2 = p.pair_rk[lb_ + lr + 64]; if (lr + 96 < valid_) R3 = p.pair_rk[lb_ + lr + 96]; \
    if (tid < valid_) TOK = p.pair_tok[lb_ + tid]; } while (0)
  int2 rc0, rc1, rc2, rc3; int tokc = 0;
  rc0 = rc1 = rc2 = rc3 = make_int2(0, 0);
  int it = xi.lb;
  if (it < nit) DOWN_FETCH(it, rc0, rc1, rc2, rc3, tokc);
  for (; it < nit; it += xi.nlb) {
    const int prt = rlo + (it >> 3), j = it & 7;
    const int pb = tileB[prt];
    const int blk = prt - preP[pb];
    const int valid = min(128, cntS[pb] - blk * 128);
    const int g = pb / 28; int q = pb - g * 28, a = 0;
    while (q >= 7 - a) { q -= 7 - a; ++a; }
    const int eA = g * 8 + a, eB = eA + 1 + q;
    const int baseA = preE[eA] * 128, baseB = preE[eB] * 128;
    if (tid < 128) tabT[tid] = tokc;
    int2 rn0, rn1, rn2, rn3; int tokn = 0;
    rn0 = rn1 = rn2 = rn3 = make_int2(0, 0);
    if (it + xi.nlb < nit) DOWN_FETCH(it + xi.nlb, rn0, rn1, rn2, rn3, tokn);
    f32x4 acc[4][4];
    gemm_mainloop_pair(acc, [&](int i, const bf16_t*& pa, const bf16_t*& pbp) {
      const bool ok = lr + 32 * i < valid;
      const int2 rk = (i == 0) ? rc0 : (i == 1) ? rc1 : (i == 2) ? rc2 : rc3;
      pa = p.hbuf + (size_t)((ok ? baseA : 0) + rk.x) * 256; pbp = p.hbuf + (size_t)((ok ? baseB : 0) + rk.y) * 256;
    }, p.Wdt + ((size_t)eA * 1024 + j * 128) * 256, p.Wdt + ((size_t)eB * 1024 + j * 128) * 256, lds);
    const int c8 = tid & 15, r0 = tid >> 4;
    const int cA = (layer == 0) ? c8 * 8 : c8 * 4, cB = (layer == 0) ? c8 * 8 + 4 : 64 + c8 * 4;
    f32x8_t bres[8];
#pragma unroll
    for (int i = 0; i < 8; ++i) {
      const bf16_t* bp_ = p.xr + (size_t)tabT[r0 + 16 * i] * 1024 + j * 128;
      if (layer == 0) bres[i] = ld8(bp_ + cA);
      else {
        const u32x2 lo = *(const u32x2*)(bp_ + cA), hi = *(const u32x2*)(bp_ + cB);
        bres[i].v[0] = bflo(lo[0]); bres[i].v[1] = bfhi(lo[0]); bres[i].v[2] = bflo(lo[1]); bres[i].v[3] = bfhi(lo[1]);
        bres[i].v[4] = bflo(hi[0]); bres[i].v[5] = bfhi(hi[0]); bres[i].v[6] = bflo(hi[1]); bres[i].v[7] = bfhi(hi[1]);
      }
    }
    acc_to_lds<4>(acc, Cs);
#pragma unroll
    for (int i = 0; i < 8; ++i) {
      const int row = r0 + 16 * i;
      float sq = 0.f;
      if (row < valid) {
        const size_t o = (size_t)tabT[row] * 1024 + j * 128;
        const f32x4 v0 = *(const f32x4*)(Cs + row * 132 + cA), v1 = *(const f32x4*)(Cs + row * 132 + cB);
        f32x8_t r = bres[i];
#pragma unroll
        for (int c = 0; c < 4; ++c) { r.v[c] += v0[c]; r.v[4 + c] += v1[c]; }
        if (layer == 0) {
          const u32x4 w = pack8(r);
          __builtin_nontemporal_store(w, (u32x4*)(p.xr + o + cA));
#pragma unroll
          for (int c = 0; c < 4; ++c) { const float q0 = bflo(w[c]), q1 = bfhi(w[c]); sq += q0 * q0 + q1 * q1; }
        } else {
          __builtin_nontemporal_store((f32x4){r.v[0], r.v[1], r.v[2], r.v[3]}, (f32x4*)(p.out + o + cA));
          __builtin_nontemporal_store((f32x4){r.v[4], r.v[5], r.v[6], r.v[7]}, (f32x4*)(p.out + o + cB));
        }
      }
      if (layer == 0) {
        sq += __shfl_xor(sq, 1); sq += __shfl_xor(sq, 2); sq += __shfl_xor(sq, 4); sq += __shfl_xor(sq, 8);
        if (c8 == 0 && row < valid) p.ssp[(size_t)tabT[row] * 8 + j] = sq;
      }
    }
    __syncthreads();
    rc0 = rn0; rc1 = rn1; rc2 = rn2; rc3 = rn3;
    tokc = tokn;
  }
}

DEVI void nsa_proj_phase(PR p, char* lds) {
  float* Cs = (float*)lds;
  XcdIter xi; xi.init();
  for (int n = xi.lb; n < 32 * 15; n += xi.nlb) {
    const int grp = n / 160, rem = n - grp * 160;
    const int rl = rem / 5, jn = grp * 5 + (rem - rl * 5);
    const int rt = xi.xcd * 32 + rl;
    f32x4 acc[4][4];
    float* rsA = (float*)(lds + 72704);
    if (get_tid() < 128) {
      const float4* sp = (const float4*)(p.ssp + (size_t)(rt * 128 + get_tid()) * 8);
      const float4 s0 = sp[0], s1 = sp[1];
      const float ss = ((s0.x + s0.y) + (s0.z + s0.w)) + ((s1.x + s1.y) + (s1.z + s1.w));
      rsA[get_tid()] = 1.0f / sqrtf(ss * (1.0f / 1024.0f) + 1e-6f);
    }
    const bf16_t* Ab = p.xr + (size_t)rt * 128 * 1024;
    gemm_mainloop<4>(acc, [&](int r) { return Ab + (size_t)r * 1024; }, p.W5t + (size_t)jn * 128 * 1024, 1024, 1024, lds);
    acc_to_lds_scaled<4>(acc, Cs, rsA);
    const int row = get_tid() >> 1, half = get_tid() & 1;
    const int t = rt * 128 + row, b = t >> 11, s = t & 2047;
    const float* cr = Cs + row * 132 + half * 64;
    if (jn == 14) {
      if (half == 0) {
#pragma unroll
        for (int i = 0; i < 12; ++i) {
          const f32x4 c = *(const f32x4*)(cr + i * 4);
          *(float4*)(p.GATES + (size_t)t * 48 + i * 4) = make_float4(sigmoidf_(c[0]), sigmoidf_(c[1]), sigmoidf_(c[2]), sigmoidf_(c[3]));
        }
      }
    } else if (jn == 11 || jn == 13) {
      const int tc = get_tid() & 15, dq = get_tid() >> 4;
      bf16_t* dstb = (jn == 11 ? p.VSt : p.VWt) + ((size_t)((rt >> 4) * 2) * 64) * 2048 + (rt & 15) * 128 + tc * 8;
#pragma unroll
      for (int i = 0; i < 8; ++i) {
        const int dvg = dq + 16 * i;
        float vv[8];
#pragma unroll
        for (int e = 0; e < 8; ++e) vv[e] = Cs[(tc * 8 + e) * 132 + dvg];
        u32x4 w; w[0] = pack2(vv[0], vv[1]); w[1] = pack2(vv[2], vv[3]); w[2] = pack2(vv[4], vv[5]); w[3] = pack2(vv[6], vv[7]);
        __builtin_nontemporal_store(w, (u32x4*)(dstb + (size_t)dvg * 2048));
      }
    } else {
      const int c = get_tid() & 7, rq = get_tid() >> 3;
#pragma unroll
      for (int hh = 0; hh < 2; ++hh) {
        const float* gn = nullptr; bf16_t* dstb; float osc = 1.0f;
        if (jn < 8) { gn = p.nsa_q_norm; dstb = p.Q1 + ((size_t)((rt >> 4) * 16 + jn * 2 + hh) * 2048 + (rt & 15) * 128) * 64; osc = 0.125f * LOG2E; }
        else {
          bf16_t* base = (jn == 8) ? p.KC : (jn == 9) ? p.VC : (jn == 10) ? p.KS : p.KW;
          if (jn == 10) gn = p.nsa_k_norm_slc; else if (jn == 12) gn = p.nsa_k_norm_win;
          dstb = base + ((size_t)((rt >> 4) * 2 + hh) * 2048 + (rt & 15) * 128) * 64;
        }
        float4 g0 = make_float4(1.f, 1.f, 1.f, 1.f), g1 = g0;
        if (gn) { g0 = *(const float4*)(gn + c * 8); g1 = *(const float4*)(gn + c * 8 + 4); }
#pragma unroll
        for (int i = 0; i < 4; ++i) {
          const int r = rq + 32 * i;
          const float* cp = Cs + r * 132 + hh * 64 + c * 8;
          const f32x4 c0 = *(const f32x4*)cp, c1 = *(const f32x4*)(cp + 4);
          float rn = 1.0f;
          if (gn) {
            float ss = c0[0] * c0[0] + c0[1] * c0[1] + c0[2] * c0[2] + c0[3] * c0[3] + c1[0] * c1[0] + c1[1] * c1[1] + c1[2] * c1[2] + c1[3] * c1[3];
            ss += __shfl_xor(ss, 1); ss += __shfl_xor(ss, 2); ss += __shfl_xor(ss, 4);
            rn = osc / sqrtf(ss * (1.0f / 64.0f) + 1e-6f);
          }
          u32x4 w;
          w[0] = pack2(c0[0] * rn * g0.x, c0[1] * rn * g0.y); w[1] = pack2(c0[2] * rn * g0.z, c0[3] * rn * g0.w);
          w[2] = pack2(c1[0] * rn * g1.x, c1[1] * rn * g1.y); w[3] = pack2(c1[2] * rn * g1.z, c1[3] * rn * g1.w);
          __builtin_nontemporal_store(w, (u32x4*)(dstb + (size_t)r * 64 + c * 8));
        }
      }
    }
    __syncthreads();
  }
}

DEVI void compress_phase(PR p, char* lds) {
  const int tid = get_tid(), lane = tid & 63, wid = tid >> 6, wr = wid >> 1, wc = wid & 1, fr = lane & 15, fq = lane >> 4;
  for (int it = blockIdx.x; it < 64; it += gridDim.x) {
    const int kv = it >> 5, bg = it & 31;
    const bf16_t* base = (kv ? p.VC : p.KC) + (size_t)bg * 2048 * 64;
    const bf16_t* W1 = kv ? p.Wc1vt : p.Wc1kt;
    const bf16_t* W2 = kv ? p.Wc2vt : p.Wc2kt;
    const float* bias = p.bias1 + kv * 128;
    f32x4 acc[4][4];
    gemm_mainloop<4>(acc, [&](int r) { return base + (size_t)min(r, 126) * 1024; }, W1, 2048, 2048, lds);
#pragma unroll
    for (int m = 0; m < 4; ++m)
#pragma unroll
      for (int n = 0; n < 4; ++n)
#pragma unroll
        for (int j = 0; j < 4; ++j) {
          const int row = wr * 64 + m * 16 + fq * 4 + j, col = wc * 64 + n * 16 + fr;
          const float xv = acc[m][n][j] + bias[col];
          const float u2 = 1.5957691216057308f * (xv + 0.044715f * xv * xv * xv);
          const float hv = xv * sigmoidf_(u2);
          const int c = col & 63;
          *(bf16_t*)(lds + (col >> 6) * 16384 + swz(row, c >> 3) + (c & 7) * 2) = f2bf(hv);
        }
#pragma unroll
    for (int i = 0; i < 4; ++i) {
      const int q = tid + 256 * i; const int r = q >> 4, c16 = q & 15;
      *(u32x4*)(lds + 32768 + (c16 >> 3) * 8192 + swz(r, c16 & 7)) = *(const u32x4*)(W2 + (size_t)r * 128 + c16 * 8);
    }
    __syncthreads();
    f32x4 a2[4][2];
#pragma unroll
    for (int m = 0; m < 4; ++m) { a2[m][0] = (f32x4){0.f, 0.f, 0.f, 0.f}; a2[m][1] = (f32x4){0.f, 0.f, 0.f, 0.f}; }
#pragma unroll
    for (int ktile = 0; ktile < 2; ++ktile) mma_stage<2>(lds + ktile * 16384, lds + 32768 + ktile * 8192, a2, wr, wc, fr, fq);
    __syncthreads();
    float* C2 = (float*)lds;
#pragma unroll
    for (int m = 0; m < 4; ++m)
#pragma unroll
      for (int n = 0; n < 2; ++n)
#pragma unroll
        for (int j = 0; j < 4; ++j) C2[(wr * 64 + m * 16 + fq * 4 + j) * 68 + wc * 32 + n * 16 + fr] = a2[m][n][j];
    __syncthreads();
    const int row = tid >> 1, half = tid & 1;
    float v[32];
#pragma unroll
    for (int i = 0; i < 8; ++i) { const f32x4 c = *(const f32x4*)(C2 + row * 68 + half * 32 + i * 4); v[4 * i] = c[0]; v[4 * i + 1] = c[1]; v[4 * i + 2] = c[2]; v[4 * i + 3] = c[3]; }
    if (kv == 0) {
      float ss = 0.f;
#pragma unroll
      for (int i = 0; i < 32; ++i) ss += v[i] * v[i];
      ss += __shfl_xor(ss, 1);
      const float rn = (row < 127) ? 1.0f / sqrtf(ss * (1.0f / 64.0f) + 1e-6f) : 0.f;
      bf16_t* dst = p.KCMP + ((size_t)bg * 128 + row) * 64 + half * 32;
#pragma unroll
      for (int i = 0; i < 4; ++i) {
        u32x4 w;
#pragma unroll
        for (int e = 0; e < 4; ++e) { const int c = 8 * i + 2 * e; w[e] = pack2(v[c] * rn * p.nsa_k_norm_cmp[half * 32 + c], v[c + 1] * rn * p.nsa_k_norm_cmp[half * 32 + c + 1]); }
        *(u32x4*)(dst + i * 8) = w;
      }
    } else {
      const float z = (row < 127) ? 1.0f : 0.f;
      bf16_t* dst = p.VCMPt + ((size_t)bg * 64 + half * 32) * 128 + row;
#pragma unroll
      for (int i = 0; i < 32; ++i) dst[(size_t)i * 128] = f2bf(v[i] * z);
    }
    __syncthreads();
    if (tid == 0) {
      __builtin_amdgcn_fence(__ATOMIC_RELEASE, "agent");
      __hip_atomic_store(&p.cflag[it], 1, __ATOMIC_RELAXED, __HIP_MEMORY_SCOPE_AGENT);
    }
  }
}


DEVI void nsa_stage_tile(char* lds, int st, const bf16_t* Kg  , const bf16_t* Vg  , int vld) {
  const int tid = get_tid();
  char* Ks = lds + st * 18432; char* Vs = Ks + 9216;
#pragma unroll
  for (int i = 0; i < 2; ++i) {
    const int q = tid + 256 * i; const int r = q >> 3, c = q & 7;
    *(u32x4*)(Ks + r * 144 + c * 16) = *(const u32x4*)(Kg + (size_t)r * 64 + c * 8);
    *(u32x4*)(Vs + r * 144 + c * 16) = *(const u32x4*)(Vg + (size_t)r * vld + c * 8);
  }
}

DEVI void out_rmw2(bf16_t* const (&dst)[2], const f32x4 (&o)[4][2], float f0, float f1, bool accumulate) {
  u32x2 w[2][4];
  if (accumulate) {
#pragma unroll
    for (int qt = 0; qt < 2; ++qt)
#pragma unroll
      for (int dt = 0; dt < 4; ++dt) w[qt][dt] = *(const u32x2*)(dst[qt] + dt * 16);
  }
#pragma unroll
  for (int qt = 0; qt < 2; ++qt) {
    const float f = qt ? f1 : f0;
#pragma unroll
    for (int dt = 0; dt < 4; ++dt) {
      float a0 = o[dt][qt][0] * f, a1 = o[dt][qt][1] * f, a2 = o[dt][qt][2] * f, a3 = o[dt][qt][3] * f;
      if (accumulate) { a0 += bflo(w[qt][dt][0]); a1 += bfhi(w[qt][dt][0]); a2 += bflo(w[qt][dt][1]); a3 += bfhi(w[qt][dt][1]); }
      u32x2 r; r[0] = pack2(a0, a1); r[1] = pack2(a2, a3);
      w[qt][dt] = r;
    }
  }
#pragma unroll
  for (int qt = 0; qt < 2; ++qt)
#pragma unroll
    for (int dt = 0; dt < 4; ++dt) *(u32x2*)(dst[qt] + dt * 16) = w[qt][dt];
}

DEVI void nsa_attn_phase(PR p, char* lds) {
  constexpr int STR = 144, STG = 22528;
  constexpr int OSTR = 136;
  const int tid = get_tid(), lane = tid & 63, wid = tid >> 6, fr = lane & 15, fq = lane >> 4;
  float* Ptok = (float*)(lds + 2 * STG);
  unsigned* maskL = (unsigned*)(lds + 2 * STG + 8192);
  char* Ot = lds + 2 * STG + 8192 + 64;
  float cbound;
  {
    float gq = fabsf(p.nsa_q_norm[lane]);
    float gk = fmaxf(fabsf(p.nsa_k_norm_cmp[lane]), fmaxf(fabsf(p.nsa_k_norm_slc[lane]), fabsf(p.nsa_k_norm_win[lane])));
#pragma unroll
    for (int m = 32; m >= 1; m >>= 1) { gq = fmaxf(gq, __shfl_xor(gq, m)); gk = fmaxf(gk, __shfl_xor(gk, m)); }
    cbound = 8.0f * LOG2E * gq * gk * 1.01f;
  }
  __syncthreads();
  for (int q = tid; q < 2 * 256; q += 256) { const int stz = q >> 8, r4 = q & 255; *(u32x4*)(lds + stz * STG + 18432 + r4 * 16) = (u32x4){0u, 0u, 0u, 0u}; }
  __syncthreads();
  XcdIter xi; xi.init();
  int cmp_seen = 0;
  for (int n = xi.lb; n < 512; n += xi.nlb) {
    const int bg = xi.xcd * 4 + (n >> 7), b = bg >> 1, g = bg & 1;
    const int tl128 = n & 127;
    const int t0 = (((n >> 6) & 1) ? (127 - (tl128 & 63)) : (tl128 & 63)) * 16;
    const int head = fr & 7;
    const int hg = g * 8 + head;
    const int pbase = p.pos[b * 2048 + t0];
    int tq[2]; float colc[2]; bf16x8 qf[2][2]; bf16x8 qa[2]; float gate[3][2];
    const float slope2 = exp2f(-0.5f * (float)(hg + 1)) * LOG2E;
#pragma unroll
    for (int qt = 0; qt < 2; ++qt) {
      tq[qt] = t0 + 4 * wid + 2 * qt + (fr >> 3);
      colc[qt] = -slope2 * (float)(p.pos[b * 2048 + tq[qt]] - pbase) - cbound;
      qa[qt] = make_qaug(slope2, colc[qt], fq);
      const bf16_t* qp = p.Q1 + ((size_t)(b * 16 + hg) * 2048 + tq[qt]) * 64;
      qf[qt][0] = *(const bf16x8*)(qp + fq * 8);
      qf[qt][1] = *(const bf16x8*)(qp + 32 + fq * 8);
      const float* gp = p.GATES + (size_t)(b * 2048 + tq[qt]) * 48 + hg;
      gate[0][qt] = gp[0]; gate[1][qt] = gp[16]; gate[2][qt] = gp[32];
    }
    char* orow[2];
#pragma unroll
    for (int qt = 0; qt < 2; ++qt) orow[qt] = Ot + (32 * wid + 16 * qt + fr) * OSTR + 8 * fq;
    auto out_acc = [&](const f32x4 (&o)[4][2], float f0, float f1, bool first) {
#pragma unroll
      for (int qt = 0; qt < 2; ++qt) {
        const float f = qt ? f1 : f0;
#pragma unroll
        for (int dt = 0; dt < 4; ++dt) {
          float a0 = o[dt][qt][0] * f, a1 = o[dt][qt][1] * f, a2 = o[dt][qt][2] * f, a3 = o[dt][qt][3] * f;
          if (!first) {
            const u32x2 w = *(const u32x2*)(orow[qt] + dt * 32);
            a0 += bflo(w[0]); a1 += bfhi(w[0]); a2 += bflo(w[1]); a3 += bfhi(w[1]);
          }
          u32x2 r; r[0] = pack2(a0, a1); r[1] = pack2(a2, a3);
          *(u32x2*)(orow[qt] + dt * 32) = r;
        }
      }
    };

    u32x4 rk[2], rv[2]; int rpos = 0;
    const int sr = tid >> 3, sc = tid & 7;
    auto fetch = [&](const bf16_t* Kg, const bf16_t* Vg, int vstride, const int* posg, int pstride, int pmax) {
      rk[0] = *(const u32x4*)(Kg + (size_t)sr * 64 + sc * 8);
      rk[1] = *(const u32x4*)(Kg + (size_t)(sr + 32) * 64 + sc * 8);
      rv[0] = *(const u32x4*)(Vg + (size_t)sr * vstride + sc * 8);
      rv[1] = *(const u32x4*)(Vg + (size_t)(sr + 32) * vstride + sc * 8);
      if (tid < 64) rpos = posg[min(tid * pstride, pmax)];
    };
    auto commit = [&](int st) {
      char* Ks = lds + st * STG; char* Vs = Ks + 9216;
      *(u32x4*)(Ks + sr * 144 + sc * 16) = rk[0];
      *(u32x4*)(Ks + (sr + 32) * 144 + sc * 16) = rk[1];
      *(u32x4*)(Vs + sr * 144 + sc * 16) = rv[0];
      *(u32x4*)(Vs + (sr + 32) * 144 + sc * 16) = rv[1];
      if (tid < 64) *(u32x4*)(Ks + 18432 + tid * 64) = make_kaug((float)(rpos - pbase));
    };
    auto fetch_win = [&](int key0) { PR q = *get_params(); fetch(q.KW + ((size_t)bg * 2048 + key0) * 64, q.VWt + (size_t)bg * 64 * 2048 + key0, 2048, q.pos + b * 2048 + key0, 1, 63); };
    auto fetch_slc = [&](int key0) { PR q = *get_params(); fetch(q.KS + ((size_t)bg * 2048 + key0) * 64, q.VSt + (size_t)bg * 64 * 2048 + key0, 2048, q.pos + b * 2048 + key0, 1, 63); };
    auto fetch_cmp = [&](int tile) { PR q = *get_params(); fetch(q.KCMP + ((size_t)bg * 128 + tile * 64) * 64, q.VCMPt + (size_t)bg * 64 * 128 + tile * 64, 128,
                                                                    q.pos + b * 2048 + 1024 * tile + 31, 16, 2047 - 1024 * tile - 31); };

    int stw;
    {
      __syncthreads();
      f32x4 o[4][2], ol[2];
      ol[0] = (f32x4){0.f, 0.f, 0.f, 0.f}; ol[1] = (f32x4){0.f, 0.f, 0.f, 0.f};
#pragma unroll
      for (int dt = 0; dt < 4; ++dt) { o[dt][0] = (f32x4){0.f, 0.f, 0.f, 0.f}; o[dt][1] = (f32x4){0.f, 0.f, 0.f, 0.f}; }
      const int kfirst = max(0, t0 - 255) >> 6, klast = t0 >> 6;
      stw = (klast - kfirst) & 1;
      fetch_win(kfirst * 64);
      for (int k64 = kfirst; k64 <= klast; ++k64) {
        const int key0 = k64 * 64;
        const int st = (k64 - kfirst) & 1;
        commit(st);
        __syncthreads();
        if (k64 < klast) fetch_win(key0 + 64);
        else {
          const int bgl = (n >> 7) & 3;
          if (!((cmp_seen >> bgl) & 1)) {
            if (wid == 0) {
              PR q = *get_params();
              for (unsigned spin = 0; spin < (1u << 22); ++spin) {
                int ok = 0;
                if (lane == 0) ok = (__hip_atomic_load(&q.cflag[bg], __ATOMIC_RELAXED, __HIP_MEMORY_SCOPE_AGENT) != 0) &
                                    (__hip_atomic_load(&q.cflag[32 + bg], __ATOMIC_RELAXED, __HIP_MEMORY_SCOPE_AGENT) != 0);
                if (__builtin_amdgcn_readfirstlane(ok)) break;
                __builtin_amdgcn_s_sleep(8);
              }
              __builtin_amdgcn_fence(__ATOMIC_ACQUIRE, "agent");
            }
            __syncthreads();
            cmp_seen |= 1 << bgl;
          }
          fetch_cmp(0);
        }
        const char* Kc = lds + st * STG;
        f32x4 s[4][2];
        qk_tile_aug<2, STR>(Kc, Kc + 18432, qf, qa, s, fr, fq);
        if (key0 < t0 + 15 - 255 || key0 + 63 > t0) {
#pragma unroll
          for (int kt = 0; kt < 4; ++kt)
#pragma unroll
            for (int j = 0; j < 4; ++j) {
              const int key = key0 + 16 * kt + 4 * fq + j;
#pragma unroll
              for (int qt = 0; qt < 2; ++qt) {
                const unsigned rel = (unsigned)(tq[qt] - key);
                s[kt][qt][j] = (rel < 256u) ? s[kt][qt][j] : NEGBIG;
              }
            }
        }
        exp_tile(s);
        pv_tile_l<STR>(Kc + 9216, s, o, ol, fr, fq);
      }
      {
        const float l0 = ol[0][0], l1 = ol[1][0];
        out_acc(o, (l0 > 0.f) ? gate[2][0] / l0 : 0.f, (l1 > 0.f) ? gate[2][1] / l1 : 0.f, true);
      }
    }

    {
      const int clim[2] = {(tq[0] - 31) >> 4, (tq[1] - 31) >> 4};
      const int sA = stw ^ 1, sB = stw;
      f32x4 ol[2];
      ol[0] = (f32x4){0.f, 0.f, 0.f, 0.f}; ol[1] = (f32x4){0.f, 0.f, 0.f, 0.f};
      f32x4 o[4][2];
#pragma unroll
      for (int dt = 0; dt < 4; ++dt) { o[dt][0] = (f32x4){0.f, 0.f, 0.f, 0.f}; o[dt][1] = (f32x4){0.f, 0.f, 0.f, 0.f}; }
      u32x4 Pk[2][2][2];
      const u32x4 onesw = (u32x4){0x3f803f80u, 0x3f803f80u, 0x3f803f80u, 0x3f803f80u};
#pragma unroll
      for (int tl2 = 0; tl2 < 2; ++tl2) {
        const int st = tl2 ? sB : sA;
        commit(st);
        __syncthreads();
        if (tl2 == 0) fetch_cmp(1);
        const bool live = (tl2 == 0) || (((t0 + 15 - 31) >> 4) >= 64);
        if (!live) {
#pragma unroll
          for (int u = 0; u < 2; ++u) { Pk[tl2][u][0] = (u32x4){0u, 0u, 0u, 0u}; Pk[tl2][u][1] = (u32x4){0u, 0u, 0u, 0u}; }
        } else {
          f32x4 s[4][2];
          qk_tile_aug<2, STR>(lds + st * STG, lds + st * STG + 18432, qf, qa, s, fr, fq);
#pragma unroll
          for (int kt = 0; kt < 4; ++kt)
#pragma unroll
            for (int j = 0; j < 4; ++j) {
              const int c0 = tl2 * 64 + 16 * kt + 4 * fq + j;
#pragma unroll
              for (int qt = 0; qt < 2; ++qt) s[kt][qt][j] = fast_exp2((c0 <= clim[qt]) ? s[kt][qt][j] : NEGBIG);
            }
#pragma unroll
          for (int u = 0; u < 2; ++u)
#pragma unroll
            for (int qt = 0; qt < 2; ++qt) {
              u32x4 w;
              w[0] = pack2(s[2 * u][qt][0], s[2 * u][qt][1]); w[1] = pack2(s[2 * u][qt][2], s[2 * u][qt][3]);
              w[2] = pack2(s[2 * u + 1][qt][0], s[2 * u + 1][qt][1]); w[3] = pack2(s[2 * u + 1][qt][2], s[2 * u + 1][qt][3]);
              Pk[tl2][u][qt] = w;
            }
        }
        __builtin_amdgcn_sched_barrier(0);
        if (tl2 == 1) fetch_slc(0);
        const char* Vs = lds + st * STG + 9216;
        if (live)
#pragma unroll
        for (int u = 0; u < 2; ++u) {
          const bf16x8 b0 = __builtin_bit_cast(bf16x8, Pk[tl2][u][0]), b1 = __builtin_bit_cast(bf16x8, Pk[tl2][u][1]);
#pragma unroll
          for (int dt = 0; dt < 4; ++dt) {
            const char* vp = Vs + (dt * 16 + fr) * STR + (32 * u + 4 * fq) * 2;
            const u32x2 lo = *(const u32x2*)(vp);
            const u32x2 hi = *(const u32x2*)(vp + 32);
            const bf16x8 a = __builtin_bit_cast(bf16x8, ((u32x4){lo[0], lo[1], hi[0], hi[1]}));
            o[dt][0] = __builtin_amdgcn_mfma_f32_16x16x32_bf16(a, b0, o[dt][0], 0, 0, 0);
            o[dt][1] = __builtin_amdgcn_mfma_f32_16x16x32_bf16(a, b1, o[dt][1], 0, 0, 0);
          }
          const bf16x8 ones = __builtin_bit_cast(bf16x8, onesw);
          ol[0] = __builtin_amdgcn_mfma_f32_16x16x32_bf16(ones, b0, ol[0], 0, 0, 0);
          ol[1] = __builtin_amdgcn_mfma_f32_16x16x32_bf16(ones, b1, ol[1], 0, 0, 0);
        }
      }
      float linv[2];
#pragma unroll
      for (int qt = 0; qt < 2; ++qt) { const float r = ol[qt][0]; linv[qt] = (r > 0.f) ? 1.0f / r : 0.f; }
#pragma unroll
      for (int tl2 = 0; tl2 < 2; ++tl2)
#pragma unroll
        for (int qt = 0; qt < 2; ++qt) {
          const int tl = 4 * wid + 2 * qt + (fr >> 3);
#pragma unroll
          for (int kt = 0; kt < 4; ++kt) {
            const u32x4 w = Pk[tl2][kt >> 1][qt];
            const unsigned w0 = w[(kt & 1) * 2], w1 = w[(kt & 1) * 2 + 1];
            f32x4 hs;
            hs[0] = head8_sum(bflo(w0) * linv[qt]); hs[1] = head8_sum(bfhi(w0) * linv[qt]);
            hs[2] = head8_sum(bflo(w1) * linv[qt]); hs[3] = head8_sum(bfhi(w1) * linv[qt]);
            if (head == 0) *(f32x4*)(Ptok + tl * 128 + tl2 * 64 + 16 * kt + 4 * fq) = hs;
          }
        }
      out_acc(o, gate[0][0] * linv[0], gate[0][1] * linv[1], false);
      __syncthreads();
      const int cur = t0 >> 6;
      const int j = tid & 31;
#pragma unroll
      for (int i = 0; i < 2; ++i) {
        const int tl = (tid >> 5) + 8 * i;
        float im = 0.f;
        for (int c = max(4 * j - 1, 0); c <= 4 * j + 3; ++c) im += Ptok[tl * 128 + c];
        const bool forced = (j == 0) || (j == cur) || (j == cur - 1);
        const float v = forced ? 1e4f : ((j <= cur) ? im : -1.0f);
        unsigned key = ((v < 0.f) ? 0u : (__float_as_uint(v) | 0x80000000u));
        key = (key & ~31u) | (unsigned)(31 - j);
        bool sel = false;
#pragma unroll
        for (int rnd = 0; rnd < 8; ++rnd) {
          unsigned m = key;
          m = max(m, (unsigned)__builtin_amdgcn_update_dpp(0, (int)m, 0xB1, 0xF, 0xF, true));
          m = max(m, (unsigned)__builtin_amdgcn_update_dpp(0, (int)m, 0x4E, 0xF, 0xF, true));
          m = max(m, (unsigned)__builtin_amdgcn_update_dpp(0, (int)m, 0x141, 0xF, 0xF, true));
          m = max(m, (unsigned)__builtin_amdgcn_update_dpp(0, (int)m, 0x140, 0xF, 0xF, true));
          m = max(m, (unsigned)__shfl_xor((int)m, 16));
          const bool win = (key == m);
          sel = sel || win;
          key = win ? 0u : key;
        }
        const unsigned long long bal = __ballot(sel);
        if (j == 0) maskL[tl] = (unsigned)(bal >> (lane & 32));
      }
      __syncthreads();
    }

    {
      const int cur = t0 >> 6;
      const unsigned curmask = (cur >= 31) ? 0xffffffffu : ((2u << cur) - 1u);
      unsigned um = 0u;
#pragma unroll
      for (int i = 0; i < 16; ++i) um |= maskL[i];
      um &= curmask;
      unsigned mq[2];
#pragma unroll
      for (int qt = 0; qt < 2; ++qt) mq[qt] = maskL[4 * wid + 2 * qt + (fr >> 3)];
      const unsigned wm = (maskL[4 * wid] | maskL[4 * wid + 1] | maskL[4 * wid + 2] | maskL[4 * wid + 3]) & curmask;
      f32x4 o[4][2], ol[2];
      ol[0] = (f32x4){0.f, 0.f, 0.f, 0.f}; ol[1] = (f32x4){0.f, 0.f, 0.f, 0.f};
#pragma unroll
      for (int dt = 0; dt < 4; ++dt) { o[dt][0] = (f32x4){0.f, 0.f, 0.f, 0.f}; o[dt][1] = (f32x4){0.f, 0.f, 0.f, 0.f}; }
      const bf16x8 qneg = make_qaug(slope2, NEGBIG, fq);
      unsigned rem = um;
      for (int step = 0; rem != 0u; ++step) {
        const int jb = __builtin_ctz(rem); rem &= rem - 1u;
        const int key0 = jb * 64;
        const int st = step & 1;
        commit(st);
        __syncthreads();
        if (rem != 0u) fetch_slc(__builtin_ctz(rem) * 64);
        if ((wm >> jb) & 1u) {
          const char* Kc = lds + st * STG;
          f32x4 s[4][2];
          bf16x8 qs[2];
          qs[0] = ((mq[0] >> jb) & 1u) ? qa[0] : qneg;
          qs[1] = ((mq[1] >> jb) & 1u) ? qa[1] : qneg;
          qk_tile_aug<2, STR>(Kc, Kc + 18432, qf, qs, s, fr, fq);
          if (jb == cur) {
#pragma unroll
            for (int kt = 0; kt < 4; ++kt)
#pragma unroll
              for (int j = 0; j < 4; ++j) {
                const int key = key0 + 16 * kt + 4 * fq + j;
#pragma unroll
                for (int qt = 0; qt < 2; ++qt) s[kt][qt][j] = (key <= tq[qt]) ? s[kt][qt][j] : NEGBIG;
              }
          }
          exp_tile(s);
          pv_tile_l<STR>(Kc + 9216, s, o, ol, fr, fq);
        }
      }
      {
        const float l0 = ol[0][0], l1 = ol[1][0];
        out_acc(o, (l0 > 0.f) ? gate[1][0] / l0 : 0.f, (l1 > 0.f) ? gate[1][1] / l1 : 0.f, false);
      }
    }
    {
      const int c16 = lane & 7;
#pragma unroll
      for (int i = 0; i < 4; ++i) {
        const int r = (lane >> 3) + 8 * i;
        const int tok = t0 + 4 * wid + 2 * (r >> 4) + ((r & 15) >> 3), hh = g * 8 + (r & 7);
        const char* src = Ot + (32 * wid + r) * OSTR + c16 * 16;
        const u32x2 lo = *(const u32x2*)(src), hi = *(const u32x2*)(src + 8);
        *(u32x4*)(p.hn + (size_t)(b * 2048 + tok) * 1024 + hh * 64 + c16 * 8) = (u32x4){lo[0], lo[1], hi[0], hi[1]};
      }
    }
    __syncthreads();
  }
}

DEVI void misc_init(PR p) {
  if (blockIdx.x >= gridDim.x - 9 && blockIdx.x < gridDim.x - 1) {
    const int part = blockIdx.x - (gridDim.x - 9);
    const int layer = part >> 2, k = (part & 3) * 256 + get_tid();
    const float g = p.norm_ffn[layer * 1024 + k];
    for (int n = 0; n < 48; ++n) {
      float w = 0.f;
      if (n < 4) w = p.r_group[((size_t)layer * 1024 + k) * 4 + n];
      else if (n < 36) w = p.r_expert[((size_t)layer * 1024 + k) * 32 + (n - 4)];
      w *= g;
      const float hi = bf_round(w);
      p.RWh[((size_t)layer * 48 + n) * 1024 + k] = f2bf(hi);
      p.RWl[((size_t)layer * 48 + n) * 1024 + k] = f2bf(w - hi);
    }
  }
  if (blockIdx.x == gridDim.x - 1) {
    const int tid = get_tid();
    if (tid < 64) { p.gcnt[tid] = 0; p.cflag[tid] = 0; }
    p.gcntP[tid] = 0;
    const int kv = tid >> 7, n = tid & 127;
    const float* pe = kv ? p.cmp_pe_v : p.cmp_pe_k;
    const float* w1 = kv ? p.cmp_w1_v : p.cmp_w1_k;
    float a = 0.f;
    for (int i = 0; i < 2048; ++i) a += pe[i] * w1[(size_t)i * 128 + n];
    p.bias1[tid] = a;
  }
}


#define XB_TMO      128
#define XB_XCNT(j)  (256  + 64 * (j))
#define XB_XSUB(j)  (1280 + 64 * (j))
#define XB_XGEN(j)  (2304 + 64 * (j))
#define XB_TOP      3328
#define XB_TOPGEN   3392
#define XCD_BAR_WORDS 3456
#define XB_SPIN_CAP (1u << 20)
#define LAS __attribute__((address_space(3)))
DEVI unsigned xb_ld(unsigned* p) { return __hip_atomic_load(p, __ATOMIC_RELAXED, __HIP_MEMORY_SCOPE_AGENT); }
DEVI unsigned xb_add(unsigned* p, unsigned v) { return __hip_atomic_fetch_add(p, v, __ATOMIC_RELAXED, __HIP_MEMORY_SCOPE_AGENT); }
DEVI unsigned xb_xcc_id() { return (unsigned)__builtin_amdgcn_s_getreg((3 << 11) | 20) & 0xFu; }
#define XB_SPIN(cond, bar) do { unsigned _sp = 0; while (cond) { __builtin_amdgcn_s_sleep(1); \
    if ((++_sp & 255u) == 0u) { if (xb_ld(&(bar)[XB_TMO])) break; if (_sp > XB_SPIN_CAP) { atomicAdd(&(bar)[XB_TMO], 1u); break; } } } } while (0)
struct XcdBarrier { unsigned* bar; unsigned x; volatile LAS unsigned* st; };
DEVI XcdBarrier xcd_barrier_post(unsigned* bar, volatile LAS unsigned* st) {
  XcdBarrier b; b.bar = bar; b.x = xb_xcc_id(); b.st = st;
  if (threadIdx.x == 0) (void)xb_add(&bar[XB_XCNT(b.x)], 1u);
  return b;
}
DEVI void xcd_barrier_complete(unsigned* bar, unsigned x, unsigned& nloc, unsigned& nx) {
  const unsigned G = gridDim.x * gridDim.y * gridDim.z;
  unsigned sum, cnt, mine, sp = 0u;
  for (;;) {
    sum = 0u; cnt = 0u; mine = 0u;
#pragma unroll
    for (unsigned j = 0; j < 16; ++j) { const unsigned c = xb_ld(&bar[XB_XCNT(j)]); sum += c; cnt += (c > 0u) ? 1u : 0u; mine = (j == x) ? c : mine; }
    if (sum == G) break;
    __builtin_amdgcn_s_sleep(1);
    if ((++sp & 255u) == 0u) { if (xb_ld(&bar[XB_TMO])) break; if (sp > XB_SPIN_CAP) { atomicAdd(&bar[XB_TMO], 1u); break; } }
  }
  nloc = mine > 0u ? mine : 1u; nx = cnt > 0u ? cnt : 1u;
}
DEVI void xcd_barrier(const XcdBarrier& b) {
  asm volatile("s_waitcnt vmcnt(0)" ::: "memory");
  __syncthreads();
  if (threadIdx.x == 0) {
    unsigned* bar = b.bar;
    __builtin_amdgcn_s_waitcnt(0);
    unsigned nloc = b.st[0], nx = b.st[1];
    if (nloc == 0u) { xcd_barrier_complete(bar, b.x, nloc, nx); b.st[0] = nloc; b.st[1] = nx; }
    const unsigned old = xb_add(&bar[XB_XSUB(b.x)], 1u);
    const unsigned gen = old / nloc;
    if (old + 1u == (gen + 1u) * nloc) {
      __builtin_amdgcn_fence(__ATOMIC_RELEASE, "agent");
      asm volatile("s_waitcnt vmcnt(0)" ::: "memory");
      const unsigned og = xb_add(&bar[XB_TOP], 1u);
      const unsigned tg = og / nx;
      if (og + 1u == (tg + 1u) * nx) xb_add(&bar[XB_TOPGEN], 1u);
      else XB_SPIN(xb_ld(&bar[XB_TOPGEN]) == tg, bar);
      __builtin_amdgcn_fence(__ATOMIC_ACQUIRE, "agent");
      xb_add(&bar[XB_XGEN(b.x)], 1u);
      asm volatile("s_waitcnt vmcnt(0)" ::: "memory");
    } else {
      XB_SPIN(xb_ld(&bar[XB_XGEN(b.x)]) == gen, bar);
      __builtin_amdgcn_fence(__ATOMIC_ACQUIRE, "agent");
      asm volatile("s_waitcnt vmcnt(0)" ::: "memory");
    }
  }
  __syncthreads();
}

#ifndef PROBE_PHASE
#define PROBE_PHASE -1
#endif
#define GSYNC() do { if (use_cg) grid.sync(); else xcd_barrier(xb); } while (0)
__global__ void __launch_bounds__(256, 2) mega_kernel(Params p_unused) {
  extern __shared__ __attribute__((aligned(16))) char lds[];
  cg::grid_group grid = cg::this_grid();
  volatile LAS unsigned* xst = (volatile LAS unsigned*)(lds + LDS_BYTES - 16);
  if (threadIdx.x == 0) { xst[0] = 0u; xst[1] = 0u; }
  __syncthreads();
  unsigned* barw; int use_cg;
  { PR p = *get_params(); barw = p.bar; use_cg = p.use_cg; }
  const XcdBarrier xb = xcd_barrier_post(barw, xst);
  { PR p = *get_params(); conv_weights_phase(p, 0, p.njobsA, p.ntilesA, lds); }
  { PR p = *get_params(); xcopy_phase(p); }
  { PR p = *get_params(); misc_init(p); }
  GSYNC();
#if PROBE_PHASE == 0
  { PR p = *get_params(); conv_weights_phase(p, 0, p.njobsA, p.ntilesA, lds); }
  { PR p = *get_params(); xcopy_phase(p); }
  GSYNC();
#endif
  { PR p = *get_params(); gemm_bf16out_phase(p.xb, 1024, p.W1t, 1024, 12, p.proj0, PROJ_LD, 416, p.rs0, p.ssq, p.gluB, lds); }
  { PR p = *get_params(); conv_weights_phase(p, p.njobsA, p.njobs0, p.ntiles0, lds); }
  GSYNC();
#if PROBE_PHASE == 1
  { PR p = *get_params(); gemm_bf16out_phase(p.xb, 1024, p.W1t, 1024, 12, p.proj0, PROJ_LD, 416, p.rs0, p.ssq, p.gluB, lds); }
  GSYNC();
#endif
  { PR p = *get_params(); l0_phase2(p, lds); }
  GSYNC();
#if PROBE_PHASE == 2
  { PR p = *get_params(); l0_phase2(p, lds); }
  GSYNC();
#endif
  { PR p = *get_params(); mla_attn_phase(p, lds); }
  GSYNC();
#if PROBE_PHASE == 3
  { PR p = *get_params(); mla_attn_phase(p, lds); }
  GSYNC();
#endif
  { PR p = *get_params(); gemm_resid_phase(p.hn, p.Wo0t, p.xb, p.xr, lds); }
  GSYNC();
#if PROBE_PHASE == 4
  { PR p = *get_params(); gemm_resid_phase(p.hn, p.Wo0t, p.xb, p.xr, lds); }
  GSYNC();
#endif
#if PROBE_PHASE == 5
  { PR p = *get_params(); router_phase(p, 1, lds); }
  GSYNC();
  { PR p = *get_params(); if (blockIdx.x == 0 && threadIdx.x < 32) p.gcnt[32 + threadIdx.x] = 0; }
#endif
  { PR p = *get_params(); router_phase(p, 0, lds); }
  GSYNC();
  { PR p = *get_params(); moe_gateup_phase(p, 0, lds); }
  GSYNC();
#if PROBE_PHASE == 6
  { PR p = *get_params(); moe_gateup_phase(p, 0, lds); }
  GSYNC();
#endif
  { PR p = *get_params(); moe_down_phase(p, 0, lds); }
  GSYNC();
#if PROBE_PHASE == 7
  { PR p = *get_params(); moe_down_phase(p, 0, lds); }
  GSYNC();
#endif
  { PR p = *get_params(); nsa_proj_phase(p, lds); }
  GSYNC();
#if PROBE_PHASE == 9
  { PR p = *get_params(); nsa_proj_phase(p, lds); }
  GSYNC();
#endif
  { PR p = *get_params(); compress_phase(p, lds); }
  { PR p = *get_params(); conv_weights_phase(p, p.njobs1_begin, p.njobs1_begin + 3, p.ntiles1, lds); }
#if PROBE_PHASE == 10
  { PR p = *get_params(); compress_phase(p, lds); }
  GSYNC();
#endif
  { PR p = *get_params(); nsa_attn_phase(p, lds); }
  GSYNC();
#if PROBE_PHASE == 11
  { PR p = *get_params(); nsa_attn_phase(p, lds); }
  GSYNC();
#endif
  { PR p = *get_params(); gemm_resid_phase(p.hn, p.Wo1t, p.xr, p.xr, lds); }
  GSYNC();
  { PR p = *get_params(); router_phase(p, 1, lds); }
  GSYNC();
  { PR p = *get_params(); moe_gateup_phase(p, 1, lds); }
  GSYNC();
  { PR p = *get_params(); moe_down_phase(p, 1, lds); }
}

static inline size_t align_up(size_t v, size_t a) { return (v + a - 1) / a * a; }

extern "C" void kernel_launch(void* const* d_in, const int* in_sizes, int n_in, void* d_out, int out_size, void* d_ws, size_t ws_size,
                              hipStream_t stream) {
  (void)in_sizes; (void)n_in; (void)out_size;
  Params p;
  memset(&p, 0, sizeof(p));
  const float* const* in = (const float* const*)d_in;
  p.x = in[0]; p.pos = (const int*)d_in[1]; p.norm_mix = in[2]; p.norm_ffn = in[3];
  const float* mix0_w_in = in[4]; const float* mla_q_a_norm = in[5]; const float* mla_w_uq = in[6];
  const float* mla_kv_a_norm = in[7]; const float* mla_w_ukv = in[8];
  p.mla_q_norm = in[9]; p.mla_k_norm = in[10];
  p.conv_dw_w = in[11]; p.conv_dw_b = in[12]; p.conv_ln_g = in[13]; p.conv_ln_b = in[14];
  const float* mix0_w_out = in[15]; const float* nsa_w_in = in[16];
  p.nsa_q_norm = in[17]; p.nsa_k_norm_cmp = in[18]; p.nsa_k_norm_slc = in[19]; p.nsa_k_norm_win = in[20];
  p.cmp_pe_k = in[21]; p.cmp_w1_k = in[22]; const float* cmp_w2_k = in[23];
  p.cmp_pe_v = in[24]; p.cmp_w1_v = in[25]; const float* cmp_w2_v = in[26];
  const float* nsa_w_out = in[27];
  p.r_group = in[28]; p.r_group_b = in[29]; p.r_expert = in[30]; p.r_expert_b = in[31];
  const float* w_gate = in[32]; const float* w_up = in[33]; const float* w_down = in[34];
  p.out = (float*)d_out;

  char* ws = (char*)d_ws; size_t off = 0;
  auto take = [&](size_t bytes) { char* r = ws + off; off = align_up(off + bytes, 256); return r; };
  p.W1t = (bf16_t*)take((size_t)1536 * 1024 * 2);
  p.Wuqt = (bf16_t*)take((size_t)768 * 256 * 2);
  p.Wukvt = (bf16_t*)take((size_t)1024 * 128 * 2);
  p.Wo0t = (bf16_t*)take((size_t)1024 * 1024 * 2);
  p.W5t = (bf16_t*)take((size_t)1920 * 1024 * 2);
  p.Wc1kt = (bf16_t*)take((size_t)128 * 2048 * 2);
  p.Wc1vt = (bf16_t*)take((size_t)128 * 2048 * 2);
  p.Wc2kt = (bf16_t*)take((size_t)64 * 128 * 2);
  p.Wc2vt = (bf16_t*)take((size_t)64 * 128 * 2);
  p.Wo1t = (bf16_t*)take((size_t)1024 * 1024 * 2);
  p.Wgut = (bf16_t*)take((size_t)32 * 512 * 1024 * 2);
  p.Wdt = (bf16_t*)take((size_t)32 * 1024 * 256 * 2);
  p.xr = (bf16_t*)take((size_t)T_ * 1024 * 2);
  p.hn = (bf16_t*)take((size_t)T_ * 1024 * 2);
  p.RWh = (bf16_t*)take((size_t)2 * 48 * 1024 * 2);
  p.RWl = (bf16_t*)take((size_t)2 * 48 * 1024 * 2);
  p.rs = (float*)take((size_t)T_ * 4);
  p.rs0 = (float*)take((size_t)T_ * 4);
  {
    char* u = (char*)take((size_t)T_ * 1024 * 2);
    p.xb = (bf16_t*)u;
    size_t o = 0;
    auto tk = [&](size_t bytes) { char* r = u + o; o = align_up(o + bytes, 256); return r; };
    p.row_aux = (float2*)tk((size_t)32 * T_ * 8);
    p.row_tok = (int*)tk((size_t)32 * T_ * 4);
    p.pair_tok = (int*)tk((size_t)112 * T_ * 4);
    p.pair_rk = (int2*)tk((size_t)112 * T_ * 8);
  }
  p.gcnt = (int*)take(256);
  p.cflag = (int*)take(256);
  p.gcntP = (int*)take(1024);
  p.ssp = (float*)take((size_t)T_ * 8 * 4);
  p.ssq = (float*)take((size_t)T_ * 4 * 4);
  p.bias1 = (float*)take(1024);
  p.bar = (unsigned*)take((size_t)XCD_BAR_WORDS * 4);
  p.use_cg = 0;
  p.KCMP = (bf16_t*)take((size_t)32 * 128 * 64 * 2);
  p.VCMPt = (bf16_t*)take((size_t)32 * 64 * 128 * 2);
  char* scr = ws + off;
  {
    size_t o = 0;
    auto tk = [&](size_t bytes) { char* r = scr + o; o = align_up(o + bytes, 256); return r; };
    p.proj0 = (bf16_t*)tk((size_t)T_ * 1440 * 2);
    p.Q0 = (bf16_t*)tk((size_t)T_ * 768 * 2);
    p.K0 = (bf16_t*)tk((size_t)T_ * 768 * 2);
    p.V0t = (bf16_t*)tk((size_t)T_ * 512 * 2);
    p.gluB = (bf16_t*)tk((size_t)T_ * 512 * 2);
  }
  {
    size_t o = 0;
    auto tk = [&](size_t bytes) { char* r = scr + o; o = align_up(o + bytes, 256); return r; };
    p.hbuf = (bf16_t*)tk((size_t)(2 * T_ + 4096) * 256 * 2);
  }
  {
    size_t o = 0;
    auto tk = [&](size_t bytes) { char* r = scr + o; o = align_up(o + bytes, 256); return r; };
    p.Q1 = (bf16_t*)tk((size_t)T_ * 1024 * 2);
    p.KC = (bf16_t*)tk((size_t)T_ * 128 * 2);
    p.VC = (bf16_t*)tk((size_t)T_ * 128 * 2);
    p.KS = (bf16_t*)tk((size_t)T_ * 128 * 2);
    p.VSt = (bf16_t*)tk((size_t)T_ * 128 * 2);
    p.KW = (bf16_t*)tk((size_t)T_ * 128 * 2);
    p.VWt = (bf16_t*)tk((size_t)T_ * 128 * 2);
    p.GATES = (float*)tk((size_t)T_ * 48 * 4);
  }
  const size_t need = off + (size_t)T_ * (1440 + 768 + 768 + 512 + 512) * 2 + 8192;
  if (need > ws_size) { fprintf(stderr, "workspace too small: need %zu have %zu\n", need, ws_size); return; }
  for (int i = 0; i < 16; ++i) p.inv_freq[i] = (float)pow(10000.0, -(double)i / 16.0);

  int nj = 0, tiles = 0;
  auto add = [&](const float* src, bf16_t* dst, const float* gain, int K, int N, int Npad, int mode, int batch, long long ss, long long ds) {
    ConvJob& j = p.jobs[nj++];
    j.src = src; j.dst = dst; j.gain = gain; j.K = K; j.N = N; j.Npad = Npad; j.mode = mode; j.batch = batch; j.tile_start = tiles; j.pad0 = 0;
    j.sstride = ss; j.dstride = ds;
    tiles += batch * (K / 64) * (Npad / 64);
  };
  add(mix0_w_in, p.W1t, p.norm_mix, 1024, 1440, 1536, 3, 1, 0, 0);
  add(mla_w_uq, p.Wuqt, mla_q_a_norm, 256, 768, 768, 0, 1, 0, 0);
  add(mla_w_ukv, p.Wukvt, mla_kv_a_norm, 128, 1024, 1024, 0, 1, 0, 0);
  add(mix0_w_out, p.Wo0t, nullptr, 1024, 1024, 1024, 0, 1, 0, 0);
  add(nsa_w_in, p.W5t, p.norm_mix + 1024, 1024, 1840, 1920, 0, 1, 0, 0);
  add(p.cmp_w1_k, p.Wc1kt, nullptr, 2048, 128, 128, 0, 1, 0, 0);
  add(p.cmp_w1_v, p.Wc1vt, nullptr, 2048, 128, 128, 0, 1, 0, 0);
  add(cmp_w2_k, p.Wc2kt, nullptr, 128, 64, 64, 0, 1, 0, 0);
  add(cmp_w2_v, p.Wc2vt, nullptr, 128, 64, 64, 0, 1, 0, 0);
  add(nsa_w_out, p.Wo1t, nullptr, 1024, 1024, 1024, 0, 1, 0, 0);
  p.njobsA = nj; p.ntilesA = tiles;
  tiles = 0;
  add(w_gate, p.Wgut, p.norm_ffn, 1024, 256, 256, 1, 32, 1024LL * 256, 512LL * 1024);
  add(w_up, p.Wgut, p.norm_ffn, 1024, 256, 256, 2, 32, 1024LL * 256, 512LL * 1024);
  add(w_down, p.Wdt, nullptr, 256, 1024, 1024, 0, 32, 256LL * 1024, 1024LL * 256);
  p.njobs0 = nj; p.ntiles0 = tiles;
  p.njobs1_begin = nj;
  tiles = 0;
  const size_t l1 = (size_t)32 * 1024 * 256;
  add(w_gate + l1, p.Wgut, p.norm_ffn + 1024, 1024, 256, 256, 1, 32, 1024LL * 256, 512LL * 1024);
  add(w_up + l1, p.Wgut, p.norm_ffn + 1024, 1024, 256, 256, 2, 32, 1024LL * 256, 512LL * 1024);
  add(w_down + l1, p.Wdt, nullptr, 256, 1024, 1024, 0, 32, 256LL * 1024, 1024LL * 256);
  p.ntiles1 = tiles;

  static int grid_blocks = 0;
  if (!grid_blocks) {
    (void)hipFuncSetAttribute((const void*)mega_kernel, hipFuncAttributeMaxDynamicSharedMemorySize, LDS_BYTES);
    int dev = 0, cus = 0, per_cu = 0;
    (void)hipGetDevice(&dev);
    (void)hipDeviceGetAttribute(&cus, hipDeviceAttributeMultiprocessorCount, dev);
    (void)hipOccupancyMaxActiveBlocksPerMultiprocessor(&per_cu, mega_kernel, 256, LDS_BYTES);
    if (per_cu > 2) per_cu = 2;
    if (per_cu < 1) per_cu = 1;
    grid_blocks = cus * per_cu;
  }
  (void)hipMemsetAsync(p.bar, 0, (size_t)XCD_BAR_WORDS * 4, stream);
  void* args[] = {&p};
  hipError_t e = hipLaunchCooperativeKernel((const void*)mega_kernel, dim3(grid_blocks), dim3(256), args, LDS_BYTES, stream);
  if (e != hipSuccess) fprintf(stderr, "cooperative launch failed: %s (grid %d)\n", hipGetErrorString(e), grid_blocks);
}
```
